# Optimizing an MI355X kernel written in HIP

```python
import math
import jax, jax.numpy as jnp
from jax import lax
import numpy as np

D_MODEL = 2048
BATCH = 4
SEQ = 2048
DEPTH = 4

HEAD_DIM = 64
A_HEADS = 16
A_KV_HEADS = 2
A_REP = A_HEADS // A_KV_HEADS
A_WINDOW = 128
B_HEADS = 16
B_PATTERNS = ((128, 1), (512, 4), (2048, 16))
BLK = 128
NUM_BUCKETS = 32
REL_MAX_DISTANCE = 2048
N_ATTN_HEADS = A_HEADS + B_HEADS
A_WIDTH = A_HEADS * HEAD_DIM
A_KV_WIDTH = A_KV_HEADS * HEAD_DIM
B_WIDTH = B_HEADS * HEAD_DIM
EVEN_MIX = A_WIDTH + B_WIDTH
EVEN_IN = 2 * A_WIDTH + 2 * A_KV_WIDTH + 4 * B_WIDTH
C_WIDTH = 2 * D_MODEL
C_GROUPS = 16
C_GROUP_DIM = C_WIDTH // C_GROUPS
C_CHUNK = 128
C_IN = 3 * C_WIDTH
N_EVEN = (DEPTH + 1) // 2
N_ODD = DEPTH // 2
EPS = 1e-6
NEG = -1e30
SCALE = HEAD_DIM ** -0.5

kernel_name = 'hybrid_swa_dilated_sgu_trunk'


def _rms(x, g):
    xf = x.astype(jnp.float32)
    y = xf * lax.rsqrt(jnp.mean(xf * xf, axis=-1, keepdims=True) + EPS)
    return y * g.astype(jnp.float32)


def _t5_bucket(dist):
    n = np.maximum(dist, 0)
    max_exact = NUM_BUCKETS // 2
    large = max_exact + (np.log(np.maximum(n, 1) / max_exact)
                         / np.log(REL_MAX_DISTANCE / max_exact)
                         * (NUM_BUCKETS - max_exact)).astype(np.int32)
    large = np.minimum(large, NUM_BUCKETS - 1)
    return np.where(n < max_exact, n, large).astype(np.int32)


def _block_dist():
    a = np.arange(BLK)[:, None]
    b = np.arange(2 * BLK)[None, :]
    return BLK + a - b


def _rel_bias_block(table, dil):
    bucket = _t5_bucket(_block_dist() * dil)
    return table.astype(jnp.float32)[bucket].transpose(2, 0, 1)


def _band_mask(nb, max_dist):
    dist = _block_dist()
    key_idx = np.arange(nb)[:, None, None] * BLK - BLK + np.arange(2 * BLK)[None, None, :]
    return (dist >= 0)[None] & (dist <= max_dist)[None] & (key_idx >= 0)


def _blocks(x, nb):
    L = x.shape[-2]
    x = jnp.pad(x, [(0, 0)] * (x.ndim - 2) + [(0, nb * BLK - L), (0, 0)])
    return x.reshape(x.shape[:-2] + (nb, BLK, x.shape[-1]))


def _with_prev(xb):
    prev = jnp.pad(xb, [(0, 0)] * (xb.ndim - 3) + [(1, 0), (0, 0), (0, 0)])[..., :-1, :, :]
    return jnp.concatenate([prev, xb], axis=-2)


def _band_parts(q, k, v, bias, max_dist):
    L = q.shape[-2]
    nb = -(-L // BLK)
    qb = _blocks(q, nb)
    kb = _with_prev(_blocks(k, nb))
    vb = _with_prev(_blocks(v, nb))
    s = jnp.einsum('bgrnqd,bgnkd->bgrnqk', qb, kb) + bias[:, :, None]
    s = jnp.where(_band_mask(nb, max_dist), s, NEG)
    m = jnp.max(s, axis=-1)
    p = jnp.exp(s - m[..., None])
    l = jnp.sum(p, axis=-1)
    u = jnp.einsum('bgrnqk,bgnkd->bgrnqd', p, vb)
    m = m.reshape(m.shape[:-2] + (nb * BLK,))[..., :L]
    l = l.reshape(l.shape[:-2] + (nb * BLK,))[..., :L]
    u = u.reshape(u.shape[:-3] + (nb * BLK, HEAD_DIM))[..., :L, :]
    return m, l, u


def _mixer_a(q, k, v, gq, gk, sinks, table):
    Bn, S, _ = q.shape
    q = _rms(q.reshape(Bn, S, A_HEADS, HEAD_DIM), gq) * SCALE
    k = _rms(k.reshape(Bn, S, A_KV_HEADS, HEAD_DIM), gk)
    v = v.reshape(Bn, S, A_KV_HEADS, HEAD_DIM).astype(jnp.float32)
    q = q.reshape(Bn, S, A_KV_HEADS, A_REP, HEAD_DIM).transpose(0, 2, 3, 1, 4)
    k = k.transpose(0, 2, 1, 3)
    v = v.transpose(0, 2, 1, 3)
    bias = _rel_bias_block(table, 1).reshape(A_KV_HEADS, A_REP, BLK, 2 * BLK)
    m, l, u = _band_parts(q, k, v, bias, A_WINDOW - 1)
    snk = sinks.astype(jnp.float32).reshape(1, A_KV_HEADS, A_REP, 1)
    mx = jnp.maximum(m, snk)
    w = jnp.exp(m - mx)
    o = u * (w / (l * w + jnp.exp(snk - mx)))[..., None]
    return o.transpose(0, 3, 1, 2, 4).reshape(Bn, S, A_WIDTH)


def _mixer_b(q, k, v, gq, gk, table):
    Bn, S, _ = q.shape
    q = (_rms(q.reshape(Bn, S, B_HEADS, HEAD_DIM), gq) * SCALE).transpose(0, 2, 1, 3)
    k = _rms(k.reshape(Bn, S, B_HEADS, HEAD_DIM), gk).transpose(0, 2, 1, 3)
    v = v.reshape(Bn, S, B_HEADS, HEAD_DIM).astype(jnp.float32).transpose(0, 2, 1, 3)
    ms, ls, us = [], [], []
    for window, dil in B_PATTERNS:
        L = S // dil
        def strided(t):
            return t.reshape(Bn, B_HEADS, L, dil, HEAD_DIM).transpose(0, 1, 3, 2, 4).reshape(Bn, B_HEADS * dil, L, HEAD_DIM)
        bias = jnp.repeat(_rel_bias_block(table, dil), dil, axis=0)[:, None]
        m, l, u = _band_parts(strided(q)[:, :, None], strided(k), strided(v), bias, window // dil)
        ms.append(m.reshape(Bn, B_HEADS, dil, L).transpose(0, 1, 3, 2).reshape(Bn, B_HEADS, S))
        ls.append(l.reshape(Bn, B_HEADS, dil, L).transpose(0, 1, 3, 2).reshape(Bn, B_HEADS, S))
        us.append(u.reshape(Bn, B_HEADS, dil, L, HEAD_DIM).transpose(0, 1, 3, 2, 4).reshape(Bn, B_HEADS, S, HEAD_DIM))
    m_all = jnp.stack(ms)
    mx = jnp.max(m_all, axis=0)
    w = jnp.exp(m_all - mx)
    num = jnp.sum(w[..., None] * jnp.stack(us), axis=0)
    den = jnp.sum(w * jnp.stack(ls), axis=0)
    o = num / den[..., None]
    return o.transpose(0, 2, 1, 3).reshape(Bn, S, B_WIDTH)


def _even_layer(x, ln_g, w_in, qk_g, sinks, w_out, rel_bias):
    h = _rms(x, ln_g).astype(x.dtype)
    z = h @ w_in
    cuts = np.cumsum([A_WIDTH, A_KV_WIDTH, A_KV_WIDTH, A_WIDTH, B_WIDTH, B_WIDTH, B_WIDTH]).tolist()
    qa, ka, va, ga, qb, kb, vb, gb = jnp.split(z, cuts, axis=-1)
    ya = _mixer_a(qa, ka, va, qk_g[0], qk_g[1], sinks, rel_bias[:, :A_HEADS])
    yb = _mixer_b(qb, kb, vb, qk_g[2], qk_g[3], rel_bias[:, A_HEADS:])
    y = jnp.concatenate([ya * jax.nn.silu(ga.astype(jnp.float32)),
                         yb * jax.nn.silu(gb.astype(jnp.float32))], axis=-1)
    return x + y.astype(x.dtype) @ w_out


def _odd_layer(x, ln_g, w_in, v_g, w_s, b_s, w_out):
    Bn, S, _ = x.shape
    h = _rms(x, ln_g).astype(x.dtype)
    z = h @ w_in
    uv = jax.nn.gelu(z[..., :2 * C_WIDTH].astype(jnp.float32), approximate=False)
    gate = jax.nn.silu(z[..., 2 * C_WIDTH:].astype(jnp.float32))
    u, v = uv[..., :C_WIDTH], uv[..., C_WIDTH:]
    v = _rms(v, v_g).reshape(Bn, S // C_CHUNK, C_CHUNK, C_GROUPS, C_GROUP_DIM)
    ws = w_s.astype(jnp.float32) * np.tril(np.ones((C_CHUNK, C_CHUNK), np.float32))
    s = jnp.einsum('gts,bnsgc->bntgc', ws, v) + b_s.astype(jnp.float32).T[:, :, None]
    y = u * s.reshape(Bn, S, C_WIDTH) * gate
    return x + y.astype(x.dtype) @ w_out


def setup_inputs(seed: int = 0) -> dict:
    key = jax.random.key(seed)
    ks = jax.random.split(key, 14)
    f32 = jnp.float32
    nrm = lambda k, shape, sc: jax.random.normal(k, shape, f32) * sc
    return {
        'x': nrm(ks[0], (BATCH, SEQ, D_MODEL), 1.0),
        'ev_ln_g': 1.0 + nrm(ks[1], (N_EVEN, D_MODEL), 0.01),
        'ev_w_in': nrm(ks[2], (N_EVEN, D_MODEL, EVEN_IN), D_MODEL ** -0.5),
        'ev_qk_g': 1.0 + nrm(ks[3], (N_EVEN, 4, HEAD_DIM), 0.01),
        'ev_sinks': nrm(ks[4], (N_EVEN, A_HEADS), 1.0),
        'ev_w_out': nrm(ks[5], (N_EVEN, EVEN_MIX, D_MODEL), EVEN_MIX ** -0.5),
        'od_ln_g': 1.0 + nrm(ks[6], (N_ODD, D_MODEL), 0.01),
        'od_w_in': nrm(ks[7], (N_ODD, D_MODEL, C_IN), D_MODEL ** -0.5),
        'od_v_g': 1.0 + nrm(ks[8], (N_ODD, C_WIDTH), 0.01),
        'od_w_s': nrm(ks[9], (N_ODD, C_GROUPS, C_CHUNK, C_CHUNK), C_CHUNK ** -0.5),
        'od_b_s': 1.0 + nrm(ks[10], (N_ODD, C_GROUPS, C_CHUNK), 0.01),
        'od_w_out': nrm(ks[11], (N_ODD, C_WIDTH, D_MODEL), C_WIDTH ** -0.5),
        'rel_bias': nrm(ks[12], (NUM_BUCKETS, N_ATTN_HEADS), 0.2),
    }


def reference(x, ev_ln_g, ev_w_in, ev_qk_g, ev_sinks, ev_w_out, od_ln_g, od_w_in,
              od_v_g, od_w_s, od_b_s, od_w_out, rel_bias):
    for i in range(DEPTH):
        j = i // 2
        if i % 2 == 0:
            x = _even_layer(x, ev_ln_g[j], ev_w_in[j], ev_qk_g[j], ev_sinks[j], ev_w_out[j], rel_bias)
        else:
            x = _odd_layer(x, od_ln_g[j], od_w_in[j], od_v_g[j], od_w_s[j], od_b_s[j], od_w_out[j])
    return x
```

```cpp
#include <hip/hip_runtime.h>
#include <cstdio>
#include <cstdint>
#define MK_ONE_LAUNCH 0

namespace pg8 {
#define PG8_LAS __attribute__((address_space(3)))
typedef unsigned short bf16_t;
typedef short bf16x8 __attribute__((ext_vector_type(8)));
typedef float f32x4 __attribute__((ext_vector_type(4)));
typedef unsigned u32x4 __attribute__((ext_vector_type(4)));
constexpr int BM = 256, BK = 64, HALF = 128, HTB = HALF * BK * 2  , STAGE_BYTES = 8 * HTB, NXCD = 8, WGM = 8;

__host__ __device__ __forceinline__ int lds_byte(int r, int c) { const int st = (r >> 4) * 2 + (c >> 5), rr = r & 15, cc = c & 31, ob = rr * 64 + cc * 2; return st * 1024 + (ob ^ (((ob >> 9) & 1) << 5)); }
__host__ __device__ __forceinline__ void stage_rc(int b, int& R, int& C) { const int st = b / 1024, sb = b % 1024, swz = sb ^ (((sb >> 9) & 1) << 5); R = (st >> 1) * 16 + swz / 64; C = (st & 1) * 32 + (swz % 64) / 2; }
__host__ __device__ __forceinline__ int perm32(int rho) { const int n = rho >> 4, i = rho & 15; return 8 * (i >> 2) + 4 * n + (i & 3); }

struct Unit { int pm, pn; };
struct Gemm { const bf16_t* A; const bf16_t* Bt; int M, N, K; };

struct StaticOrder {
    int nM, nN, nwg, G, c;
    __host__ __device__ void init(int M, int N, int G_, int c_) { nM = M / BM; nN = N / BM; nwg = nM * nN; G = G_; c = c_; }
    __host__ __device__ bool next(int i, Unit& u) const {
        const long L = (long)i * G + c; if (L >= nwg) return false;
        int wgid = (int)L; { const int q = nwg / NXCD, r = nwg % NXCD, xcd = wgid % NXCD, off = wgid / NXCD; wgid = (xcd < r ? xcd * (q + 1) : r * (q + 1) + (xcd - r) * q) + off; }
        const int nig = WGM * nN, gid = wgid / nig, fm = gid * WGM, gsz = (nM - fm) < WGM ? (nM - fm) : WGM;
        u.pm = fm + ((wgid % nig) % gsz); u.pn = (wgid % nig) / gsz; return true;
    }
    __device__ __forceinline__ void a_ready(const Unit&) const {}
    __device__ __forceinline__ void done(const Unit&) const {}
};

__device__ __forceinline__ unsigned cvt_pk_bf16(float lo, float hi) { unsigned r; asm volatile("v_cvt_pk_bf16_f32 %0, %1, %2" : "=v"(r) : "v"(lo), "v"(hi)); return r; }
typedef float f32x2 __attribute__((ext_vector_type(2)));
__device__ __forceinline__ f32x2 gelu_pk(f32x2 v) {
    const f32x2 av = __builtin_elementwise_abs(v), d = av * 0.2316418882f + 1.0f;
    f32x2 t; t.x = __builtin_amdgcn_rcpf(d.x); t.y = __builtin_amdgcn_rcpf(d.y);
    f32x2 q = t * 0.5307027145f + (-0.7265760135f); q = q * t + 0.7107068705f; q = q * t + (-0.142248368f); q = q * t + 0.127414796f; q = q * t;
    const f32x2 s = (v * v) * (-0.72134752044f);
    f32x2 e; e.x = __builtin_amdgcn_exp2f(s.x); e.y = __builtin_amdgcn_exp2f(s.y);
    const f32x2 m = v * (q * e), r = v - m;
    f32x2 o; o.x = v.x < 0.f ? m.x : r.x; o.y = v.y < 0.f ? m.y : r.y; return o;
}


__device__ __forceinline__ float silu_f(float x) { return x * __builtin_amdgcn_rcpf(1.0f + __builtin_amdgcn_exp2f(-1.4426950408889634f * x)); }
struct EpiAct {
    static constexpr bool PERM = true, AFTER_DRAIN = false;
    bf16_t* O; int ldc; int gelu_below; int silu_from;
    __device__ __forceinline__ void operator()(const f32x4 (&acc)[2][2][4][2], const Unit& u, int wr, int wc, int fr, int fq) const {
        const int row0 = u.pm * BM + wr * 64 + fr, col0 = u.pn * BM + wc * 32 + 8 * fq;
        const int mode = (u.pn < gelu_below) ? 1 : ((u.pn >= silu_from) ? 2 : 0);
#pragma unroll
        for (int ai = 0; ai < 2; ++ai)
#pragma unroll
            for (int m = 0; m < 4; ++m) { bf16_t* rowp = O + (size_t)(row0 + ai * HALF + m * 16) * ldc + col0;
#pragma unroll
                for (int bj = 0; bj < 2; ++bj) { f32x4 v0 = acc[ai][bj][m][0], v1 = acc[ai][bj][m][1];
                    if (mode == 1) { f32x2 a = gelu_pk((f32x2){v0[0], v0[1]}), b = gelu_pk((f32x2){v0[2], v0[3]}), c = gelu_pk((f32x2){v1[0], v1[1]}), d = gelu_pk((f32x2){v1[2], v1[3]});
                        v0 = (f32x4){a.x, a.y, b.x, b.y}; v1 = (f32x4){c.x, c.y, d.x, d.y}; }
                    else if (mode == 2) { v0 = (f32x4){silu_f(v0[0]), silu_f(v0[1]), silu_f(v0[2]), silu_f(v0[3])}; v1 = (f32x4){silu_f(v1[0]), silu_f(v1[1]), silu_f(v1[2]), silu_f(v1[3])}; }
                    u32x4 w; w.x = cvt_pk_bf16(v0[0], v0[1]); w.y = cvt_pk_bf16(v0[2], v0[3]); w.z = cvt_pk_bf16(v1[0], v1[1]); w.w = cvt_pk_bf16(v1[2], v1[3]);
                    *(u32x4*)(rowp + bj * HALF) = w; } }
    }
};
struct EpiRes {
    static constexpr bool PERM = false, AFTER_DRAIN = false;
    const float* base; float* out; int ldc;
    __device__ __forceinline__ void operator()(const f32x4 (&acc)[2][2][4][2], const Unit& u, int wr, int wc, int fr, int fq) const {
        const int row0 = u.pm * BM + wr * 64 + fr, col0 = u.pn * BM + wc * 32 + 4 * fq;
#pragma unroll
        for (int ai = 0; ai < 2; ++ai)
#pragma unroll
            for (int m = 0; m < 4; ++m) { const size_t off = (size_t)(row0 + ai * HALF + m * 16) * ldc + col0;
#pragma unroll
                for (int bj = 0; bj < 2; ++bj)
#pragma unroll
                    for (int n = 0; n < 2; ++n) { const f32x4 bs = *(const f32x4*)(base + off + bj * HALF + n * 16); *(f32x4*)(out + off + bj * HALF + n * 16) = bs + acc[ai][bj][m][n]; } }
    }
};

template <class Epi, class Sched, bool ALIGN_EPI = false, bool SP2 = false>
__device__ __forceinline__ void gemm_phase(PG8_LAS unsigned char* lds, const Gemm g, const Sched& S, const Epi& E, const int tid) {
    const int wid = __builtin_amdgcn_readfirstlane(tid >> 6), lane = tid & 63, wr = wid >> 2, wc = wid & 3, fr = lane & 15, fq = lane >> 4;
    const int K = g.K, nt = K / BK;
    unsigned voffA[2], voffB[2];
#pragma unroll
    for (int i = 0; i < 2; ++i) { int R, C; stage_rc(tid * 16 + i * 8192, R, C); const int Rb = Epi::PERM ? ((R & ~31) + perm32(R & 31)) : R;
        voffA[i] = (unsigned)(R * K + C) * 2u; voffB[i] = (unsigned)(Rb * K + C) * 2u; }
    const size_t kstep = (size_t)(BK * 2);
    const size_t hstep = (size_t)HALF * K * 2;
    const size_t tstep = 2 * hstep;
    const unsigned ldsw = (unsigned)wid * 1024u;
    const int aoff = lds_byte(wr * 64 + fr, fq * 8), boff = lds_byte(wc * 32 + fr, fq * 8);
#define PG8_SA(b, h) (((b) * 2 + (h)) * HTB)
#define PG8_SB(b, h) ((4 + (b) * 2 + (h)) * HTB)
#define PG8_STAGE(bufoff, gbase, voff) do { _Pragma("unroll") for (int _i = 0; _i < 2; ++_i) \
        __builtin_amdgcn_global_load_lds((const unsigned*)((const char*)(gbase) + (voff)[_i]), (PG8_LAS unsigned*)(lds + (bufoff) + ldsw + _i * 8192), 16, 0, 0); } while (0)
#define PG8_LDA(dst, b, h) do { _Pragma("unroll") for (int m = 0; m < 4; ++m) _Pragma("unroll") for (int k = 0; k < 2; ++k) dst[m][k] = *(const PG8_LAS bf16x8*)(lds + PG8_SA(b, h) + aoff + m * 2048 + k * 1024); } while (0)
#define PG8_LDB(dst, b, h) do { _Pragma("unroll") for (int n = 0; n < 2; ++n) _Pragma("unroll") for (int k = 0; k < 2; ++k) dst[n][k] = *(const PG8_LAS bf16x8*)(lds + PG8_SB(b, h) + boff + n * 2048 + k * 1024); } while (0)
#define PG8_MMA(ai, bj, At, Bt) do { __builtin_amdgcn_s_setprio(1); _Pragma("unroll") for (int m = 0; m < 4; ++m) _Pragma("unroll") for (int n = 0; n < 2; ++n) _Pragma("unroll") for (int k = 0; k < 2; ++k) \
        acc[ai][bj][m][n] = __builtin_amdgcn_mfma_f32_16x16x32_bf16(Bt[n][k], At[m][k], acc[ai][bj][m][n], 0, 0, 0); __builtin_amdgcn_s_setprio(0); } while (0)
#define PG8_WAIT_V(n) asm volatile("s_waitcnt vmcnt(" #n ")" ::: "memory")
#define PG8_WAIT_L(n) asm volatile("s_waitcnt lgkmcnt(" #n ")" ::: "memory")
#define PG8_BAR __builtin_amdgcn_s_barrier()
#define PG8_SCHED __builtin_amdgcn_sched_barrier(0)
    Unit cur, nxt; int ui = 0;
    if (!S.next(0, cur)) return;
    f32x4 acc[2][2][4][2];
#pragma unroll
    for (int a = 0; a < 2; ++a)
#pragma unroll
        for (int b = 0; b < 2; ++b)
#pragma unroll
            for (int m = 0; m < 4; ++m)
#pragma unroll
                for (int n = 0; n < 2; ++n) acc[a][b][m][n] = (f32x4){0.f, 0.f, 0.f, 0.f};
    bf16x8 At[4][2], B0[2][2], B1[2][2];
    const char* cA = (const char*)g.A + (size_t)cur.pm * tstep; const char* cB = (const char*)g.Bt + (size_t)cur.pn * tstep;
    S.a_ready(cur);
    if constexpr (SP2) {
        PG8_STAGE(PG8_SB(0, 0), cB, voffB); PG8_STAGE(PG8_SB(0, 1), cB + hstep, voffB); PG8_STAGE(PG8_SA(0, 0), cA, voffA); PG8_STAGE(PG8_SA(0, 1), cA + hstep, voffA);
        if (wr == 1) PG8_BAR;
        PG8_WAIT_V(2); PG8_BAR;
        PG8_STAGE(PG8_SB(1, 0), cB + kstep, voffB); PG8_STAGE(PG8_SA(1, 0), cA + kstep, voffA); PG8_STAGE(PG8_SB(1, 1), cB + hstep + kstep, voffB);
        PG8_WAIT_V(6); PG8_BAR;
    } else {
        PG8_STAGE(PG8_SB(0, 0), cB, voffB); PG8_STAGE(PG8_SA(0, 0), cA, voffA); PG8_STAGE(PG8_SB(0, 1), cB + hstep, voffB); PG8_STAGE(PG8_SA(0, 1), cA + hstep, voffA);
        if (wr == 1) PG8_BAR;
        PG8_WAIT_V(4); PG8_BAR;
        PG8_STAGE(PG8_SB(1, 0), cB + kstep, voffB); PG8_STAGE(PG8_SA(1, 0), cA + kstep, voffA); PG8_STAGE(PG8_SB(1, 1), cB + hstep + kstep, voffB);
        PG8_WAIT_V(6); PG8_BAR;
    }
    for (;;) {
        const bool has_next = S.next(ui + 1, nxt);
        const char* nA = has_next ? (const char*)g.A + (size_t)nxt.pm * tstep : cA; const char* nB = has_next ? (const char*)g.Bt + (size_t)nxt.pn * tstep : cB;
        for (int t = 0; t < nt; t += 2) {
            const bool last = (t == nt - 2);
            const char* a1 = cA + (size_t)(t + 1) * kstep;
            const char* a2 = last ? nA : cA + (size_t)(t + 2) * kstep; const char* b2 = last ? nB : cB + (size_t)(t + 2) * kstep;
            const char* a3 = a2 + kstep; const char* b3 = b2 + kstep;
            if (last && has_next) S.a_ready(nxt);
            if constexpr (SP2) {
            PG8_LDB(B0, 0, 0); PG8_LDB(B1, 0, 1); PG8_SCHED; PG8_LDA(At, 0, 0); PG8_STAGE(PG8_SA(1, 1), a1 + hstep, voffA);
            PG8_WAIT_V(8); PG8_WAIT_L(0); PG8_BAR; PG8_MMA(0, 0, At, B0); PG8_MMA(0, 1, At, B1); PG8_BAR; PG8_SCHED;
            PG8_LDA(At, 0, 1); PG8_STAGE(PG8_SB(0, 0), b2, voffB); PG8_STAGE(PG8_SB(0, 1), b2 + hstep, voffB); PG8_STAGE(PG8_SA(0, 0), a2, voffA);
            PG8_WAIT_V(8); PG8_WAIT_L(0); PG8_BAR; PG8_MMA(1, 0, At, B0); PG8_MMA(1, 1, At, B1); PG8_BAR; PG8_SCHED;
            PG8_LDB(B0, 1, 0); PG8_LDB(B1, 1, 1); PG8_SCHED; PG8_LDA(At, 1, 0); PG8_STAGE(PG8_SA(0, 1), a2 + hstep, voffA);
            PG8_WAIT_V(8); PG8_WAIT_L(0); PG8_BAR; PG8_MMA(0, 0, At, B0); PG8_MMA(0, 1, At, B1); PG8_BAR; PG8_SCHED;
            PG8_LDA(At, 1, 1); PG8_STAGE(PG8_SB(1, 0), b3, voffB); PG8_STAGE(PG8_SB(1, 1), b3 + hstep, voffB); PG8_STAGE(PG8_SA(1, 0), a3, voffA);
            PG8_WAIT_V(8); PG8_WAIT_L(0); PG8_BAR; PG8_MMA(1, 0, At, B0); PG8_MMA(1, 1, At, B1); PG8_BAR; PG8_SCHED;
            } else {
            PG8_LDB(B0, 0, 0); PG8_SCHED; PG8_LDA(At, 0, 0); PG8_STAGE(PG8_SA(1, 1), a1 + hstep, voffA);
            PG8_WAIT_L(8); PG8_BAR; PG8_WAIT_L(0); PG8_MMA(0, 0, At, B0); PG8_BAR; PG8_SCHED;
            PG8_LDB(B1, 0, 1); PG8_STAGE(PG8_SB(0, 0), b2, voffB);
            PG8_BAR; PG8_WAIT_L(0); PG8_MMA(0, 1, At, B1); PG8_BAR;
            PG8_LDA(At, 0, 1); PG8_STAGE(PG8_SA(0, 0), a2, voffA);
            PG8_BAR; PG8_WAIT_L(0); PG8_MMA(1, 0, At, B0); PG8_BAR; PG8_SCHED;
            PG8_STAGE(PG8_SB(0, 1), b2 + hstep, voffB);
            PG8_WAIT_V(6); PG8_BAR; PG8_MMA(1, 1, At, B1); PG8_BAR;
            PG8_LDB(B0, 1, 0); PG8_SCHED; PG8_LDA(At, 1, 0); PG8_STAGE(PG8_SA(0, 1), a2 + hstep, voffA);
            PG8_WAIT_L(8); PG8_BAR; PG8_WAIT_L(0); PG8_MMA(0, 0, At, B0); PG8_BAR; PG8_SCHED;
            PG8_LDB(B1, 1, 1); PG8_STAGE(PG8_SB(1, 0), b3, voffB);
            PG8_BAR; PG8_WAIT_L(0); PG8_MMA(0, 1, At, B1); PG8_BAR;
            PG8_LDA(At, 1, 1); PG8_STAGE(PG8_SA(1, 0), a3, voffA);
            PG8_BAR; PG8_WAIT_L(0); PG8_MMA(1, 0, At, B0); PG8_BAR; PG8_SCHED;
            PG8_STAGE(PG8_SB(1, 1), b3 + hstep, voffB);
            PG8_WAIT_V(6); PG8_BAR; PG8_MMA(1, 1, At, B1); PG8_BAR;
            }
        }
        if constexpr (ALIGN_EPI) { if (wr == 0) PG8_BAR; }
        if constexpr (!Epi::AFTER_DRAIN) { E(acc, cur, wr, wc, fr, fq); S.done(cur); }
        if (!has_next) break;
#pragma unroll
        for (int a = 0; a < 2; ++a)
#pragma unroll
            for (int b = 0; b < 2; ++b)
#pragma unroll
                for (int m = 0; m < 4; ++m)
#pragma unroll
                    for (int n = 0; n < 2; ++n) acc[a][b][m][n] = (f32x4){0.f, 0.f, 0.f, 0.f};
        cur = nxt; cA = nA; cB = nB; ++ui;
        if constexpr (ALIGN_EPI) { if (wr == 1) PG8_BAR; }
    }
    PG8_WAIT_V(0);
    if constexpr (!ALIGN_EPI) { if (wr == 0) PG8_BAR; }
    PG8_BAR;
    if constexpr (Epi::AFTER_DRAIN) { E.fused(acc, cur, wr, wc, fr, fq, lds, wid, lane); S.done(cur); }
#undef PG8_SA
#undef PG8_SB
#undef PG8_STAGE
#undef PG8_LDA
#undef PG8_LDB
#undef PG8_MMA
#undef PG8_WAIT_V
#undef PG8_WAIT_L
#undef PG8_BAR
#undef PG8_SCHED
}
}


#define GAS __attribute__((address_space(1)))
#define LAS __attribute__((address_space(3)))
typedef unsigned short bf16;
typedef unsigned v4u __attribute__((ext_vector_type(4)));
typedef float f32x4 __attribute__((ext_vector_type(4)));
typedef short bf16x8 __attribute__((ext_vector_type(8)));
typedef GAS unsigned gu32;
typedef GAS unsigned long long gu64;
#define RLX_AGENT __ATOMIC_RELAXED, __HIP_MEMORY_SCOPE_AGENT
#define LDS_WAIT() asm volatile("s_waitcnt lgkmcnt(0)" ::: "memory")
#define VM_WAIT() asm volatile("s_waitcnt vmcnt(0)" ::: "memory")
__device__ __forceinline__ unsigned long long rt() { return __builtin_amdgcn_s_memrealtime(); }
__device__ __forceinline__ unsigned f2bf(float f) { unsigned u = __builtin_bit_cast(unsigned, f); return (u + 0x7fffu + ((u >> 16) & 1u)) >> 16; }
__device__ __forceinline__ unsigned pk2(float lo, float hi) { return f2bf(lo) | (f2bf(hi) << 16); }

#define XB_TMO      128
#define XB_XCNT(j)  (256  + 64 * (j))
#define XB_XSUB(j)  (1280 + 64 * (j))
#define XB_XGEN(j)  (2304 + 64 * (j))
#define XB_TOP      3328
#define XB_TOPGEN   3392
#define XCD_BAR_WORDS 3456
#define XB_SPIN_CAP (1u << 18)

__device__ __forceinline__ unsigned xb_ld(unsigned* p)              { return __hip_atomic_load(p, __ATOMIC_RELAXED, __HIP_MEMORY_SCOPE_AGENT); }
__device__ __forceinline__ unsigned xb_add(unsigned* p, unsigned v) { return __hip_atomic_fetch_add(p, v, __ATOMIC_RELAXED, __HIP_MEMORY_SCOPE_AGENT); }
__device__ __forceinline__ unsigned xb_xcc_id() { return (unsigned)__builtin_amdgcn_s_getreg((3 << 11) | 20) & 0xFu; }
#define XB_SPIN(cond, bar) do { unsigned _sp = 0; while (cond) { __builtin_amdgcn_s_sleep(1); \
    if ((++_sp & 255u) == 0u) { if (xb_ld(&(bar)[XB_TMO])) break; if (_sp > XB_SPIN_CAP) { atomicAdd(&(bar)[XB_TMO], 1u); break; } } } } while (0)

struct XcdBarrier {
    unsigned* bar; unsigned x;
    volatile LAS unsigned* st;
};

__device__ __forceinline__ XcdBarrier xcd_barrier_post(unsigned* bar, volatile LAS unsigned* st) {
    XcdBarrier b; b.bar = bar; b.x = xb_xcc_id(); b.st = st;
    if (threadIdx.x == 0) (void)xb_add(&bar[XB_XCNT(b.x)], 1u);
    return b;
}
__device__ __forceinline__ void xcd_barrier_complete(unsigned* bar, unsigned x, unsigned& nloc, unsigned& nx) {
    const unsigned G = gridDim.x * gridDim.y * gridDim.z;
    unsigned sum, cnt, mine, sp = 0u;
    for (;;) {
        sum = 0u; cnt = 0u; mine = 0u;
#pragma unroll
        for (unsigned j = 0; j < 16; ++j) { const unsigned c = xb_ld(&bar[XB_XCNT(j)]); sum += c; cnt += (c > 0u) ? 1u : 0u; mine = (j == x) ? c : mine; }
        if (sum == G) break;
        __builtin_amdgcn_s_sleep(1);
        if ((++sp & 255u) == 0u) { if (xb_ld(&bar[XB_TMO])) break; if (sp > XB_SPIN_CAP) { atomicAdd(&bar[XB_TMO], 1u); break; } }
    }
    nloc = mine > 0u ? mine : 1u; nx = cnt > 0u ? cnt : 1u;
}

__device__ __forceinline__ void xcd_barrier(const XcdBarrier& b) {
    asm volatile("s_waitcnt vmcnt(0)" ::: "memory");
    __syncthreads();
    if (threadIdx.x == 0) {
        unsigned* bar = b.bar;
        __builtin_amdgcn_s_waitcnt(0);
        unsigned nloc = b.st[0], nx = b.st[1];
        if (nloc == 0u) { xcd_barrier_complete(bar, b.x, nloc, nx); b.st[0] = nloc; b.st[1] = nx; }
        const unsigned old = xb_add(&bar[XB_XSUB(b.x)], 1u);
        const unsigned gen = old / nloc;
        if (old + 1u == (gen + 1u) * nloc) {
            __builtin_amdgcn_fence(__ATOMIC_RELEASE, "agent");
            asm volatile("s_waitcnt vmcnt(0)" ::: "memory");
            const unsigned og = xb_add(&bar[XB_TOP], 1u);
            const unsigned tg = og / nx;
            if (og + 1u == (tg + 1u) * nx) xb_add(&bar[XB_TOPGEN], 1u);
            else XB_SPIN(xb_ld(&bar[XB_TOPGEN]) == tg, bar);
            __builtin_amdgcn_fence(__ATOMIC_ACQUIRE, "agent");
            xb_add(&bar[XB_XGEN(b.x)], 1u);
            asm volatile("s_waitcnt vmcnt(0)" ::: "memory");
        } else {
            XB_SPIN(xb_ld(&bar[XB_XGEN(b.x)]) == gen, bar);
            __builtin_amdgcn_fence(__ATOMIC_ACQUIRE, "agent");
            asm volatile("s_waitcnt vmcnt(0)" ::: "memory");
        }
    }
    __syncthreads();
}

constexpr int NWAVES = 8;
#ifndef MK_ONE_LAUNCH
#define MK_ONE_LAUNCH 1
#endif
constexpr int SEQ = 2048, DMODEL = 2048, MROWS = 8192;
constexpr int EV_IN = 6400, OD_IN = 12288, CWID = 4096;
constexpr float EPS = 1e-6f;
constexpr size_t MiB = 1u << 20;
constexpr size_t WS_CTL = 0, CTL_ZERO_BYTES = 1 * MiB;
constexpr size_t WS_EWIN = 2 * MiB, SZ_EWIN = 25 * MiB;
constexpr size_t WS_EWOUT = 52 * MiB, SZ_EWOUT = 8 * MiB;
constexpr size_t WS_OWIN = 68 * MiB, SZ_OWIN = 48 * MiB;
constexpr size_t WS_OWOUT = 164 * MiB, SZ_OWOUT = 16 * MiB;
constexpr size_t WS_XN = 196 * MiB;
constexpr size_t WS_Z = 228 * MiB;
constexpr size_t WS_Y = 420 * MiB;
constexpr size_t WS_R = 484 * MiB;
constexpr size_t WS_END = 486 * MiB;
constexpr int CW_BAR = 4096;
constexpr int RING_OFF = 0, RING_BYTES = 131072;
constexpr int LDSCTL_OFF = RING_BYTES, MISC_OFF = LDSCTL_OFF + 320;
constexpr int LDS_BYTES = 147456;
constexpr int NPHASE = 18;
enum { PH_PRO = 0, PH_G1 = 1, PH_ATT = 2, PH_VS = 3, PH_MIX = 4, PH_G2 = 5, PH_RN = 6 };

__device__ __forceinline__ float bf2f(unsigned short u) { return __uint_as_float((unsigned)u << 16); }
__device__ __forceinline__ float wave_sum(float v) {
#pragma unroll
    for (int o = 1; o < 64; o <<= 1) v += __shfl_xor(v, o);
    return v;
}
__device__ __forceinline__ float wave_max(float v) {
#pragma unroll
    for (int o = 1; o < 64; o <<= 1) v = fmaxf(v, __shfl_xor(v, o));
    return v;
}
__device__ __forceinline__ float silu1(float x) { return x * __builtin_amdgcn_rcpf(1.0f + __builtin_amdgcn_exp2f(-1.4426950408889634f * x)); }
__device__ __forceinline__ int t5_bucket(int n) {
    if (n < 16) return n;
    return 16 + (n >= 22) + (n >= 30) + (n >= 40) + (n >= 54) + (n >= 73) + (n >= 99) + (n >= 134) + (n >= 182) + (n >= 246) + (n >= 332) + (n >= 450) + (n >= 609) + (n >= 825) + (n >= 1117) + (n >= 1513);
}

struct Frame {
    LAS unsigned char* lds;
    int tid, lane, wave, vcu, G;
};

__device__ __forceinline__ void p0_transpose_item(const float* W, int K, int N, bf16* WT, LAS float* scr, int item, int lane) {
    const int nblk = N / 32, kb = item / nblk, nb = item % nblk, k0 = 64 * kb, n0 = 32 * nb;
#pragma unroll 8
    for (int i = 0; i < 32; ++i) { const int kk = 2 * i + (lane >> 5); scr[kk * 33 + (lane & 31)] = W[(size_t)(k0 + kk) * N + n0 + (lane & 31)]; }
    LDS_WAIT(); asm volatile("" ::: "memory");
    const int c = lane & 7;
#pragma unroll
    for (int j = 0; j < 4; ++j) { const int n = (lane >> 3) + 8 * j; const LAS float* s = scr + (8 * c) * 33 + n;
        v4u o; o.x = pk2(s[0 * 33], s[1 * 33]); o.y = pk2(s[2 * 33], s[3 * 33]); o.z = pk2(s[4 * 33], s[5 * 33]); o.w = pk2(s[6 * 33], s[7 * 33]);
        *(GAS v4u*)(WT + (size_t)(n0 + n) * K + k0 + 8 * c) = o; }
    LDS_WAIT(); asm volatile("" ::: "memory");
}
__device__ __forceinline__ void rms_row_to_bf16(const float* xrow, const float* g, bf16* orow, int lane) {
    const GAS f32x4* xr = (const GAS f32x4*)xrow + lane; const GAS f32x4* gr = (const GAS f32x4*)g + lane;
    f32x4 v[8]; float s = 0.f;
#pragma unroll
    for (int j = 0; j < 8; ++j) { v[j] = xr[64 * j]; s += (v[j].x * v[j].x + v[j].y * v[j].y) + (v[j].z * v[j].z + v[j].w * v[j].w); }
    const float r = 1.0f / sqrtf(wave_sum(s) * (1.f / DMODEL) + EPS);
    GAS unsigned long long* o8 = (GAS unsigned long long*)orow + lane;
#pragma unroll
    for (int j = 0; j < 8; ++j) { const f32x4 gg = gr[64 * j];
        o8[64 * j] = (unsigned long long)pk2(v[j].x * r * gg.x, v[j].y * r * gg.y) | ((unsigned long long)pk2(v[j].z * r * gg.z, v[j].w * r * gg.w) << 32); }
}
__device__ __forceinline__ void ph_rmsnorm(Frame& F, const float* x, const float* g, bf16* xn) {
    const int gw = F.vcu * NWAVES + F.wave, NGW = F.G * NWAVES;
    for (int m = gw; m < MROWS; m += NGW) rms_row_to_bf16(x + (size_t)m * DMODEL, g, xn + (size_t)m * DMODEL, F.lane);
}
struct Weights { const float *ev_w_in, *ev_w_out, *od_w_in, *od_w_out; };
__device__ __forceinline__ void ph_prologue(Frame& F, const Weights& W, unsigned char* ws, const float* x, const float* g0) {
    LAS float* scr = (LAS float*)(F.lds + RING_OFF + F.wave * 16384);
    const int gw = F.vcu * NWAVES + F.wave, NGW = F.G * NWAVES;
    constexpr int I_EI = (DMODEL / 64) * (EV_IN / 32), I_EO = (DMODEL / 64) * (DMODEL / 32), I_OI = (DMODEL / 64) * (OD_IN / 32), I_OO = (CWID / 64) * (DMODEL / 32);
    constexpr int I_PAIR = I_EI + I_EO + I_OI + I_OO, NITEMS = 2 * I_PAIR;
    for (int it = gw; it < NITEMS; it += NGW) {
        const int j = it / I_PAIR; int r = it % I_PAIR;
        if (r < I_EI) { p0_transpose_item(W.ev_w_in + (size_t)j * DMODEL * EV_IN, DMODEL, EV_IN, (bf16*)(ws + WS_EWIN + j * SZ_EWIN), scr, r, F.lane); continue; } r -= I_EI;
        if (r < I_EO) { p0_transpose_item(W.ev_w_out + (size_t)j * DMODEL * DMODEL, DMODEL, DMODEL, (bf16*)(ws + WS_EWOUT + j * SZ_EWOUT), scr, r, F.lane); continue; } r -= I_EO;
        if (r < I_OI) { p0_transpose_item(W.od_w_in + (size_t)j * DMODEL * OD_IN, DMODEL, OD_IN, (bf16*)(ws + WS_OWIN + j * SZ_OWIN), scr, r, F.lane); continue; } r -= I_OI;
        p0_transpose_item(W.od_w_out + (size_t)j * CWID * DMODEL, CWID, DMODEL, (bf16*)(ws + WS_OWOUT + j * SZ_OWOUT), scr, r, F.lane);
    }
    ph_rmsnorm(F, x, g0, (bf16*)(ws + WS_XN));
}

__device__ __forceinline__ float att_score(const bf16* Z, const float (&qr)[64], const float* relb, int b, int t, int hh, int kcol, int dil, int j0, int maxj, int lane) {
    const int j = j0 + lane, kpos = t - j * dil;
    float s = -1e30f;
    if (j <= maxj && kpos >= 0) {
        const GAS v4u* kp = (const GAS v4u*)(Z + (size_t)(b * SEQ + kpos) * EV_IN + kcol);
        float dot = 0.f, ss = 0.f;
#pragma unroll
        for (int i = 0; i < 8; ++i) { const v4u w = kp[i];
            const float f0 = __uint_as_float(w.x << 16), f1 = __uint_as_float(w.x & 0xffff0000u), f2 = __uint_as_float(w.y << 16), f3 = __uint_as_float(w.y & 0xffff0000u);
            const float f4 = __uint_as_float(w.z << 16), f5 = __uint_as_float(w.z & 0xffff0000u), f6 = __uint_as_float(w.w << 16), f7 = __uint_as_float(w.w & 0xffff0000u);
            dot += qr[8 * i] * f0 + qr[8 * i + 1] * f1 + qr[8 * i + 2] * f2 + qr[8 * i + 3] * f3 + qr[8 * i + 4] * f4 + qr[8 * i + 5] * f5 + qr[8 * i + 6] * f6 + qr[8 * i + 7] * f7;
            ss += f0 * f0 + f1 * f1 + f2 * f2 + f3 * f3 + f4 * f4 + f5 * f5 + f6 * f6 + f7 * f7; }
        s = dot * (1.0f / sqrtf(ss * (1.f / 64.f) + EPS)) + relb[t5_bucket(j * dil) * 32 + hh];
    }
    return s;
}
__device__ __forceinline__ void att_pv(const bf16* Z, float (&o)[8], float pc, int b, int t, int vcol, int dil, int j0, int lane) {
    const int kg = lane >> 3, db = lane & 7;
#pragma unroll
    for (int i = 0; i < 8; ++i) { const int kk = 8 * i + kg; const float p = __shfl(pc, kk); const int kpos = t - (j0 + kk) * dil;
        if (p != 0.f && kpos >= 0) { const v4u w = *(const GAS v4u*)(Z + (size_t)(b * SEQ + kpos) * EV_IN + vcol + db * 8);
            o[0] += p * __uint_as_float(w.x << 16); o[1] += p * __uint_as_float(w.x & 0xffff0000u); o[2] += p * __uint_as_float(w.y << 16); o[3] += p * __uint_as_float(w.y & 0xffff0000u);
            o[4] += p * __uint_as_float(w.z << 16); o[5] += p * __uint_as_float(w.z & 0xffff0000u); o[6] += p * __uint_as_float(w.w << 16); o[7] += p * __uint_as_float(w.w & 0xffff0000u); } }
}
__device__ __forceinline__ void ph_attn_simple(Frame& F, const bf16* Z, bf16* Y, const float* qkg, const float* sinks, const float* relb) {
    LAS float* scr = (LAS float*)(F.lds + RING_OFF + F.wave * 1024);
    const int gw = F.vcu * NWAVES + F.wave, NGW = F.G * NWAVES, lane = F.lane;
    for (int task = gw; task < MROWS * 32; task += NGW) {
        const int m = task >> 5, hh = task & 31, b = m >> 11, t = m & 2047;
        const bool isB = hh >= 16; const int h = hh & 15;
        const int qcol = isB ? 2304 + h * 64 : h * 64;
        const int kcol = isB ? 3328 + h * 64 : 1024 + (h >> 3) * 64;
        const int vcol = isB ? 4352 + h * 64 : 1152 + (h >> 3) * 64;
        const int gcol = isB ? 5376 + h * 64 : 1280 + h * 64;
        const float* gq = qkg + (isB ? 128 : 0); const float* gk = qkg + (isB ? 192 : 64);
        const bf16* zrow = Z + (size_t)m * EV_IN;
        const float qv = bf2f(zrow[qcol + lane]);
        const float rq = 1.0f / sqrtf(wave_sum(qv * qv) * (1.f / 64.f) + EPS);
        scr[lane] = qv * rq * gq[lane] * 0.125f * gk[lane];
        LDS_WAIT(); asm volatile("" ::: "memory");
        float qr[64];
#pragma unroll
        for (int i = 0; i < 16; ++i) { const f32x4 q4 = ((const LAS f32x4*)scr)[i]; qr[4 * i] = q4.x; qr[4 * i + 1] = q4.y; qr[4 * i + 2] = q4.z; qr[4 * i + 3] = q4.w; }
        LDS_WAIT(); asm volatile("" ::: "memory");
        float s0, s1, s2 = -1e30f, s3 = -1e30f, s4 = -1e30f, s5 = -1e30f, s6 = -1e30f, s7 = -1e30f;
        if (!isB) { s0 = att_score(Z, qr, relb, b, t, hh, kcol, 1, 0, 127, lane); s1 = att_score(Z, qr, relb, b, t, hh, kcol, 1, 64, 127, lane); }
        else { s0 = att_score(Z, qr, relb, b, t, hh, kcol, 1, 0, 128, lane); s1 = att_score(Z, qr, relb, b, t, hh, kcol, 1, 64, 128, lane); s2 = att_score(Z, qr, relb, b, t, hh, kcol, 1, 128, 128, lane);
               s3 = att_score(Z, qr, relb, b, t, hh, kcol, 4, 0, 128, lane); s4 = att_score(Z, qr, relb, b, t, hh, kcol, 4, 64, 128, lane); s5 = att_score(Z, qr, relb, b, t, hh, kcol, 4, 128, 128, lane);
               s6 = att_score(Z, qr, relb, b, t, hh, kcol, 16, 0, 128, lane); s7 = att_score(Z, qr, relb, b, t, hh, kcol, 16, 64, 128, lane); }
        const float mx = wave_max(fmaxf(fmaxf(fmaxf(s0, s1), fmaxf(s2, s3)), fmaxf(fmaxf(s4, s5), fmaxf(s6, s7))));
        const float p0 = __expf(s0 - mx), p1 = __expf(s1 - mx), p2 = __expf(s2 - mx), p3 = __expf(s3 - mx), p4 = __expf(s4 - mx), p5 = __expf(s5 - mx), p6 = __expf(s6 - mx), p7 = __expf(s7 - mx);
        const float l = wave_sum(((p0 + p1) + (p2 + p3)) + ((p4 + p5) + (p6 + p7)));
        float o[8] = {0.f, 0.f, 0.f, 0.f, 0.f, 0.f, 0.f, 0.f};
        att_pv(Z, o, p0, b, t, vcol, 1, 0, lane); att_pv(Z, o, p1, b, t, vcol, 1, 64, lane);
        if (isB) { att_pv(Z, o, p2, b, t, vcol, 1, 128, lane); att_pv(Z, o, p3, b, t, vcol, 4, 0, lane); att_pv(Z, o, p4, b, t, vcol, 4, 64, lane); att_pv(Z, o, p5, b, t, vcol, 4, 128, lane);
                   att_pv(Z, o, p6, b, t, vcol, 16, 0, lane); att_pv(Z, o, p7, b, t, vcol, 16, 64, lane); }
#pragma unroll
        for (int e = 0; e < 8; ++e) { o[e] += __shfl_xor(o[e], 8); o[e] += __shfl_xor(o[e], 16); o[e] += __shfl_xor(o[e], 32); }
        float scale;
        if (!isB) { const float snk = sinks[h], m2 = fmaxf(mx, snk), w = __expf(mx - m2); scale = w / (l * w + __expf(snk - m2)); } else scale = 1.0f / l;
        if (lane < 8) { const v4u gw4 = *(const GAS v4u*)(zrow + gcol + lane * 8);
            const float g0 = silu1(__uint_as_float(gw4.x << 16)), g1 = silu1(__uint_as_float(gw4.x & 0xffff0000u)), g2 = silu1(__uint_as_float(gw4.y << 16)), g3 = silu1(__uint_as_float(gw4.y & 0xffff0000u));
            const float g4 = silu1(__uint_as_float(gw4.z << 16)), g5 = silu1(__uint_as_float(gw4.z & 0xffff0000u)), g6 = silu1(__uint_as_float(gw4.w << 16)), g7 = silu1(__uint_as_float(gw4.w & 0xffff0000u));
            v4u ov; ov.x = pk2(o[0] * scale * g0, o[1] * scale * g1); ov.y = pk2(o[2] * scale * g2, o[3] * scale * g3); ov.z = pk2(o[4] * scale * g4, o[5] * scale * g5); ov.w = pk2(o[6] * scale * g6, o[7] * scale * g7);
            *(GAS v4u*)(Y + (size_t)m * DMODEL + (isB ? 1024 : 0) + h * 64 + lane * 8) = ov; }
    }
}

__device__ __forceinline__ void ph_vscale(Frame& F, const bf16* Z, float* R) {
    const int gw = F.vcu * NWAVES + F.wave, NGW = F.G * NWAVES;
    for (int m = gw; m < MROWS; m += NGW) { const GAS v4u* vp = (const GAS v4u*)(Z + (size_t)m * OD_IN + CWID) + F.lane; float s = 0.f;
#pragma unroll
        for (int j = 0; j < 8; ++j) { const v4u w = vp[64 * j];
            const float f0 = __uint_as_float(w.x << 16), f1 = __uint_as_float(w.x & 0xffff0000u), f2 = __uint_as_float(w.y << 16), f3 = __uint_as_float(w.y & 0xffff0000u);
            const float f4 = __uint_as_float(w.z << 16), f5 = __uint_as_float(w.z & 0xffff0000u), f6 = __uint_as_float(w.w << 16), f7 = __uint_as_float(w.w & 0xffff0000u);
            s += (f0 * f0 + f1 * f1) + (f2 * f2 + f3 * f3) + (f4 * f4 + f5 * f5) + (f6 * f6 + f7 * f7); }
        s = wave_sum(s);
        if (F.lane == 0) R[m] = 1.0f / sqrtf(s * (1.f / CWID) + EPS); }
}
__device__ __forceinline__ void ph_mix_simple(Frame& F, const bf16* Z, bf16* Y, const float* R, const float* vg, const float* wsp, const float* bsp) {
    LAS float* vn = (LAS float*)(F.lds + RING_OFF); LAS float* wm = (LAS float*)(F.lds + RING_OFF + 65536);
    const int tid = F.tid;
    for (int task = F.vcu; task < 64 * 16 * 2; task += F.G) {
        const int hf = task & 1, g = (task >> 1) & 15, ch = task >> 5, row0 = ch * 128, c0 = g * 256 + hf * 128;
        for (int k = 0; k < 32; ++k) { const int idx = tid + 512 * k, s = idx >> 7, cc = idx & 127;
            vn[idx] = bf2f(Z[(size_t)(row0 + s) * OD_IN + CWID + c0 + cc]) * R[row0 + s] * vg[c0 + cc];
            wm[idx] = wsp[(size_t)g * 16384 + idx]; }
        __syncthreads();
        const int tg = F.wave >> 1, c = (F.wave & 1) * 64 + F.lane;
        for (int i = 0; i < 32; ++i) { const int t = tg + 4 * i; float acc = 0.f;
            for (int s = 0; s <= t; ++s) acc += wm[t * 128 + s] * vn[s * 128 + c];
            const size_t zo = (size_t)(row0 + t) * OD_IN + c0 + c;
            const float u = bf2f(Z[zo]), gt = bf2f(Z[zo + 2 * CWID]);
            Y[(size_t)(row0 + t) * CWID + c0 + c] = (bf16)f2bf(u * (acc + bsp[g * 128 + t]) * gt); }
        __syncthreads();
    }
}

struct Args { const float* in[13]; float* out; unsigned char* ws; int ph_lo, ph_hi; };
__global__ void __launch_bounds__(NWAVES * 64, 2) skel_fwd(Args args) {
    extern __shared__ __attribute__((aligned(16))) unsigned char lds[];
    Frame F;
    F.lds = (LAS unsigned char*)lds;
    F.tid = threadIdx.x;
    F.G = gridDim.x; { const int bx = blockIdx.x; F.vcu = (F.G % 8 == 0) ? (bx % 8) * (F.G / 8) + bx / 8 : bx; }
    unsigned char* ws = args.ws;
    gu32* ctl = (gu32*)(ws + WS_CTL);
    for (int u = F.tid; u < (LDS_BYTES - LDSCTL_OFF) / 4; u += NWAVES * 64) ((LAS unsigned*)(F.lds + LDSCTL_OFF))[u] = 0u;
    __syncthreads();
    const int lo = args.ph_lo, hi = args.ph_hi;
    XcdBarrier bar; bar.bar = (unsigned*)(ctl + CW_BAR); bar.x = 0; bar.st = nullptr;
    if (hi - lo > 1) bar = xcd_barrier_post((unsigned*)(ctl + CW_BAR), (volatile LAS unsigned*)(F.lds + MISC_OFF) + 8);
    const float* x_in = args.in[0];
    const float *ev_ln_g = args.in[1], *ev_w_in = args.in[2], *ev_qk_g = args.in[3], *ev_sinks = args.in[4], *ev_w_out = args.in[5];
    const float *od_ln_g = args.in[6], *od_w_in = args.in[7], *od_v_g = args.in[8], *od_w_s = args.in[9], *od_b_s = args.in[10], *od_w_out = args.in[11], *rel_bias = args.in[12];
    float* out = args.out;
    bf16* XN = (bf16*)(ws + WS_XN); bf16* Z = (bf16*)(ws + WS_Z); bf16* Y = (bf16*)(ws + WS_Y); float* R = (float*)(ws + WS_R);

    for (int p = lo; p < hi; ++p) {
        { int t_ = threadIdx.x; asm volatile("" : "+v"(t_)); F.tid = t_; F.lane = t_ & 63; F.wave = __builtin_amdgcn_readfirstlane(t_ >> 6); }
        int kind, layer;
        if (p == 0) { kind = PH_PRO; layer = 0; }
        else { const int q = p - 1, pair = q / 9, r = q % 9;
            if (r < 4) { layer = 2 * pair; kind = (r == 0) ? PH_G1 : (r == 1) ? PH_ATT : (r == 2) ? PH_G2 : PH_RN; }
            else { layer = 2 * pair + 1; kind = (r == 4) ? PH_G1 : (r == 5) ? PH_VS : (r == 6) ? PH_MIX : (r == 7) ? PH_G2 : PH_RN; } }
        const int j = layer >> 1; const bool odd = (layer & 1) != 0;
        if (kind == PH_PRO) {
            Weights W{ev_w_in, ev_w_out, od_w_in, od_w_out};
            ph_prologue(F, W, ws, x_in, ev_ln_g);
        } else if (kind == PH_G1) {
            pg8::Gemm g{XN, odd ? (const bf16*)(ws + WS_OWIN + j * SZ_OWIN) : (const bf16*)(ws + WS_EWIN + j * SZ_EWIN), MROWS, odd ? OD_IN : EV_IN, DMODEL};
            pg8::StaticOrder S; S.init(g.M, g.N, F.G, (int)blockIdx.x);
            pg8::EpiAct E{Z, g.N, odd ? 32 : 0, odd ? 32 : 1000000};
            pg8::gemm_phase<pg8::EpiAct, pg8::StaticOrder, true, true>(F.lds + RING_OFF, g, S, E, F.tid);
        } else if (kind == PH_G2) {
            pg8::Gemm g{Y, odd ? (const bf16*)(ws + WS_OWOUT + j * SZ_OWOUT) : (const bf16*)(ws + WS_EWOUT + j * SZ_EWOUT), MROWS, DMODEL, odd ? CWID : DMODEL};
            pg8::StaticOrder S; S.init(g.M, g.N, F.G, (int)blockIdx.x);
            pg8::EpiRes E{layer == 0 ? x_in : (const float*)out, out, DMODEL};
            pg8::gemm_phase<pg8::EpiRes, pg8::StaticOrder, true, true>(F.lds + RING_OFF, g, S, E, F.tid);
        } else if (kind == PH_ATT) {
            ph_attn_simple(F, Z, Y, ev_qk_g + j * 256, ev_sinks + j * 16, rel_bias);
        } else if (kind == PH_VS) {
            ph_vscale(F, Z, R);
        } else if (kind == PH_MIX) {
            ph_mix_simple(F, Z, Y, R, od_v_g + j * CWID, od_w_s + (size_t)j * 16 * 16384, od_b_s + j * 2048);
        } else {
            const int nl = layer + 1, nj = nl >> 1;
            ph_rmsnorm(F, out, (nl & 1) ? od_ln_g + nj * DMODEL : ev_ln_g + nj * DMODEL, XN);
        }
        if (p + 1 < hi) xcd_barrier(bar);
    }
}

extern "C" void kernel_launch(void* const* d_in, const int* in_sizes, int n_in, void* d_out, int out_size, void* d_ws, size_t ws_size, hipStream_t stream) {
    static int grid = 0;
    if (grid == 0) {
        if (n_in != 13 || out_size != MROWS * DMODEL || ws_size < WS_END) { fprintf(stderr, "kernel_launch: unexpected shapes (n_in %d out %d ws %zu)\n", n_in, out_size, ws_size); grid = -1; return; }
        int dev = 0, cus = 0;
        if (hipGetDevice(&dev) != hipSuccess || hipDeviceGetAttribute(&cus, hipDeviceAttributeMultiprocessorCount, dev) != hipSuccess) { grid = -1; return; }
        if (hipFuncSetAttribute((const void*)skel_fwd, hipFuncAttributeMaxDynamicSharedMemorySize, LDS_BYTES) != hipSuccess) { fprintf(stderr, "kernel_launch: hipFuncSetAttribute failed\n"); grid = -1; return; }
        int per_cu = 0;
        (void)hipOccupancyMaxActiveBlocksPerMultiprocessor(&per_cu, (const void*)skel_fwd, NWAVES * 64, LDS_BYTES);
        (void)hipGetLastError();
        grid = cus;
    }
    if (grid < 0) return;
    (void)hipMemsetAsync((char*)d_ws + WS_CTL, 0, CTL_ZERO_BYTES, stream);
    Args a{};
    for (int i = 0; i < 13; ++i) a.in[i] = (const float*)d_in[i];
    a.out = (float*)d_out; a.ws = (unsigned char*)d_ws;
#if MK_ONE_LAUNCH
    a.ph_lo = 0; a.ph_hi = NPHASE;
    hipLaunchKernelGGL(skel_fwd, dim3(grid), dim3(NWAVES * 64), LDS_BYTES, stream, a);
#else
    for (int p = 0; p < NPHASE; ++p) { a.ph_lo = p; a.ph_hi = p + 1; hipLaunchKernelGGL(skel_fwd, dim3(grid), dim3(NWAVES * 64), LDS_BYTES, stream, a); }
#endif
}
```

```cpp
#include <hip/hip_runtime.h>
#include <cstdio>
#include <cstdint>
#define MK_ONE_LAUNCH 1
#define DUP_MASK 0

namespace pg8 {
#define PG8_LAS __attribute__((address_space(3)))
typedef unsigned short bf16_t;
typedef short bf16x8 __attribute__((ext_vector_type(8)));
typedef float f32x4 __attribute__((ext_vector_type(4)));
typedef unsigned u32x4 __attribute__((ext_vector_type(4)));
constexpr int BM = 256, BK = 64, HALF = 128, HTB = HALF * BK * 2  , STAGE_BYTES = 8 * HTB, NXCD = 8, WGM = 8;

__host__ __device__ __forceinline__ int lds_byte(int r, int c) { const int st = (r >> 4) * 2 + (c >> 5), rr = r & 15, cc = c & 31, ob = rr * 64 + cc * 2; return st * 1024 + (ob ^ (((ob >> 9) & 1) << 5)); }
__host__ __device__ __forceinline__ void stage_rc(int b, int& R, int& C) { const int st = b / 1024, sb = b % 1024, swz = sb ^ (((sb >> 9) & 1) << 5); R = (st >> 1) * 16 + swz / 64; C = (st & 1) * 32 + (swz % 64) / 2; }
__host__ __device__ __forceinline__ int perm32(int rho) { const int n = rho >> 4, i = rho & 15; return 8 * (i >> 2) + 4 * n + (i & 3); }

struct Unit { int pm, pn; };
struct Gemm { const bf16_t* A; const bf16_t* Bt; int M, N, K; };

struct StaticOrder {
    int nM, nN, nwg, G, c;
    __host__ __device__ void init(int M, int N, int G_, int c_) { nM = M / BM; nN = N / BM; nwg = nM * nN; G = G_; c = c_; }
    __host__ __device__ bool next(int i, Unit& u) const {
        const long L = (long)i * G + c; if (L >= nwg) return false;
        int wgid = (int)L; { const int q = nwg / NXCD, r = nwg % NXCD, xcd = wgid % NXCD, off = wgid / NXCD; wgid = (xcd < r ? xcd * (q + 1) : r * (q + 1) + (xcd - r) * q) + off; }
        const int nig = WGM * nN, gid = wgid / nig, fm = gid * WGM, gsz = (nM - fm) < WGM ? (nM - fm) : WGM;
        u.pm = fm + ((wgid % nig) % gsz); u.pn = (wgid % nig) / gsz; return true;
    }
    __device__ __forceinline__ void a_ready(const Unit&) const {}
    __device__ __forceinline__ void done(const Unit&) const {}
};

__device__ __forceinline__ unsigned cvt_pk_bf16(float lo, float hi) { unsigned r; asm volatile("v_cvt_pk_bf16_f32 %0, %1, %2" : "=v"(r) : "v"(lo), "v"(hi)); return r; }
typedef float f32x2 __attribute__((ext_vector_type(2)));
__device__ __forceinline__ f32x2 gelu_pk(f32x2 v) {
    const f32x2 av = __builtin_elementwise_abs(v), d = av * 0.2316418882f + 1.0f;
    f32x2 t; t.x = __builtin_amdgcn_rcpf(d.x); t.y = __builtin_amdgcn_rcpf(d.y);
    f32x2 q = t * 0.5307027145f + (-0.7265760135f); q = q * t + 0.7107068705f; q = q * t + (-0.142248368f); q = q * t + 0.127414796f; q = q * t;
    const f32x2 s = (v * v) * (-0.72134752044f);
    f32x2 e; e.x = __builtin_amdgcn_exp2f(s.x); e.y = __builtin_amdgcn_exp2f(s.y);
    const f32x2 m = v * (q * e), r = v - m;
    f32x2 o; o.x = v.x < 0.f ? m.x : r.x; o.y = v.y < 0.f ? m.y : r.y; return o;
}


__device__ __forceinline__ float silu_f(float x) { return x * __builtin_amdgcn_rcpf(1.0f + __builtin_amdgcn_exp2f(-1.4426950408889634f * x)); }
struct EpiAct {
    static constexpr bool PERM = true, AFTER_DRAIN = false;
    bf16_t* O; int ldc; int gelu_below; int silu_from;
    __device__ __forceinline__ void operator()(const f32x4 (&acc)[2][2][4][2], const Unit& u, int wr, int wc, int fr, int fq) const {
        const int row0 = u.pm * BM + wr * 64 + fr, col0 = u.pn * BM + wc * 32 + 8 * fq;
        const int mode = (u.pn < gelu_below) ? 1 : ((u.pn >= silu_from) ? 2 : 0);
#pragma unroll
        for (int ai = 0; ai < 2; ++ai)
#pragma unroll
            for (int m = 0; m < 4; ++m) { bf16_t* rowp = O + (size_t)(row0 + ai * HALF + m * 16) * ldc + col0;
#pragma unroll
                for (int bj = 0; bj < 2; ++bj) { f32x4 v0 = acc[ai][bj][m][0], v1 = acc[ai][bj][m][1];
                    if (mode == 1) { f32x2 a = gelu_pk((f32x2){v0[0], v0[1]}), b = gelu_pk((f32x2){v0[2], v0[3]}), c = gelu_pk((f32x2){v1[0], v1[1]}), d = gelu_pk((f32x2){v1[2], v1[3]});
                        v0 = (f32x4){a.x, a.y, b.x, b.y}; v1 = (f32x4){c.x, c.y, d.x, d.y}; }
                    else if (mode == 2) { v0 = (f32x4){silu_f(v0[0]), silu_f(v0[1]), silu_f(v0[2]), silu_f(v0[3])}; v1 = (f32x4){silu_f(v1[0]), silu_f(v1[1]), silu_f(v1[2]), silu_f(v1[3])}; }
                    u32x4 w; w.x = cvt_pk_bf16(v0[0], v0[1]); w.y = cvt_pk_bf16(v0[2], v0[3]); w.z = cvt_pk_bf16(v1[0], v1[1]); w.w = cvt_pk_bf16(v1[2], v1[3]);
                    *(u32x4*)(rowp + bj * HALF) = w; } }
    }
};
struct EpiRes {
    static constexpr bool PERM = false, AFTER_DRAIN = false;
    const float* base; float* out; int ldc;
    __device__ __forceinline__ void operator()(const f32x4 (&acc)[2][2][4][2], const Unit& u, int wr, int wc, int fr, int fq) const {
        const int row0 = u.pm * BM + wr * 64 + fr, col0 = u.pn * BM + wc * 32 + 4 * fq;
#pragma unroll
        for (int ai = 0; ai < 2; ++ai)
#pragma unroll
            for (int m = 0; m < 4; ++m) { const size_t off = (size_t)(row0 + ai * HALF + m * 16) * ldc + col0;
#pragma unroll
                for (int bj = 0; bj < 2; ++bj)
#pragma unroll
                    for (int n = 0; n < 2; ++n) { const f32x4 bs = *(const f32x4*)(base + off + bj * HALF + n * 16); *(f32x4*)(out + off + bj * HALF + n * 16) = bs + acc[ai][bj][m][n]; } }
    }
};

struct EpiQKV {
    static constexpr bool PERM = true, AFTER_DRAIN = false;
    bf16_t* O; int ldc; const float* qkg; const float* ssx;
    __device__ __forceinline__ void operator()(const f32x4 (&acc)[2][2][4][2], const Unit& u, int wr, int wc, int fr, int fq) const {
        const int row0 = u.pm * BM + wr * 64 + fr, colw = u.pn * BM + wc * 64;
        int mode = 0; const float* gv = qkg; float sc = 1.f;
        if (colw < 1024) { mode = 1; gv = qkg; sc = 0.125f * 1.4426950408889634f; }
        else if (colw < 1152) { mode = 1; gv = qkg + 64; }
        else if (colw < 1280) { mode = 0; }
        else if (colw < 2304) { mode = 2; }
        else if (colw < 3328) { mode = 1; gv = qkg + 128; sc = 0.125f * 1.4426950408889634f; }
        else if (colw < 4352) { mode = 1; gv = qkg + 192; }
        else if (colw < 5376) { mode = 0; }
        else { mode = 2; }
        f32x4 gg[2][2];
#pragma unroll
        for (int bj = 0; bj < 2; ++bj)
#pragma unroll
            for (int n = 0; n < 2; ++n) gg[bj][n] = (mode == 1) ? *(const f32x4*)(gv + 32 * bj + 8 * fq + 4 * n) * sc : (f32x4){1.f, 1.f, 1.f, 1.f};
#pragma unroll
        for (int ai = 0; ai < 2; ++ai)
#pragma unroll
            for (int m = 0; m < 4; ++m) { bf16_t* rowp = O + (size_t)(row0 + ai * HALF + m * 16) * ldc + colw + 8 * fq;
                f32x4 v[2][2];
                const float rx = __builtin_amdgcn_rsqf(ssx[row0 + ai * HALF + m * 16] * (1.f / 2048.f) + 1e-6f);
#pragma unroll
                for (int bj = 0; bj < 2; ++bj)
#pragma unroll
                    for (int n = 0; n < 2; ++n) v[bj][n] = acc[ai][bj][m][n] * rx;
                if (mode == 1) { float ss = 0.f;
#pragma unroll
                    for (int bj = 0; bj < 2; ++bj)
#pragma unroll
                        for (int n = 0; n < 2; ++n) ss += (v[bj][n][0] * v[bj][n][0] + v[bj][n][1] * v[bj][n][1]) + (v[bj][n][2] * v[bj][n][2] + v[bj][n][3] * v[bj][n][3]);
                    ss += __shfl_xor(ss, 16); ss += __shfl_xor(ss, 32);
                    const float r = __builtin_amdgcn_rsqf(ss * (1.f / 64.f) + 1e-6f);
#pragma unroll
                    for (int bj = 0; bj < 2; ++bj)
#pragma unroll
                        for (int n = 0; n < 2; ++n) v[bj][n] = v[bj][n] * r * gg[bj][n]; }
                else if (mode == 2) {
#pragma unroll
                    for (int bj = 0; bj < 2; ++bj)
#pragma unroll
                        for (int n = 0; n < 2; ++n) v[bj][n] = (f32x4){silu_f(v[bj][n][0]), silu_f(v[bj][n][1]), silu_f(v[bj][n][2]), silu_f(v[bj][n][3])}; }
#pragma unroll
                for (int bj = 0; bj < 2; ++bj) { u32x4 w; w.x = cvt_pk_bf16(v[bj][0][0], v[bj][0][1]); w.y = cvt_pk_bf16(v[bj][0][2], v[bj][0][3]); w.z = cvt_pk_bf16(v[bj][1][0], v[bj][1][1]); w.w = cvt_pk_bf16(v[bj][1][2], v[bj][1][3]);
                    *(u32x4*)(rowp + 32 * bj) = w; } }
    }
};

struct EpiOdd {
    static constexpr bool PERM = true, AFTER_DRAIN = false;
    bf16_t* UG; bf16_t* V; const float* ssx; float* ssv;
    __device__ __forceinline__ void operator()(const f32x4 (&acc)[2][2][4][2], const Unit& u, int wr, int wc, int fr, int fq) const {
        const int row0 = u.pm * BM + wr * 64 + fr;
        if (u.pn < 32) {
#pragma unroll
            for (int ai = 0; ai < 2; ++ai)
#pragma unroll
                for (int m = 0; m < 4; ++m) { const int row = row0 + ai * HALF + m * 16;
                    const float rx = __builtin_amdgcn_rsqf(ssx[row] * (1.f / 2048.f) + 1e-6f);
                    f32x4 o[2];
#pragma unroll
                    for (int n = 0; n < 2; ++n) { const f32x4 uu = acc[ai][0][m][n] * rx, gt = acc[ai][1][m][n] * rx;
                        const f32x2 a = gelu_pk((f32x2){uu[0], uu[1]}), b = gelu_pk((f32x2){uu[2], uu[3]});
                        o[n] = (f32x4){a.x * silu_f(gt[0]), a.y * silu_f(gt[1]), b.x * silu_f(gt[2]), b.y * silu_f(gt[3])}; }
                    u32x4 w; w.x = cvt_pk_bf16(o[0][0], o[0][1]); w.y = cvt_pk_bf16(o[0][2], o[0][3]); w.z = cvt_pk_bf16(o[1][0], o[1][1]); w.w = cvt_pk_bf16(o[1][2], o[1][3]);
                    *(u32x4*)(UG + (size_t)row * 4096 + u.pn * 128 + wc * 32 + 8 * fq) = w; }
        } else {
            const int colb = (u.pn - 32) * 256 + wc * 32 + 8 * fq;
#pragma unroll
            for (int ai = 0; ai < 2; ++ai)
#pragma unroll
                for (int m = 0; m < 4; ++m) { const int row = row0 + ai * HALF + m * 16;
                    const float rx = __builtin_amdgcn_rsqf(ssx[row] * (1.f / 2048.f) + 1e-6f);
                    float ss = 0.f;
#pragma unroll
                    for (int bj = 0; bj < 2; ++bj) { const f32x4 v0 = acc[ai][bj][m][0] * rx, v1 = acc[ai][bj][m][1] * rx;
                        const f32x2 a = gelu_pk((f32x2){v0[0], v0[1]}), b = gelu_pk((f32x2){v0[2], v0[3]}), c = gelu_pk((f32x2){v1[0], v1[1]}), d = gelu_pk((f32x2){v1[2], v1[3]});
                        ss += (a.x * a.x + a.y * a.y) + (b.x * b.x + b.y * b.y) + (c.x * c.x + c.y * c.y) + (d.x * d.x + d.y * d.y);
                        u32x4 w; w.x = cvt_pk_bf16(a.x, a.y); w.y = cvt_pk_bf16(b.x, b.y); w.z = cvt_pk_bf16(c.x, c.y); w.w = cvt_pk_bf16(d.x, d.y);
                        *(u32x4*)(V + (size_t)row * 4096 + colb + bj * HALF) = w; }
                    ss += __shfl_xor(ss, 16); ss += __shfl_xor(ss, 32);
                    if (fq == 0) atomicAdd(ssv + row, ss); }
        }
    }
};
struct EpiResN {
    static constexpr bool PERM = false, AFTER_DRAIN = false;
    const float* base; float* out; int ldc; bf16_t* xn; const float* gn; float* ssn;
    __device__ __forceinline__ void operator()(const f32x4 (&acc)[2][2][4][2], const Unit& u, int wr, int wc, int fr, int fq) const {
        typedef unsigned u32x2v __attribute__((ext_vector_type(2)));
        const int row0 = u.pm * BM + wr * 64 + fr, col0 = u.pn * BM + wc * 32 + 4 * fq;
        f32x4 gg[2][2];
#pragma unroll
        for (int bj = 0; bj < 2; ++bj)
#pragma unroll
            for (int n = 0; n < 2; ++n) gg[bj][n] = xn ? *(const f32x4*)(gn + col0 + bj * HALF + n * 16) : (f32x4){0.f, 0.f, 0.f, 0.f};
#pragma unroll
        for (int ai = 0; ai < 2; ++ai)
#pragma unroll
            for (int m = 0; m < 4; ++m) { const int row = row0 + ai * HALF + m * 16; const size_t off = (size_t)row * ldc + col0; float ss = 0.f;
#pragma unroll
                for (int bj = 0; bj < 2; ++bj)
#pragma unroll
                    for (int n = 0; n < 2; ++n) { const f32x4 o = *(const f32x4*)(base + off + bj * HALF + n * 16) + acc[ai][bj][m][n]; *(f32x4*)(out + off + bj * HALF + n * 16) = o;
                        if (xn) { ss += (o[0] * o[0] + o[1] * o[1]) + (o[2] * o[2] + o[3] * o[3]); const f32x4 t = o * gg[bj][n];
                            u32x2v w; w.x = cvt_pk_bf16(t[0], t[1]); w.y = cvt_pk_bf16(t[2], t[3]); *(u32x2v*)(xn + off + bj * HALF + n * 16) = w; } }
                if (xn) { ss += __shfl_xor(ss, 16); ss += __shfl_xor(ss, 32); if (fq == 0) atomicAdd(ssn + row, ss); } }
    }
};

template <class Epi, class Sched, bool ALIGN_EPI = false, bool SP2 = false>
__device__ __forceinline__ void gemm_phase(PG8_LAS unsigned char* lds, const Gemm g, const Sched& S, const Epi& E, const int tid) {
    const int wid = __builtin_amdgcn_readfirstlane(tid >> 6), lane = tid & 63, wr = wid >> 2, wc = wid & 3, fr = lane & 15, fq = lane >> 4;
    const int K = g.K, nt = K / BK;
    unsigned voffA[2], voffB[2];
#pragma unroll
    for (int i = 0; i < 2; ++i) { int R, C; stage_rc(tid * 16 + i * 8192, R, C); const int Rb = Epi::PERM ? ((R & ~31) + perm32(R & 31)) : R;
        voffA[i] = (unsigned)(R * K + C) * 2u; voffB[i] = (unsigned)(Rb * K + C) * 2u; }
    const size_t kstep = (size_t)(BK * 2);
    const size_t hstep = (size_t)HALF * K * 2;
    const size_t tstep = 2 * hstep;
    const unsigned ldsw = (unsigned)wid * 1024u;
    const int aoff = lds_byte(wr * 64 + fr, fq * 8), boff = lds_byte(wc * 32 + fr, fq * 8);
#define PG8_SA(b, h) (((b) * 2 + (h)) * HTB)
#define PG8_SB(b, h) ((4 + (b) * 2 + (h)) * HTB)
#define PG8_STAGE(bufoff, gbase, voff) do { _Pragma("unroll") for (int _i = 0; _i < 2; ++_i) \
        __builtin_amdgcn_global_load_lds((const unsigned*)((const char*)(gbase) + (voff)[_i]), (PG8_LAS unsigned*)(lds + (bufoff) + ldsw + _i * 8192), 16, 0, 0); } while (0)
#define PG8_LDA(dst, b, h) do { _Pragma("unroll") for (int m = 0; m < 4; ++m) _Pragma("unroll") for (int k = 0; k < 2; ++k) dst[m][k] = *(const PG8_LAS bf16x8*)(lds + PG8_SA(b, h) + aoff + m * 2048 + k * 1024); } while (0)
#define PG8_LDB(dst, b, h) do { _Pragma("unroll") for (int n = 0; n < 2; ++n) _Pragma("unroll") for (int k = 0; k < 2; ++k) dst[n][k] = *(const PG8_LAS bf16x8*)(lds + PG8_SB(b, h) + boff + n * 2048 + k * 1024); } while (0)
#define PG8_MMA(ai, bj, At, Bt) do { __builtin_amdgcn_s_setprio(1); _Pragma("unroll") for (int m = 0; m < 4; ++m) _Pragma("unroll") for (int n = 0; n < 2; ++n) _Pragma("unroll") for (int k = 0; k < 2; ++k) \
        acc[ai][bj][m][n] = __builtin_amdgcn_mfma_f32_16x16x32_bf16(Bt[n][k], At[m][k], acc[ai][bj][m][n], 0, 0, 0); __builtin_amdgcn_s_setprio(0); } while (0)
#define PG8_WAIT_V(n) asm volatile("s_waitcnt vmcnt(" #n ")" ::: "memory")
#define PG8_WAIT_L(n) asm volatile("s_waitcnt lgkmcnt(" #n ")" ::: "memory")
#define PG8_BAR __builtin_amdgcn_s_barrier()
#define PG8_SCHED __builtin_amdgcn_sched_barrier(0)
    Unit cur, nxt; int ui = 0;
    if (!S.next(0, cur)) return;
    f32x4 acc[2][2][4][2];
#pragma unroll
    for (int a = 0; a < 2; ++a)
#pragma unroll
        for (int b = 0; b < 2; ++b)
#pragma unroll
            for (int m = 0; m < 4; ++m)
#pragma unroll
                for (int n = 0; n < 2; ++n) acc[a][b][m][n] = (f32x4){0.f, 0.f, 0.f, 0.f};
    bf16x8 At[4][2], B0[2][2], B1[2][2];
    const char* cA = (const char*)g.A + (size_t)cur.pm * tstep; const char* cB = (const char*)g.Bt + (size_t)cur.pn * tstep;
    S.a_ready(cur);
    if constexpr (SP2) {
        PG8_STAGE(PG8_SB(0, 0), cB, voffB); PG8_STAGE(PG8_SB(0, 1), cB + hstep, voffB); PG8_STAGE(PG8_SA(0, 0), cA, voffA); PG8_STAGE(PG8_SA(0, 1), cA + hstep, voffA);
        if (wr == 1) PG8_BAR;
        PG8_WAIT_V(2); PG8_BAR;
        PG8_STAGE(PG8_SB(1, 0), cB + kstep, voffB); PG8_STAGE(PG8_SA(1, 0), cA + kstep, voffA); PG8_STAGE(PG8_SB(1, 1), cB + hstep + kstep, voffB);
        PG8_WAIT_V(6); PG8_BAR;
    } else {
        PG8_STAGE(PG8_SB(0, 0), cB, voffB); PG8_STAGE(PG8_SA(0, 0), cA, voffA); PG8_STAGE(PG8_SB(0, 1), cB + hstep, voffB); PG8_STAGE(PG8_SA(0, 1), cA + hstep, voffA);
        if (wr == 1) PG8_BAR;
        PG8_WAIT_V(4); PG8_BAR;
        PG8_STAGE(PG8_SB(1, 0), cB + kstep, voffB); PG8_STAGE(PG8_SA(1, 0), cA + kstep, voffA); PG8_STAGE(PG8_SB(1, 1), cB + hstep + kstep, voffB);
        PG8_WAIT_V(6); PG8_BAR;
    }
    for (;;) {
        const bool has_next = S.next(ui + 1, nxt);
        const char* nA = has_next ? (const char*)g.A + (size_t)nxt.pm * tstep : cA; const char* nB = has_next ? (const char*)g.Bt + (size_t)nxt.pn * tstep : cB;
        for (int t = 0; t < nt; t += 2) {
            const bool last = (t == nt - 2);
            const char* a1 = cA + (size_t)(t + 1) * kstep;
            const char* a2 = last ? nA : cA + (size_t)(t + 2) * kstep; const char* b2 = last ? nB : cB + (size_t)(t + 2) * kstep;
            const char* a3 = a2 + kstep; const char* b3 = b2 + kstep;
            if (last && has_next) S.a_ready(nxt);
            if constexpr (SP2) {
            PG8_LDB(B0, 0, 0); PG8_LDB(B1, 0, 1); PG8_SCHED; PG8_LDA(At, 0, 0); PG8_STAGE(PG8_SA(1, 1), a1 + hstep, voffA);
            PG8_WAIT_V(8); PG8_WAIT_L(0); PG8_BAR; PG8_MMA(0, 0, At, B0); PG8_MMA(0, 1, At, B1); PG8_BAR; PG8_SCHED;
            PG8_LDA(At, 0, 1); PG8_STAGE(PG8_SB(0, 0), b2, voffB); PG8_STAGE(PG8_SB(0, 1), b2 + hstep, voffB); PG8_STAGE(PG8_SA(0, 0), a2, voffA);
            PG8_WAIT_V(8); PG8_WAIT_L(0); PG8_BAR; PG8_MMA(1, 0, At, B0); PG8_MMA(1, 1, At, B1); PG8_BAR; PG8_SCHED;
            PG8_LDB(B0, 1, 0); PG8_LDB(B1, 1, 1); PG8_SCHED; PG8_LDA(At, 1, 0); PG8_STAGE(PG8_SA(0, 1), a2 + hstep, voffA);
            PG8_WAIT_V(8); PG8_WAIT_L(0); PG8_BAR; PG8_MMA(0, 0, At, B0); PG8_MMA(0, 1, At, B1); PG8_BAR; PG8_SCHED;
            PG8_LDA(At, 1, 1); PG8_STAGE(PG8_SB(1, 0), b3, voffB); PG8_STAGE(PG8_SB(1, 1), b3 + hstep, voffB); PG8_STAGE(PG8_SA(1, 0), a3, voffA);
            PG8_WAIT_V(8); PG8_WAIT_L(0); PG8_BAR; PG8_MMA(1, 0, At, B0); PG8_MMA(1, 1, At, B1); PG8_BAR; PG8_SCHED;
            } else {
            PG8_LDB(B0, 0, 0); PG8_SCHED; PG8_LDA(At, 0, 0); PG8_STAGE(PG8_SA(1, 1), a1 + hstep, voffA);
            PG8_WAIT_L(8); PG8_BAR; PG8_WAIT_L(0); PG8_MMA(0, 0, At, B0); PG8_BAR; PG8_SCHED;
            PG8_LDB(B1, 0, 1); PG8_STAGE(PG8_SB(0, 0), b2, voffB);
            PG8_BAR; PG8_WAIT_L(0); PG8_MMA(0, 1, At, B1); PG8_BAR;
            PG8_LDA(At, 0, 1); PG8_STAGE(PG8_SA(0, 0), a2, voffA);
            PG8_BAR; PG8_WAIT_L(0); PG8_MMA(1, 0, At, B0); PG8_BAR; PG8_SCHED;
            PG8_STAGE(PG8_SB(0, 1), b2 + hstep, voffB);
            PG8_WAIT_V(6); PG8_BAR; PG8_MMA(1, 1, At, B1); PG8_BAR;
            PG8_LDB(B0, 1, 0); PG8_SCHED; PG8_LDA(At, 1, 0); PG8_STAGE(PG8_SA(0, 1), a2 + hstep, voffA);
            PG8_WAIT_L(8); PG8_BAR; PG8_WAIT_L(0); PG8_MMA(0, 0, At, B0); PG8_BAR; PG8_SCHED;
            PG8_LDB(B1, 1, 1); PG8_STAGE(PG8_SB(1, 0), b3, voffB);
            PG8_BAR; PG8_WAIT_L(0); PG8_MMA(0, 1, At, B1); PG8_BAR;
            PG8_LDA(At, 1, 1); PG8_STAGE(PG8_SA(1, 0), a3, voffA);
            PG8_BAR; PG8_WAIT_L(0); PG8_MMA(1, 0, At, B0); PG8_BAR; PG8_SCHED;
            PG8_STAGE(PG8_SB(1, 1), b3 + hstep, voffB);
            PG8_WAIT_V(6); PG8_BAR; PG8_MMA(1, 1, At, B1); PG8_BAR;
            }
        }
        if constexpr (ALIGN_EPI) { if (wr == 0) PG8_BAR; }
        if constexpr (!Epi::AFTER_DRAIN) { E(acc, cur, wr, wc, fr, fq); S.done(cur); }
        if (!has_next) break;
#pragma unroll
        for (int a = 0; a < 2; ++a)
#pragma unroll
            for (int b = 0; b < 2; ++b)
#pragma unroll
                for (int m = 0; m < 4; ++m)
#pragma unroll
                    for (int n = 0; n < 2; ++n) acc[a][b][m][n] = (f32x4){0.f, 0.f, 0.f, 0.f};
        cur = nxt; cA = nA; cB = nB; ++ui;
        if constexpr (ALIGN_EPI) { if (wr == 1) PG8_BAR; }
    }
    PG8_WAIT_V(0);
    if constexpr (!ALIGN_EPI) { if (wr == 0) PG8_BAR; }
    PG8_BAR;
    if constexpr (Epi::AFTER_DRAIN) { E.fused(acc, cur, wr, wc, fr, fq, lds, wid, lane); S.done(cur); }
#undef PG8_SA
#undef PG8_SB
#undef PG8_STAGE
#undef PG8_LDA
#undef PG8_LDB
#undef PG8_MMA
#undef PG8_WAIT_V
#undef PG8_WAIT_L
#undef PG8_BAR
#undef PG8_SCHED
}
}


#define GAS __attribute__((address_space(1)))
#define LAS __attribute__((address_space(3)))
typedef unsigned short bf16;
typedef unsigned v4u __attribute__((ext_vector_type(4)));
typedef float f32x4 __attribute__((ext_vector_type(4)));
typedef short bf16x8 __attribute__((ext_vector_type(8)));
typedef GAS unsigned gu32;
typedef GAS unsigned long long gu64;
#define RLX_AGENT __ATOMIC_RELAXED, __HIP_MEMORY_SCOPE_AGENT
#define LDS_WAIT() asm volatile("s_waitcnt lgkmcnt(0)" ::: "memory")
#define VM_WAIT() asm volatile("s_waitcnt vmcnt(0)" ::: "memory")
__device__ __forceinline__ unsigned long long rt() { return __builtin_amdgcn_s_memrealtime(); }
__device__ __forceinline__ unsigned f2bf(float f) { unsigned u = __builtin_bit_cast(unsigned, f); return (u + 0x7fffu + ((u >> 16) & 1u)) >> 16; }
__device__ __forceinline__ unsigned pk2(float lo, float hi) { return f2bf(lo) | (f2bf(hi) << 16); }

#define XB_TMO      128
#define XB_XCNT(j)  (256  + 64 * (j))
#define XB_XSUB(j)  (1280 + 64 * (j))
#define XB_XGEN(j)  (2304 + 64 * (j))
#define XB_TOP      3328
#define XB_TOPGEN   3392
#define XCD_BAR_WORDS 3456
#define XB_SPIN_CAP (1u << 18)

__device__ __forceinline__ unsigned xb_ld(unsigned* p)              { return __hip_atomic_load(p, __ATOMIC_RELAXED, __HIP_MEMORY_SCOPE_AGENT); }
__device__ __forceinline__ unsigned xb_add(unsigned* p, unsigned v) { return __hip_atomic_fetch_add(p, v, __ATOMIC_RELAXED, __HIP_MEMORY_SCOPE_AGENT); }
__device__ __forceinline__ unsigned xb_xcc_id() { return (unsigned)__builtin_amdgcn_s_getreg((3 << 11) | 20) & 0xFu; }
#define XB_SPIN(cond, bar) do { unsigned _sp = 0; while (cond) { __builtin_amdgcn_s_sleep(1); \
    if ((++_sp & 255u) == 0u) { if (xb_ld(&(bar)[XB_TMO])) break; if (_sp > XB_SPIN_CAP) { atomicAdd(&(bar)[XB_TMO], 1u); break; } } } } while (0)

struct XcdBarrier {
    unsigned* bar; unsigned x;
    volatile LAS unsigned* st;
};

__device__ __forceinline__ XcdBarrier xcd_barrier_post(unsigned* bar, volatile LAS unsigned* st) {
    XcdBarrier b; b.bar = bar; b.x = xb_xcc_id(); b.st = st;
    if (threadIdx.x == 0) (void)xb_add(&bar[XB_XCNT(b.x)], 1u);
    return b;
}
__device__ __forceinline__ void xcd_barrier_complete(unsigned* bar, unsigned x, unsigned& nloc, unsigned& nx) {
    const unsigned G = gridDim.x * gridDim.y * gridDim.z;
    unsigned sum, cnt, mine, sp = 0u;
    for (;;) {
        sum = 0u; cnt = 0u; mine = 0u;
#pragma unroll
        for (unsigned j = 0; j < 16; ++j) { const unsigned c = xb_ld(&bar[XB_XCNT(j)]); sum += c; cnt += (c > 0u) ? 1u : 0u; mine = (j == x) ? c : mine; }
        if (sum == G) break;
        __builtin_amdgcn_s_sleep(1);
        if ((++sp & 255u) == 0u) { if (xb_ld(&bar[XB_TMO])) break; if (sp > XB_SPIN_CAP) { atomicAdd(&bar[XB_TMO], 1u); break; } }
    }
    nloc = mine > 0u ? mine : 1u; nx = cnt > 0u ? cnt : 1u;
}

__device__ __forceinline__ void xcd_barrier(const XcdBarrier& b) {
    asm volatile("s_waitcnt vmcnt(0)" ::: "memory");
    __syncthreads();
    if (threadIdx.x == 0) {
        unsigned* bar = b.bar;
        __builtin_amdgcn_s_waitcnt(0);
        unsigned nloc = b.st[0], nx = b.st[1];
        if (nloc == 0u) { xcd_barrier_complete(bar, b.x, nloc, nx); b.st[0] = nloc; b.st[1] = nx; }
        const unsigned old = xb_add(&bar[XB_XSUB(b.x)], 1u);
        const unsigned gen = old / nloc;
        if (old + 1u == (gen + 1u) * nloc) {
            __builtin_amdgcn_fence(__ATOMIC_RELEASE, "agent");
            asm volatile("s_waitcnt vmcnt(0)" ::: "memory");
            const unsigned og = xb_add(&bar[XB_TOP], 1u);
            const unsigned tg = og / nx;
            if (og + 1u == (tg + 1u) * nx) xb_add(&bar[XB_TOPGEN], 1u);
            else XB_SPIN(xb_ld(&bar[XB_TOPGEN]) == tg, bar);
            __builtin_amdgcn_fence(__ATOMIC_ACQUIRE, "agent");
            xb_add(&bar[XB_XGEN(b.x)], 1u);
            asm volatile("s_waitcnt vmcnt(0)" ::: "memory");
        } else {
            XB_SPIN(xb_ld(&bar[XB_XGEN(b.x)]) == gen, bar);
            __builtin_amdgcn_fence(__ATOMIC_ACQUIRE, "agent");
            asm volatile("s_waitcnt vmcnt(0)" ::: "memory");
        }
    }
    __syncthreads();
}

constexpr int NWAVES = 8;
#ifndef MK_ONE_LAUNCH
#define MK_ONE_LAUNCH 1
#endif
constexpr int SEQ = 2048, DMODEL = 2048, MROWS = 8192;
constexpr int EV_IN = 6400, OD_IN = 12288, CWID = 4096;
constexpr float EPS = 1e-6f;
constexpr size_t MiB = 1u << 20;
constexpr size_t WS_CTL = 0, CTL_ZERO_BYTES = 1 * MiB;
constexpr size_t WS_EWIN = 2 * MiB, SZ_EWIN = 25 * MiB;
constexpr size_t WS_EWOUT = 52 * MiB, SZ_EWOUT = 8 * MiB;
constexpr size_t WS_OWIN = 68 * MiB, SZ_OWIN = 48 * MiB;
constexpr size_t WS_OWOUT = 164 * MiB, SZ_OWOUT = 16 * MiB;
constexpr size_t WS_XN = 196 * MiB;
constexpr size_t WS_Z = 228 * MiB;
constexpr size_t WS_Y = 420 * MiB;
constexpr size_t WS_END = 486 * MiB;
constexpr int CW_BAR = 4096;
constexpr int CW_SSX = 16384;
constexpr int CW_SSV = 49152;
static_assert((CW_SSV + 2 * 8192) * 4 <= (int)CTL_ZERO_BYTES, "CTL map");
constexpr int RING_OFF = 0, RING_BYTES = 131072;
constexpr int LDSCTL_OFF = RING_BYTES, MISC_OFF = LDSCTL_OFF + 320;
constexpr int LDS_BYTES = 147456;
constexpr int NPHASE = 13;
enum { PH_PRO = 0, PH_G1 = 1, PH_MID = 2, PH_G2 = 3 };

__device__ __forceinline__ float bf2f(unsigned short u) { return __uint_as_float((unsigned)u << 16); }
__device__ __forceinline__ float wave_sum(float v) {
#pragma unroll
    for (int o = 1; o < 64; o <<= 1) v += __shfl_xor(v, o);
    return v;
}
__device__ __forceinline__ int t5_bucket(int n) {
    if (n < 16) return n;
    return 16 + (n >= 22) + (n >= 30) + (n >= 40) + (n >= 54) + (n >= 73) + (n >= 99) + (n >= 134) + (n >= 182) + (n >= 246) + (n >= 332) + (n >= 450) + (n >= 609) + (n >= 825) + (n >= 1117) + (n >= 1513);
}

__device__ __forceinline__ void p0_transpose_item(const float* W, int K, int N, bf16* WT, LAS float* scr, int item, int lane, const int permkind) {
    const int nblk = N / 32, kb = item / nblk, nb = item % nblk, k0 = 64 * kb, n0 = 32 * nb;
    int r0 = n0;
    if (permkind == 1) r0 = (n0 & ~255) + 128 * ((n0 >> 5) & 1) + 32 * ((n0 >> 6) & 3);
    else if (permkind == 2) r0 = (n0 < 4096) ? (256 * (n0 >> 7) + (n0 & 127))
                               : (n0 < 8192) ? (8192 + (n0 - 4096))
                               : (256 * ((n0 - 8192) >> 7) + 128 + ((n0 - 8192) & 127));
#pragma unroll 8
    for (int i = 0; i < 32; ++i) { const int kk = 2 * i + (lane >> 5); scr[kk * 33 + (lane & 31)] = W[(size_t)(k0 + kk) * N + n0 + (lane & 31)]; }
    LDS_WAIT(); asm volatile("" ::: "memory");
    const int c = lane & 7;
#pragma unroll
    for (int j = 0; j < 4; ++j) { const int n = (lane >> 3) + 8 * j; const LAS float* s = scr + (8 * c) * 33 + n;
        v4u o; o.x = pk2(s[0 * 33], s[1 * 33]); o.y = pk2(s[2 * 33], s[3 * 33]); o.z = pk2(s[4 * 33], s[5 * 33]); o.w = pk2(s[6 * 33], s[7 * 33]);
        *(GAS v4u*)(WT + (size_t)(r0 + n) * K + k0 + 8 * c) = o; }
    LDS_WAIT(); asm volatile("" ::: "memory");
}
__device__ __forceinline__ void xg_row_to_bf16(const float* xrow, const float* g, bf16* orow, float* ss, int lane) {
    const GAS f32x4* xr = (const GAS f32x4*)xrow + lane; const GAS f32x4* gr = (const GAS f32x4*)g + lane;
    GAS unsigned long long* o8 = (GAS unsigned long long*)orow + lane; float s = 0.f;
#pragma unroll
    for (int j = 0; j < 8; ++j) { const f32x4 v = xr[64 * j], gg = gr[64 * j]; s += (v.x * v.x + v.y * v.y) + (v.z * v.z + v.w * v.w);
        o8[64 * j] = (unsigned long long)pk2(v.x * gg.x, v.y * gg.y) | ((unsigned long long)pk2(v.z * gg.z, v.w * gg.w) << 32); }
    s = wave_sum(s);
    if (lane == 0) *ss = s;
}
struct Weights { const float *ev_w_in, *ev_w_out, *od_w_in, *od_w_out; };
__device__ __forceinline__ void convert_set(LAS unsigned char* lds, int wave, int lane, const Weights& W, unsigned char* ws, const int set, const int gw, const int NGW) {
    LAS float* scr = (LAS float*)(lds + RING_OFF + wave * 16384);
    constexpr int I_EI = (DMODEL / 64) * (EV_IN / 32), I_EO = (DMODEL / 64) * (DMODEL / 32), I_OI = (DMODEL / 64) * (OD_IN / 32), I_OO = (CWID / 64) * (DMODEL / 32);
    if (set == 0) {
        for (int it = gw; it < 2 * I_EI; it += NGW) { const int j = it / I_EI, r = it % I_EI;
            p0_transpose_item(W.ev_w_in + (size_t)j * DMODEL * EV_IN, DMODEL, EV_IN, (bf16*)(ws + WS_EWIN + j * SZ_EWIN), scr, r, lane, 1); }
    } else {
        const int j = set - 1;
        for (int it = gw; it < I_EO + I_OI + I_OO; it += NGW) { int r = it;
            if (r < I_OI) { p0_transpose_item(W.od_w_in + (size_t)j * DMODEL * OD_IN, DMODEL, OD_IN, (bf16*)(ws + WS_OWIN + j * SZ_OWIN), scr, r, lane, 2); continue; } r -= I_OI;
            if (r < I_OO) { p0_transpose_item(W.od_w_out + (size_t)j * CWID * DMODEL, CWID, DMODEL, (bf16*)(ws + WS_OWOUT + j * SZ_OWOUT), scr, r, lane, 0); continue; } r -= I_OO;
            p0_transpose_item(W.ev_w_out + (size_t)j * DMODEL * DMODEL, DMODEL, DMODEL, (bf16*)(ws + WS_EWOUT + j * SZ_EWOUT), scr, r, lane, 0); }
    }
}
__device__ __forceinline__ void ph_prologue(LAS unsigned char* lds, int wave, int lane, int vcu, int G, const Weights& W, unsigned char* ws, const float* x, const float* g0) {
    const int gw = vcu * NWAVES + wave, NGW = G * NWAVES;
    convert_set(lds, wave, lane, W, ws, 0, gw, NGW);
    float* ssx0 = (float*)(ws + WS_CTL) + CW_SSX;
    for (int m = gw; m < MROWS; m += NGW) xg_row_to_bf16(x + (size_t)m * DMODEL, g0, (bf16*)(ws + WS_XN) + (size_t)m * DMODEL, ssx0 + m, lane);
}


namespace att {
using bf16x8 = __attribute__((ext_vector_type(8))) short;
using s16x4 = __attribute__((ext_vector_type(4))) short;
using f32x16 = __attribute__((ext_vector_type(16))) float;
using u32x4 = __attribute__((ext_vector_type(4))) unsigned;
typedef short v4i16_t __attribute__((ext_vector_type(4)));
typedef float f32x2_t __attribute__((ext_vector_type(2))); typedef __bf16 bf16x2_t __attribute__((ext_vector_type(2)));
constexpr int ZP = 6400, YP = 2048, SLOTB = 8192;
constexpr int L_K = 0, L_V = 16384, L_LUT = 32768, L_WS = 43008, L_OST = 45056, L_END = 77824;
constexpr int LUT_N = 2304, LUT_OFF = 256;
constexpr float LOG2E = 1.4426950408889634f;
__device__ __forceinline__ int crow(int r, int hi) { return (r & 3) + 8 * (r >> 2) + 4 * hi; }
__device__ __forceinline__ void glds16(const void* gsrc, unsigned lds_dst) { unsigned keep;
    asm volatile("s_mov_b32 %0, m0\n\ts_mov_b32 m0, %2\n\ts_nop 0\n\tglobal_load_lds_dwordx4 %1, off\n\ts_mov_b32 m0, %0" : "=&s"(keep) : "v"(gsrc), "s"(lds_dst) : "memory"); }
__device__ __forceinline__ unsigned cvtpk_s(float lo, float hi) { f32x2_t v = {lo, hi}; bf16x2_t b = __builtin_convertvector(v, bf16x2_t); return __builtin_bit_cast(unsigned, b); }
#define ATT_WAIT_BAR() asm volatile("s_waitcnt vmcnt(0) lgkmcnt(0)\n\ts_barrier" ::: "memory")
#define ATT_SBAR() __builtin_amdgcn_sched_barrier(0)
__device__ __forceinline__ void pv(f32x16* o, int vb, bf16x8 pa0, bf16x8 pa1, bf16x8 pa2, bf16x8 pa3) {
#pragma unroll
    for (int d0 = 0; d0 < 2; ++d0) { s16x4 lo[4], hi[4];
#pragma unroll
        for (int ks = 0; ks < 4; ++ks) {
            asm volatile("ds_read_b64_tr_b16 %0,%1 offset:%c2" : "=&v"(lo[ks]) : "v"(vb), "i"(d0 * 4096 + ks * 1024) : "memory");
            asm volatile("ds_read_b64_tr_b16 %0,%1 offset:%c2" : "=&v"(hi[ks]) : "v"(vb), "i"(d0 * 4096 + ks * 1024 + 512) : "memory"); }
        asm volatile("s_waitcnt lgkmcnt(0)" ::: "memory"); ATT_SBAR();
#define ATT_PK(k) (bf16x8){lo[k][0], lo[k][1], lo[k][2], lo[k][3], hi[k][0], hi[k][1], hi[k][2], hi[k][3]}
        o[d0] = __builtin_amdgcn_mfma_f32_32x32x16_bf16(pa0, ATT_PK(0), o[d0], 0, 0, 0);
        o[d0] = __builtin_amdgcn_mfma_f32_32x32x16_bf16(pa1, ATT_PK(1), o[d0], 0, 0, 0);
        o[d0] = __builtin_amdgcn_mfma_f32_32x32x16_bf16(pa2, ATT_PK(2), o[d0], 0, 0, 0);
        o[d0] = __builtin_amdgcn_mfma_f32_32x32x16_bf16(pa3, ATT_PK(3), o[d0], 0, 0, 0);
#undef ATT_PK
    }
}
__device__ __forceinline__ void attn_unit(const int b, const int hh, const int qb, const bf16* Z, bf16* Y, const float* qkg, const float* sinks, const float* relb, LAS unsigned char* shm, const int tid) {
    const bool isB = hh >= 16; const int h = hh & 15;
    const int lane = tid & 63, r32 = lane & 31, hi = lane >> 5; const int wid = __builtin_amdgcn_readfirstlane(tid >> 6);
    const int qcol = isB ? 2304 + h * 64 : h * 64;
    const int kcol = isB ? 3328 + h * 64 : 1024 + (h >> 3) * 64;
    const int vcol = isB ? 4352 + h * 64 : 1152 + (h >> 3) * 64;
    const int gcol = isB ? 5376 + h * 64 : 1280 + h * 64;
    const int ycol = (isB ? 1024 : 0) + h * 64;
    const float* gq = qkg + (isB ? 128 : 0); const float* gk = qkg + (isB ? 192 : 64);
    const long rowbase = (long)b * SEQ; const int q0 = qb * 256;
    const int t_hi = 4 * qb + 3, t_lo = isB ? 0 : (qb > 0 ? 4 * qb - 2 : 0);
    float maxg = 0.f, maxb = 0.f;
    for (int d = 0; d < 64; ++d) maxg = fmaxf(maxg, fabsf(gq[d] * gk[d]));
    for (int k = 0; k < 32; ++k) maxb = fmaxf(maxb, fabsf(relb[k * 32 + hh]));
    const float M0 = (8.0f * maxg + maxb) * LOG2E + 1.5849625f + 0.25f;
    LAS float* lut = (LAS float*)(shm + L_LUT);
    for (int i = tid; i < LUT_N; i += 512) { const int d = i - LUT_OFF; float val = -1e30f;
        if (d >= 0) { const int w = isB ? ((d <= 128 ? 1 : 0) + (((d & 3) == 0 && d <= 512) ? 1 : 0) + (((d & 15) == 0) ? 1 : 0)) : (d <= 127 ? 1 : 0);
            if (w > 0) val = relb[t5_bucket(d) * 32 + hh] * LOG2E + (w == 1 ? 0.f : (w == 2 ? 1.0f : 1.5849625f)) - M0; }
        lut[i] = val; }
    const bf16* Qw = Z + (rowbase + q0 + wid * 32) * ZP + qcol;
    bf16x8 qr[4];
#pragma unroll
    for (int d0 = 0; d0 < 4; ++d0) qr[d0] = *reinterpret_cast<const bf16x8*>(Qw + (long)r32 * ZP + d0 * 16 + hi * 8);
    const unsigned lds0 = (unsigned)(uintptr_t)shm;
    const bf16* ksrc = Z + (rowbase + lane) * ZP + kcol + wid * 8;
    const bf16* vsrc = Z + (rowbase + 16 * (wid & 3) + (lane >> 2)) * ZP + vcol + (wid >> 2) * 32 + (lane & 3) * 8;
    const unsigned kdst = lds0 + L_K + wid * 1024, vdst = lds0 + L_V + wid * 1024;
#define ATT_DMA(t, slot) do { glds16(ksrc + (long)(t) * 64 * ZP, (unsigned)__builtin_amdgcn_readfirstlane(kdst + (slot))); glds16(vsrc + (long)(t) * 64 * ZP, (unsigned)__builtin_amdgcn_readfirstlane(vdst + (slot))); } while (0)
    const int vb0 = (int)(lds0 + L_V) + ((lane >> 4) & 1) * 32 + (lane & 3) * 8 + (4 * hi + ((lane & 15) >> 2)) * 64;
    const LAS unsigned char* kp0 = shm + L_K + hi * 1024 + r32 * 16;
    ATT_DMA(t_lo, 0);
    f32x16 o[2]; o[0] = f32x16{}; o[1] = f32x16{}; float l_reg = 0.f;
    const int qlo = q0 + wid * 32;
    int slot = 0;
    for (int t = t_lo; t <= t_hi; ++t) {
        ATT_WAIT_BAR();
        if (t < t_hi) ATT_DMA(t + 1, slot ^ SLOTB);
        const int klo = 64 * t;
        const bool active = (klo <= qlo + 31) && (isB || (klo + 63 >= qlo - 127));
        if (active) {
            const LAS unsigned char* kp = kp0 + slot;
            f32x16 p0, p1;
#pragma unroll
            for (int d0 = 0; d0 < 4; ++d0) {
                const bf16x8 b0 = *(const LAS bf16x8*)(kp + d0 * 2048), b1 = *(const LAS bf16x8*)(kp + d0 * 2048 + 512);
                if (d0 == 0) { p0 = __builtin_amdgcn_mfma_f32_32x32x16_bf16(b0, qr[0], f32x16{}, 0, 0, 0); p1 = __builtin_amdgcn_mfma_f32_32x32x16_bf16(b1, qr[0], f32x16{}, 0, 0, 0); }
                else { p0 = __builtin_amdgcn_mfma_f32_32x32x16_bf16(b0, qr[d0], p0, 0, 0, 0); p1 = __builtin_amdgcn_mfma_f32_32x32x16_bf16(b1, qr[d0], p1, 0, 0, 0); } }
            const LAS float* lp = lut + (qlo + r32 - klo - 4 * hi + LUT_OFF);
            float sacc = 0.f;
#pragma unroll
            for (int r = 0; r < 16; ++r) { const int c = (r & 3) + 8 * (r >> 2);
                p0[r] = __builtin_amdgcn_exp2f(p0[r] + lp[-c]); p1[r] = __builtin_amdgcn_exp2f(p1[r] + lp[-c - 32]); sacc += p0[r] + p1[r]; }
            l_reg += sacc;
            u32x4 pw0, pw1, pw2, pw3;
            pw0 = (u32x4){cvtpk_s(p0[0], p0[1]), cvtpk_s(p0[2], p0[3]), cvtpk_s(p0[4], p0[5]), cvtpk_s(p0[6], p0[7])};
            pw1 = (u32x4){cvtpk_s(p0[8], p0[9]), cvtpk_s(p0[10], p0[11]), cvtpk_s(p0[12], p0[13]), cvtpk_s(p0[14], p0[15])};
            pw2 = (u32x4){cvtpk_s(p1[0], p1[1]), cvtpk_s(p1[2], p1[3]), cvtpk_s(p1[4], p1[5]), cvtpk_s(p1[6], p1[7])};
            pw3 = (u32x4){cvtpk_s(p1[8], p1[9]), cvtpk_s(p1[10], p1[11]), cvtpk_s(p1[12], p1[13]), cvtpk_s(p1[14], p1[15])};
            ATT_SBAR();
            pv(o, vb0 + slot, __builtin_bit_cast(bf16x8, pw0), __builtin_bit_cast(bf16x8, pw1), __builtin_bit_cast(bf16x8, pw2), __builtin_bit_cast(bf16x8, pw3));
        }
        slot ^= SLOTB;
    }
#undef ATT_DMA
    { auto rr = __builtin_amdgcn_permlane32_swap(__float_as_uint(l_reg), __float_as_uint(l_reg), false, false); l_reg = __uint_as_float(rr[0]) + __uint_as_float(rr[1]); }
    if (!isB) l_reg += __builtin_amdgcn_exp2f(sinks[h] * LOG2E - M0);
    LAS float* wsf = (LAS float*)(shm + L_WS) + wid * 64;
    if (hi == 0) wsf[32 + r32] = l_reg;
    asm volatile("s_waitcnt lgkmcnt(0)" ::: "memory");
    float rli[16];
#pragma unroll
    for (int r = 0; r < 16; ++r) rli[r] = __builtin_amdgcn_rcpf(wsf[32 + crow(r, hi)]);
    { LAS bf16* stg = (LAS bf16*)(shm + L_OST) + wid * 2048;
#pragma unroll
        for (int r = 0; r < 16; ++r) { const int orow = crow(r, hi);
#pragma unroll
            for (int d0 = 0; d0 < 2; ++d0) stg[orow * 64 + d0 * 32 + r32] = (bf16)f2bf(o[d0][r] * rli[r]); }
        asm volatile("s_waitcnt lgkmcnt(0)" ::: "memory");
#pragma unroll
        for (int i = 0; i < 4; ++i) { const int row = i * 8 + (lane >> 3), ch = lane & 7;
            const u32x4 v = *(const LAS u32x4*)(stg + row * 64 + ch * 8);
            const u32x4 g = *(const GAS u32x4*)(Z + (rowbase + q0 + wid * 32 + row) * ZP + gcol + ch * 8);
            u32x4 w;
            w.x = pk2(__uint_as_float(v.x << 16) * __uint_as_float(g.x << 16), __uint_as_float(v.x & 0xffff0000u) * __uint_as_float(g.x & 0xffff0000u));
            w.y = pk2(__uint_as_float(v.y << 16) * __uint_as_float(g.y << 16), __uint_as_float(v.y & 0xffff0000u) * __uint_as_float(g.y & 0xffff0000u));
            w.z = pk2(__uint_as_float(v.z << 16) * __uint_as_float(g.z << 16), __uint_as_float(v.z & 0xffff0000u) * __uint_as_float(g.z & 0xffff0000u));
            w.w = pk2(__uint_as_float(v.w << 16) * __uint_as_float(g.w << 16), __uint_as_float(v.w & 0xffff0000u) * __uint_as_float(g.w & 0xffff0000u));
            *(GAS u32x4*)(Y + (rowbase + q0 + wid * 32 + row) * YP + ycol + ch * 8) = w; } }
    asm volatile("s_waitcnt lgkmcnt(0)\n\ts_barrier" ::: "memory");
}
__device__ __forceinline__ void attn_phase(const bf16* Z, bf16* Y, const float* qkg, const float* sinks, const float* relb, LAS unsigned char* shm, int vcu, int G, int tid) {
    for (int u = vcu; u < 1024; u += G) {
        const int i = u >> 8, v = u & 255, bh = v >> 2, s = v & 3, b = bh >> 4, h = bh & 15;
        const int qb = (i == 0) ? 7 - s : (i == 1) ? s : (i == 2) ? 2 * s : 2 * s + 1;
        attn_unit(b, (i < 2) ? 16 + h : h, qb, Z, Y, qkg, sinks, relb, shm, tid);
    }
}
#undef ATT_WAIT_BAR
#undef ATT_SBAR
}

namespace mix {
using bf16x8 = __attribute__((ext_vector_type(8))) short;
using s16x4 = __attribute__((ext_vector_type(4))) short;
using f32x16 = __attribute__((ext_vector_type(16))) float;
using u32x4 = __attribute__((ext_vector_type(4))) unsigned;
constexpr int L_V = 0, L_STG = 65536, L_RS = RING_BYTES + 2048;
#define MIX_DMA_V(ch_, g_) do { const bf16* src_ = V + (size_t)((ch_) * 128 + (lane >> 2)) * CWID + 256 * (g_) + 32 * wid + (lane & 3) * 8; \
    _Pragma("unroll") for (int kg = 0; kg < 8; ++kg) att::glds16(src_ + (size_t)(16 * kg) * CWID, (unsigned)__builtin_amdgcn_readfirstlane(lds0 + L_V + (wid * 8 + kg) * 1024)); } while (0)
__device__ __forceinline__ void mix_phase(const bf16* UG, const bf16* V, bf16* Y, const float* ssv, const float* vg, const float* wsp, const float* bsp, LAS unsigned char* shm, int vcu, int G, const int tid) {
    const int lane = tid & 63, r32 = lane & 31, hi = lane >> 5; const int wid = __builtin_amdgcn_readfirstlane(tid >> 6);
    const int tb = wid & 3, ch2 = wid >> 2, nks = 2 * tb + 2;
    LAS float* rs = (LAS float*)(shm + L_RS);
    const unsigned lds0 = (unsigned)(uintptr_t)shm;
    const int vb = (int)(lds0 + L_V) + ch2 * 32768 + ((lane >> 4) & 1) * 32 + (lane & 3) * 8 + (4 * hi + ((lane & 15) >> 2)) * 64;
    LAS bf16* stg = (LAS bf16*)(shm + L_STG) + wid * 4096;
    int u = vcu;
    if (u < 1024) { if (tid < 128) rs[tid] = __builtin_amdgcn_rsqf(ssv[(u >> 4) * 128 + tid] * (1.f / 4096.f) + EPS); MIX_DMA_V(u >> 4, u & 15); }
    for (; u < 1024; u += G) {
        const int ch = u >> 4, g = u & 15, row0 = ch * 128;
        const int t = 32 * tb + r32; const float* wrow = wsp + ((size_t)g * 128 + t) * 128 + 4 * hi;
        f32x4 wa[8][2];
#pragma unroll
        for (int ks = 0; ks < 8; ++ks) if (ks < nks) { wa[ks][0] = *(const GAS f32x4*)(wrow + 16 * ks); wa[ks][1] = *(const GAS f32x4*)(wrow + 16 * ks + 8); }
        asm volatile("s_waitcnt vmcnt(0) lgkmcnt(0)\n\ts_barrier" ::: "memory");
        bf16x8 af[8];
#pragma unroll
        for (int ks = 0; ks < 8; ++ks) { af[ks] = bf16x8{};
            if (ks < nks) { const int s0 = 16 * ks + 4 * hi;
                f32x4 a = wa[ks][0] * *(const LAS f32x4*)(rs + s0), b = wa[ks][1] * *(const LAS f32x4*)(rs + s0 + 8);
                a.x = (s0 + 0 <= t) ? a.x : 0.f; a.y = (s0 + 1 <= t) ? a.y : 0.f; a.z = (s0 + 2 <= t) ? a.z : 0.f; a.w = (s0 + 3 <= t) ? a.w : 0.f;
                b.x = (s0 + 8 <= t) ? b.x : 0.f; b.y = (s0 + 9 <= t) ? b.y : 0.f; b.z = (s0 + 10 <= t) ? b.z : 0.f; b.w = (s0 + 11 <= t) ? b.w : 0.f;
                u32x4 w; w.x = pk2(a.x, a.y); w.y = pk2(a.z, a.w); w.z = pk2(b.x, b.y); w.w = pk2(b.z, b.w);
                af[ks] = __builtin_bit_cast(bf16x8, w); } }
        f32x16 acc[4];
#pragma unroll
        for (int nb = 0; nb < 4; ++nb) { acc[nb] = f32x16{};
#pragma unroll
            for (int ks = 0; ks < 8; ++ks) { if (ks < nks) { s16x4 lo, hh;
                asm volatile("ds_read_b64_tr_b16 %0,%1 offset:%c2" : "=&v"(lo) : "v"(vb), "i"(nb * 8192 + ks * 1024) : "memory");
                asm volatile("ds_read_b64_tr_b16 %0,%1 offset:%c2" : "=&v"(hh) : "v"(vb), "i"(nb * 8192 + ks * 1024 + 512) : "memory");
                asm volatile("s_waitcnt lgkmcnt(0)" ::: "memory"); __builtin_amdgcn_sched_barrier(0);
                const bf16x8 bfr = (bf16x8){lo[0], lo[1], lo[2], lo[3], hh[0], hh[1], hh[2], hh[3]};
                acc[nb] = __builtin_amdgcn_mfma_f32_32x32x16_bf16(af[ks], bfr, acc[nb], 0, 0, 0); } } }
        asm volatile("s_waitcnt lgkmcnt(0)\n\ts_barrier" ::: "memory");
        { const int un = u + G; if (un < 1024) { if (tid < 128) rs[tid] = __builtin_amdgcn_rsqf(ssv[(un >> 4) * 128 + tid] * (1.f / 4096.f) + EPS); MIX_DMA_V(un >> 4, un & 15); } }
#pragma unroll
        for (int nb = 0; nb < 4; ++nb) { const float gv = vg[256 * g + 128 * ch2 + 32 * nb + r32];
#pragma unroll
            for (int r = 0; r < 16; ++r) { const int tl = (r & 3) + 8 * (r >> 2) + 4 * hi;
                stg[tl * 128 + 32 * nb + r32] = (bf16)f2bf(acc[nb][r] * gv + bsp[g * 128 + 32 * tb + tl]); } }
        asm volatile("s_waitcnt lgkmcnt(0)" ::: "memory");
#pragma unroll
        for (int i = 0; i < 8; ++i) { const int row = i * 4 + (lane >> 4), chk = lane & 15;
            const u32x4 s = *(const LAS u32x4*)(stg + row * 128 + chk * 8);
            const size_t idx = (size_t)(row0 + 32 * tb + row) * CWID + 256 * g + 128 * ch2 + chk * 8;
            const u32x4 q = *(const GAS u32x4*)(UG + idx);
            u32x4 w;
            w.x = pk2(__uint_as_float(s.x << 16) * __uint_as_float(q.x << 16), __uint_as_float(s.x & 0xffff0000u) * __uint_as_float(q.x & 0xffff0000u));
            w.y = pk2(__uint_as_float(s.y << 16) * __uint_as_float(q.y << 16), __uint_as_float(s.y & 0xffff0000u) * __uint_as_float(q.y & 0xffff0000u));
            w.z = pk2(__uint_as_float(s.z << 16) * __uint_as_float(q.z << 16), __uint_as_float(s.z & 0xffff0000u) * __uint_as_float(q.z & 0xffff0000u));
            w.w = pk2(__uint_as_float(s.w << 16) * __uint_as_float(q.w << 16), __uint_as_float(s.w & 0xffff0000u) * __uint_as_float(q.w & 0xffff0000u));
            *(GAS u32x4*)(Y + idx) = w; }
        asm volatile("s_waitcnt lgkmcnt(0)" ::: "memory");
    }
}
#undef MIX_DMA_V
}

struct Args { const float* in[13]; float* out; unsigned char* ws; int ph_lo, ph_hi; };
__global__ void __launch_bounds__(NWAVES * 64, 2) skel_fwd(Args args) {
    extern __shared__ __attribute__((aligned(16))) unsigned char lds_raw[];
    LAS unsigned char* lds = (LAS unsigned char*)lds_raw;
    const int G = gridDim.x; int vcu; { const int bx = blockIdx.x; vcu = (G % 8 == 0) ? (bx % 8) * (G / 8) + bx / 8 : bx; }
    unsigned char* ws = args.ws;
    gu32* ctl = (gu32*)(ws + WS_CTL);
    for (int u = threadIdx.x; u < (LDS_BYTES - LDSCTL_OFF) / 4; u += NWAVES * 64) ((LAS unsigned*)(lds + LDSCTL_OFF))[u] = 0u;
    __syncthreads();
    const int lo = args.ph_lo, hi = args.ph_hi;
    XcdBarrier bar; bar.bar = (unsigned*)(ctl + CW_BAR); bar.x = 0; bar.st = nullptr;
    if (hi - lo > 1) bar = xcd_barrier_post((unsigned*)(ctl + CW_BAR), (volatile LAS unsigned*)(lds + MISC_OFF) + 8);
    const float* x_in = args.in[0];
    const float *ev_ln_g = args.in[1], *ev_w_in = args.in[2], *ev_qk_g = args.in[3], *ev_sinks = args.in[4], *ev_w_out = args.in[5];
    const float *od_ln_g = args.in[6], *od_w_in = args.in[7], *od_v_g = args.in[8], *od_w_s = args.in[9], *od_b_s = args.in[10], *od_w_out = args.in[11], *rel_bias = args.in[12];
    float* out = args.out;
    bf16* XN = (bf16*)(ws + WS_XN); bf16* Z = (bf16*)(ws + WS_Z); bf16* VB = (bf16*)(ws + WS_Z + 64 * MiB); bf16* Y = (bf16*)(ws + WS_Y);
    float* ssx = (float*)(ws + WS_CTL) + CW_SSX; float* ssv = (float*)(ws + WS_CTL) + CW_SSV;

    for (int p = lo; p < hi; ++p) {
        int kind = PH_PRO, layer = 0;
        if (p > 0) { layer = (p - 1) / 3; kind = 1 + (p - 1) % 3; }
        const int j = layer >> 1; const bool odd = (layer & 1) != 0;
#if DUP_MASK
        const int ndup = ((kind == PH_PRO && (DUP_MASK & 1)) || ((kind == PH_G1 || kind == PH_G2) && (DUP_MASK & 2)) || (kind == PH_G1 && !odd && (DUP_MASK & 16)) || (kind == PH_G1 && odd && (DUP_MASK & 32)) || (kind == PH_G2 && !odd && (DUP_MASK & 64)) || (kind == PH_G2 && odd && (DUP_MASK & 128)) || (kind == PH_MID && !odd && (DUP_MASK & 4)) || (kind == PH_MID && odd && (DUP_MASK & 8))) ? 2 : 1;
        for (int dup = 0; dup < ndup; ++dup) {
        if (dup > 0) xcd_barrier(bar);
        const bool dummy = (ndup == 2 && dup == 0);
#else
        const bool dummy = false;
#endif
        int tid = threadIdx.x; asm volatile("" : "+v"(tid));
        const int lane = tid & 63, wave = __builtin_amdgcn_readfirstlane(tid >> 6);
        if (kind == PH_PRO) {
            Weights W{ev_w_in, ev_w_out, od_w_in, od_w_out};
            ph_prologue(lds, wave, lane, vcu, G, W, ws, x_in, ev_ln_g);
        } else if (kind == PH_G1) {
            pg8::Gemm g{XN, odd ? (const bf16*)(ws + WS_OWIN + j * SZ_OWIN) : (const bf16*)(ws + WS_EWIN + j * SZ_EWIN), MROWS, odd ? OD_IN : EV_IN, DMODEL};
            pg8::StaticOrder S; S.init(g.M, g.N, G, (int)blockIdx.x);
            if (odd) { pg8::EpiOdd E{Z, VB, ssx + layer * MROWS, dummy ? (float*)(ws + WS_Y) : ssv + j * MROWS}; pg8::gemm_phase<pg8::EpiOdd, pg8::StaticOrder, true, true>(lds + RING_OFF, g, S, E, tid); }
            else { pg8::EpiQKV E{Z, g.N, ev_qk_g + j * 256, ssx + layer * MROWS}; pg8::gemm_phase<pg8::EpiQKV, pg8::StaticOrder, true, true>(lds + RING_OFF, g, S, E, tid);
                if (!dummy) { const int rem = (g.M / 256) * (g.N / 256) % G, c = (int)blockIdx.x;
                    Weights W{ev_w_in, ev_w_out, od_w_in, od_w_out};
                    if (rem == 0) convert_set(lds, wave, lane, W, ws, 1 + j, c * NWAVES + wave, G * NWAVES);
                    else if (c >= rem) convert_set(lds, wave, lane, W, ws, 1 + j, (c - rem) * NWAVES + wave, (G - rem) * NWAVES); } }
        } else if (kind == PH_G2) {
            pg8::Gemm g{Y, odd ? (const bf16*)(ws + WS_OWOUT + j * SZ_OWOUT) : (const bf16*)(ws + WS_EWOUT + j * SZ_EWOUT), MROWS, DMODEL, odd ? CWID : DMODEL};
            pg8::StaticOrder S; S.init(g.M, g.N, G, (int)blockIdx.x);
            const int nl = layer + 1, nj = nl >> 1;
            pg8::EpiResN E{layer == 0 ? x_in : (const float*)out, dummy ? (float*)(ws + WS_Z) : out, DMODEL, (nl < 4 && !dummy) ? XN : (bf16*)nullptr, (nl & 1) ? od_ln_g + nj * DMODEL : ev_ln_g + (nj & 1) * DMODEL, ssx + (nl & 3) * MROWS};
            pg8::gemm_phase<pg8::EpiResN, pg8::StaticOrder, true, true>(lds + RING_OFF, g, S, E, tid);
        } else if (!odd) {
            att::attn_phase(Z, Y, ev_qk_g + j * 256, ev_sinks + j * 16, rel_bias, lds + RING_OFF, vcu, G, tid);
        } else {
            mix::mix_phase(Z, VB, Y, ssv + j * MROWS, od_v_g + j * CWID, od_w_s + (size_t)j * 16 * 16384, od_b_s + j * 2048, lds + RING_OFF, vcu, G, tid);
        }
#if DUP_MASK
        }
#endif
        if (p + 1 < hi) xcd_barrier(bar);
    }
}

extern "C" void kernel_launch(void* const* d_in, const int* in_sizes, int n_in, void* d_out, int out_size, void* d_ws, size_t ws_size, hipStream_t stream) {
    static int grid = 0;
    if (grid == 0) {
        if (n_in != 13 || out_size != MROWS * DMODEL || ws_size < WS_END) { fprintf(stderr, "kernel_launch: unexpected shapes (n_in %d out %d ws %zu)\n", n_in, out_size, ws_size); grid = -1; return; }
        int dev = 0, cus = 0;
        if (hipGetDevice(&dev) != hipSuccess || hipDeviceGetAttribute(&cus, hipDeviceAttributeMultiprocessorCount, dev) != hipSuccess) { grid = -1; return; }
        if (hipFuncSetAttribute((const void*)skel_fwd, hipFuncAttributeMaxDynamicSharedMemorySize, LDS_BYTES) != hipSuccess) { fprintf(stderr, "kernel_launch: hipFuncSetAttribute failed\n"); grid = -1; return; }
        int per_cu = 0;
        (void)hipOccupancyMaxActiveBlocksPerMultiprocessor(&per_cu, (const void*)skel_fwd, NWAVES * 64, LDS_BYTES);
        (void)hipGetLastError();
        grid = cus;
    }
    if (grid < 0) return;
    (void)hipMemsetAsync((char*)d_ws + WS_CTL, 0, CTL_ZERO_BYTES, stream);
    Args a{};
    for (int i = 0; i < 13; ++i) a.in[i] = (const float*)d_in[i];
    a.out = (float*)d_out; a.ws = (unsigned char*)d_ws;
#if MK_ONE_LAUNCH
    a.ph_lo = 0; a.ph_hi = NPHASE;
    hipLaunchKernelGGL(skel_fwd, dim3(grid), dim3(NWAVES * 64), LDS_BYTES, stream, a);
#else
    for (int p = 0; p < NPHASE; ++p) { a.ph_lo = p; a.ph_hi = p + 1; hipLaunchKernelGGL(skel_fwd, dim3(grid), dim3(NWAVES * 64), LDS_BYTES, stream, a); }
#endif
}
```

```cpp
#include <hip/hip_runtime.h>
#include <cstdio>
#include <cstdint>
#define MK_ONE_LAUNCH 1
#define DUP_MASK 0
#define PROBE_FULLPRO 1

namespace pg8 {
#define PG8_LAS __attribute__((address_space(3)))
typedef unsigned short bf16_t;
typedef short bf16x8 __attribute__((ext_vector_type(8)));
typedef float f32x4 __attribute__((ext_vector_type(4)));
typedef unsigned u32x4 __attribute__((ext_vector_type(4)));
constexpr int BM = 256, BK = 64, HALF = 128, HTB = HALF * BK * 2  , STAGE_BYTES = 8 * HTB, NXCD = 8, WGM = 8;

__host__ __device__ __forceinline__ int lds_byte(int r, int c) { const int st = (r >> 4) * 2 + (c >> 5), rr = r & 15, cc = c & 31, ob = rr * 64 + cc * 2; return st * 1024 + (ob ^ (((ob >> 9) & 1) << 5)); }
__host__ __device__ __forceinline__ void stage_rc(int b, int& R, int& C) { const int st = b / 1024, sb = b % 1024, swz = sb ^ (((sb >> 9) & 1) << 5); R = (st >> 1) * 16 + swz / 64; C = (st & 1) * 32 + (swz % 64) / 2; }
__host__ __device__ __forceinline__ int perm32(int rho) { const int n = rho >> 4, i = rho & 15; return 8 * (i >> 2) + 4 * n + (i & 3); }

struct Unit { int pm, pn; };
struct Gemm { const bf16_t* A; const bf16_t* Bt; int M, N, K; };

struct StaticOrder {
    int nM, nN, nwg, G, c;
    __host__ __device__ void init(int M, int N, int G_, int c_) { nM = M / BM; nN = N / BM; nwg = nM * nN; G = G_; c = c_; }
    __host__ __device__ bool next(int i, Unit& u) const {
        const long L = (long)i * G + c; if (L >= nwg) return false;
        int wgid = (int)L; { const int q = nwg / NXCD, r = nwg % NXCD, xcd = wgid % NXCD, off = wgid / NXCD; wgid = (xcd < r ? xcd * (q + 1) : r * (q + 1) + (xcd - r) * q) + off; }
        const int nig = WGM * nN, gid = wgid / nig, fm = gid * WGM, gsz = (nM - fm) < WGM ? (nM - fm) : WGM;
        u.pm = fm + ((wgid % nig) % gsz); u.pn = (wgid % nig) / gsz; return true;
    }
    __device__ __forceinline__ void a_ready(const Unit&) const {}
    __device__ __forceinline__ void done(const Unit&) const {}
};

__device__ __forceinline__ unsigned cvt_pk_bf16(float lo, float hi) { unsigned r; asm volatile("v_cvt_pk_bf16_f32 %0, %1, %2" : "=v"(r) : "v"(lo), "v"(hi)); return r; }
typedef float f32x2 __attribute__((ext_vector_type(2)));
__device__ __forceinline__ f32x2 gelu_pk(f32x2 v) {
    const f32x2 av = __builtin_elementwise_abs(v), d = av * 0.2316418882f + 1.0f;
    f32x2 t; t.x = __builtin_amdgcn_rcpf(d.x); t.y = __builtin_amdgcn_rcpf(d.y);
    f32x2 q = t * 0.5307027145f + (-0.7265760135f); q = q * t + 0.7107068705f; q = q * t + (-0.142248368f); q = q * t + 0.127414796f; q = q * t;
    const f32x2 s = (v * v) * (-0.72134752044f);
    f32x2 e; e.x = __builtin_amdgcn_exp2f(s.x); e.y = __builtin_amdgcn_exp2f(s.y);
    const f32x2 m = v * (q * e), r = v - m;
    f32x2 o; o.x = v.x < 0.f ? m.x : r.x; o.y = v.y < 0.f ? m.y : r.y; return o;
}


__device__ __forceinline__ float silu_f(float x) { return x * __builtin_amdgcn_rcpf(1.0f + __builtin_amdgcn_exp2f(-1.4426950408889634f * x)); }
struct EpiAct {
    static constexpr bool PERM = true, AFTER_DRAIN = false;
    bf16_t* O; int ldc; int gelu_below; int silu_from;
    __device__ __forceinline__ void operator()(const f32x4 (&acc)[2][2][4][2], const Unit& u, int wr, int wc, int fr, int fq) const {
        const int row0 = u.pm * BM + wr * 64 + fr, col0 = u.pn * BM + wc * 32 + 8 * fq;
        const int mode = (u.pn < gelu_below) ? 1 : ((u.pn >= silu_from) ? 2 : 0);
#pragma unroll
        for (int ai = 0; ai < 2; ++ai)
#pragma unroll
            for (int m = 0; m < 4; ++m) { bf16_t* rowp = O + (size_t)(row0 + ai * HALF + m * 16) * ldc + col0;
#pragma unroll
                for (int bj = 0; bj < 2; ++bj) { f32x4 v0 = acc[ai][bj][m][0], v1 = acc[ai][bj][m][1];
                    if (mode == 1) { f32x2 a = gelu_pk((f32x2){v0[0], v0[1]}), b = gelu_pk((f32x2){v0[2], v0[3]}), c = gelu_pk((f32x2){v1[0], v1[1]}), d = gelu_pk((f32x2){v1[2], v1[3]});
                        v0 = (f32x4){a.x, a.y, b.x, b.y}; v1 = (f32x4){c.x, c.y, d.x, d.y}; }
                    else if (mode == 2) { v0 = (f32x4){silu_f(v0[0]), silu_f(v0[1]), silu_f(v0[2]), silu_f(v0[3])}; v1 = (f32x4){silu_f(v1[0]), silu_f(v1[1]), silu_f(v1[2]), silu_f(v1[3])}; }
                    u32x4 w; w.x = cvt_pk_bf16(v0[0], v0[1]); w.y = cvt_pk_bf16(v0[2], v0[3]); w.z = cvt_pk_bf16(v1[0], v1[1]); w.w = cvt_pk_bf16(v1[2], v1[3]);
                    *(u32x4*)(rowp + bj * HALF) = w; } }
    }
};
struct EpiRes {
    static constexpr bool PERM = false, AFTER_DRAIN = false;
    const float* base; float* out; int ldc;
    __device__ __forceinline__ void operator()(const f32x4 (&acc)[2][2][4][2], const Unit& u, int wr, int wc, int fr, int fq) const {
        const int row0 = u.pm * BM + wr * 64 + fr, col0 = u.pn * BM + wc * 32 + 4 * fq;
#pragma unroll
        for (int ai = 0; ai < 2; ++ai)
#pragma unroll
            for (int m = 0; m < 4; ++m) { const size_t off = (size_t)(row0 + ai * HALF + m * 16) * ldc + col0;
#pragma unroll
                for (int bj = 0; bj < 2; ++bj)
#pragma unroll
                    for (int n = 0; n < 2; ++n) { const f32x4 bs = *(const f32x4*)(base + off + bj * HALF + n * 16); *(f32x4*)(out + off + bj * HALF + n * 16) = bs + acc[ai][bj][m][n]; } }
    }
};

struct EpiQKV {
    static constexpr bool PERM = true, AFTER_DRAIN = false;
    bf16_t* O; int ldc; const float* qkg; const float* ssx;
    __device__ __forceinline__ void operator()(const f32x4 (&acc)[2][2][4][2], const Unit& u, int wr, int wc, int fr, int fq) const {
        const int row0 = u.pm * BM + wr * 64 + fr, colw = u.pn * BM + wc * 64;
        int mode = 0; const float* gv = qkg; float sc = 1.f;
        if (colw < 1024) { mode = 1; gv = qkg; sc = 0.125f * 1.4426950408889634f; }
        else if (colw < 1152) { mode = 1; gv = qkg + 64; }
        else if (colw < 1280) { mode = 0; }
        else if (colw < 2304) { mode = 2; }
        else if (colw < 3328) { mode = 1; gv = qkg + 128; sc = 0.125f * 1.4426950408889634f; }
        else if (colw < 4352) { mode = 1; gv = qkg + 192; }
        else if (colw < 5376) { mode = 0; }
        else { mode = 2; }
        f32x4 gg[2][2];
#pragma unroll
        for (int bj = 0; bj < 2; ++bj)
#pragma unroll
            for (int n = 0; n < 2; ++n) gg[bj][n] = (mode == 1) ? *(const f32x4*)(gv + 32 * bj + 8 * fq + 4 * n) * sc : (f32x4){1.f, 1.f, 1.f, 1.f};
#pragma unroll
        for (int ai = 0; ai < 2; ++ai)
#pragma unroll
            for (int m = 0; m < 4; ++m) { bf16_t* rowp = O + (size_t)(row0 + ai * HALF + m * 16) * ldc + colw + 8 * fq;
                f32x4 v[2][2];
                const float rx = __builtin_amdgcn_rsqf(ssx[row0 + ai * HALF + m * 16] * (1.f / 2048.f) + 1e-6f);
#pragma unroll
                for (int bj = 0; bj < 2; ++bj)
#pragma unroll
                    for (int n = 0; n < 2; ++n) v[bj][n] = acc[ai][bj][m][n] * rx;
                if (mode == 1) { float ss = 0.f;
#pragma unroll
                    for (int bj = 0; bj < 2; ++bj)
#pragma unroll
                        for (int n = 0; n < 2; ++n) ss += (v[bj][n][0] * v[bj][n][0] + v[bj][n][1] * v[bj][n][1]) + (v[bj][n][2] * v[bj][n][2] + v[bj][n][3] * v[bj][n][3]);
                    ss += __shfl_xor(ss, 16); ss += __shfl_xor(ss, 32);
                    const float r = __builtin_amdgcn_rsqf(ss * (1.f / 64.f) + 1e-6f);
#pragma unroll
                    for (int bj = 0; bj < 2; ++bj)
#pragma unroll
                        for (int n = 0; n < 2; ++n) v[bj][n] = v[bj][n] * r * gg[bj][n]; }
                else if (mode == 2) {
#pragma unroll
                    for (int bj = 0; bj < 2; ++bj)
#pragma unroll
                        for (int n = 0; n < 2; ++n) v[bj][n] = (f32x4){silu_f(v[bj][n][0]), silu_f(v[bj][n][1]), silu_f(v[bj][n][2]), silu_f(v[bj][n][3])}; }
#pragma unroll
                for (int bj = 0; bj < 2; ++bj) { u32x4 w; w.x = cvt_pk_bf16(v[bj][0][0], v[bj][0][1]); w.y = cvt_pk_bf16(v[bj][0][2], v[bj][0][3]); w.z = cvt_pk_bf16(v[bj][1][0], v[bj][1][1]); w.w = cvt_pk_bf16(v[bj][1][2], v[bj][1][3]);
                    *(u32x4*)(rowp + 32 * bj) = w; } }
    }
};

struct EpiOdd {
    static constexpr bool PERM = true, AFTER_DRAIN = false;
    bf16_t* UG; bf16_t* V; const float* ssx; float* ssv;
    __device__ __forceinline__ void operator()(const f32x4 (&acc)[2][2][4][2], const Unit& u, int wr, int wc, int fr, int fq) const {
        const int row0 = u.pm * BM + wr * 64 + fr;
        if (u.pn < 32) {
#pragma unroll
            for (int ai = 0; ai < 2; ++ai)
#pragma unroll
                for (int m = 0; m < 4; ++m) { const int row = row0 + ai * HALF + m * 16;
                    const float rx = __builtin_amdgcn_rsqf(ssx[row] * (1.f / 2048.f) + 1e-6f);
                    f32x4 o[2];
#pragma unroll
                    for (int n = 0; n < 2; ++n) { const f32x4 uu = acc[ai][0][m][n] * rx, gt = acc[ai][1][m][n] * rx;
                        const f32x2 a = gelu_pk((f32x2){uu[0], uu[1]}), b = gelu_pk((f32x2){uu[2], uu[3]});
                        o[n] = (f32x4){a.x * silu_f(gt[0]), a.y * silu_f(gt[1]), b.x * silu_f(gt[2]), b.y * silu_f(gt[3])}; }
                    u32x4 w; w.x = cvt_pk_bf16(o[0][0], o[0][1]); w.y = cvt_pk_bf16(o[0][2], o[0][3]); w.z = cvt_pk_bf16(o[1][0], o[1][1]); w.w = cvt_pk_bf16(o[1][2], o[1][3]);
                    *(u32x4*)(UG + (size_t)row * 4096 + u.pn * 128 + wc * 32 + 8 * fq) = w; }
        } else {
            const int colb = (u.pn - 32) * 256 + wc * 32 + 8 * fq;
#pragma unroll
            for (int ai = 0; ai < 2; ++ai)
#pragma unroll
                for (int m = 0; m < 4; ++m) { const int row = row0 + ai * HALF + m * 16;
                    const float rx = __builtin_amdgcn_rsqf(ssx[row] * (1.f / 2048.f) + 1e-6f);
                    float ss = 0.f;
#pragma unroll
                    for (int bj = 0; bj < 2; ++bj) { const f32x4 v0 = acc[ai][bj][m][0] * rx, v1 = acc[ai][bj][m][1] * rx;
                        const f32x2 a = gelu_pk((f32x2){v0[0], v0[1]}), b = gelu_pk((f32x2){v0[2], v0[3]}), c = gelu_pk((f32x2){v1[0], v1[1]}), d = gelu_pk((f32x2){v1[2], v1[3]});
                        ss += (a.x * a.x + a.y * a.y) + (b.x * b.x + b.y * b.y) + (c.x * c.x + c.y * c.y) + (d.x * d.x + d.y * d.y);
                        u32x4 w; w.x = cvt_pk_bf16(a.x, a.y); w.y = cvt_pk_bf16(b.x, b.y); w.z = cvt_pk_bf16(c.x, c.y); w.w = cvt_pk_bf16(d.x, d.y);
                        *(u32x4*)(V + (size_t)row * 4096 + colb + bj * HALF) = w; }
                    ss += __shfl_xor(ss, 16); ss += __shfl_xor(ss, 32);
                    if (fq == 0) atomicAdd(ssv + row, ss); }
        }
    }
};
struct EpiResN {
    static constexpr bool PERM = false, AFTER_DRAIN = false;
    const float* base; float* out; int ldc; bf16_t* xn; const float* gn; float* ssn;
    __device__ __forceinline__ void operator()(const f32x4 (&acc)[2][2][4][2], const Unit& u, int wr, int wc, int fr, int fq) const {
        typedef unsigned u32x2v __attribute__((ext_vector_type(2)));
        const int row0 = u.pm * BM + wr * 64 + fr, col0 = u.pn * BM + wc * 32 + 4 * fq;
        f32x4 gg[2][2];
#pragma unroll
        for (int bj = 0; bj < 2; ++bj)
#pragma unroll
            for (int n = 0; n < 2; ++n) gg[bj][n] = xn ? *(const f32x4*)(gn + col0 + bj * HALF + n * 16) : (f32x4){0.f, 0.f, 0.f, 0.f};
#pragma unroll
        for (int ai = 0; ai < 2; ++ai)
#pragma unroll
            for (int m = 0; m < 4; ++m) { const int row = row0 + ai * HALF + m * 16; const size_t off = (size_t)row * ldc + col0; float ss = 0.f;
#pragma unroll
                for (int bj = 0; bj < 2; ++bj)
#pragma unroll
                    for (int n = 0; n < 2; ++n) { const f32x4 o = *(const f32x4*)(base + off + bj * HALF + n * 16) + acc[ai][bj][m][n]; *(f32x4*)(out + off + bj * HALF + n * 16) = o;
                        if (xn) { ss += (o[0] * o[0] + o[1] * o[1]) + (o[2] * o[2] + o[3] * o[3]); const f32x4 t = o * gg[bj][n];
                            u32x2v w; w.x = cvt_pk_bf16(t[0], t[1]); w.y = cvt_pk_bf16(t[2], t[3]); *(u32x2v*)(xn + off + bj * HALF + n * 16) = w; } }
                if (xn) { ss += __shfl_xor(ss, 16); ss += __shfl_xor(ss, 32); if (fq == 0) atomicAdd(ssn + row, ss); } }
    }
};

struct EpiResB {
    static constexpr bool PERM = true, AFTER_DRAIN = false;
    bf16_t* xb; float* outf; float* ssn; int nowrite;
    __device__ __forceinline__ void operator()(const f32x4 (&acc)[2][2][4][2], const Unit& u, int wr, int wc, int fr, int fq) const {
        const int row0 = u.pm * BM + wr * 64 + fr, col0 = u.pn * BM + wc * 32 + 8 * fq;
#pragma unroll
        for (int ai = 0; ai < 2; ++ai)
#pragma unroll
            for (int m = 0; m < 4; ++m) { const int row = row0 + ai * HALF + m * 16; const size_t off = (size_t)row * 2048 + col0; float ss = 0.f;
#pragma unroll
                for (int bj = 0; bj < 2; ++bj) { const u32x4 b = *(const u32x4*)(xb + off + bj * HALF);
                    f32x4 o0 = acc[ai][bj][m][0], o1 = acc[ai][bj][m][1];
                    o0[0] += __uint_as_float(b.x << 16); o0[1] += __uint_as_float(b.x & 0xffff0000u); o0[2] += __uint_as_float(b.y << 16); o0[3] += __uint_as_float(b.y & 0xffff0000u);
                    o1[0] += __uint_as_float(b.z << 16); o1[1] += __uint_as_float(b.z & 0xffff0000u); o1[2] += __uint_as_float(b.w << 16); o1[3] += __uint_as_float(b.w & 0xffff0000u);
                    if (outf) { *(f32x4*)(outf + off + bj * HALF) = o0; *(f32x4*)(outf + off + bj * HALF + 4) = o1; }
                    else { ss += (o0[0] * o0[0] + o0[1] * o0[1]) + (o0[2] * o0[2] + o0[3] * o0[3]) + (o1[0] * o1[0] + o1[1] * o1[1]) + (o1[2] * o1[2] + o1[3] * o1[3]);
                        u32x4 w; w.x = cvt_pk_bf16(o0[0], o0[1]); w.y = cvt_pk_bf16(o0[2], o0[3]); w.z = cvt_pk_bf16(o1[0], o1[1]); w.w = cvt_pk_bf16(o1[2], o1[3]);
                        if (!nowrite) *(u32x4*)(xb + off + bj * HALF) = w; } }
                if (!outf) { ss += __shfl_xor(ss, 16); ss += __shfl_xor(ss, 32); if (fq == 0) atomicAdd(ssn + row, ss); } }
    }
};

template <class Epi, class Sched, bool ALIGN_EPI = false, bool SP2 = false>
__device__ __forceinline__ void gemm_phase(PG8_LAS unsigned char* lds, const Gemm g, const Sched& S, const Epi& E, const int tid) {
    const int wid = __builtin_amdgcn_readfirstlane(tid >> 6), lane = tid & 63, wr = wid >> 2, wc = wid & 3, fr = lane & 15, fq = lane >> 4;
    const int K = g.K, nt = K / BK;
    unsigned voffA[2], voffB[2];
#pragma unroll
    for (int i = 0; i < 2; ++i) { int R, C; stage_rc(tid * 16 + i * 8192, R, C); const int Rb = Epi::PERM ? ((R & ~31) + perm32(R & 31)) : R;
        voffA[i] = (unsigned)(R * K + C) * 2u; voffB[i] = (unsigned)(Rb * K + C) * 2u; }
    const size_t kstep = (size_t)(BK * 2);
    const size_t hstep = (size_t)HALF * K * 2;
    const size_t tstep = 2 * hstep;
    const unsigned ldsw = (unsigned)wid * 1024u;
    const int aoff = lds_byte(wr * 64 + fr, fq * 8), boff = lds_byte(wc * 32 + fr, fq * 8);
#define PG8_SA(b, h) (((b) * 2 + (h)) * HTB)
#define PG8_SB(b, h) ((4 + (b) * 2 + (h)) * HTB)
#define PG8_STAGE(bufoff, gbase, voff) do { _Pragma("unroll") for (int _i = 0; _i < 2; ++_i) \
        __builtin_amdgcn_global_load_lds((const unsigned*)((const char*)(gbase) + (voff)[_i]), (PG8_LAS unsigned*)(lds + (bufoff) + ldsw + _i * 8192), 16, 0, 0); } while (0)
#define PG8_LDA(dst, b, h) do { _Pragma("unroll") for (int m = 0; m < 4; ++m) _Pragma("unroll") for (int k = 0; k < 2; ++k) dst[m][k] = *(const PG8_LAS bf16x8*)(lds + PG8_SA(b, h) + aoff + m * 2048 + k * 1024); } while (0)
#define PG8_LDB(dst, b, h) do { _Pragma("unroll") for (int n = 0; n < 2; ++n) _Pragma("unroll") for (int k = 0; k < 2; ++k) dst[n][k] = *(const PG8_LAS bf16x8*)(lds + PG8_SB(b, h) + boff + n * 2048 + k * 1024); } while (0)
#define PG8_MMA(ai, bj, At, Bt) do { __builtin_amdgcn_s_setprio(1); _Pragma("unroll") for (int m = 0; m < 4; ++m) _Pragma("unroll") for (int n = 0; n < 2; ++n) _Pragma("unroll") for (int k = 0; k < 2; ++k) \
        acc[ai][bj][m][n] = __builtin_amdgcn_mfma_f32_16x16x32_bf16(Bt[n][k], At[m][k], acc[ai][bj][m][n], 0, 0, 0); __builtin_amdgcn_s_setprio(0); } while (0)
#define PG8_WAIT_V(n) asm volatile("s_waitcnt vmcnt(" #n ")" ::: "memory")
#define PG8_WAIT_L(n) asm volatile("s_waitcnt lgkmcnt(" #n ")" ::: "memory")
#define PG8_BAR __builtin_amdgcn_s_barrier()
#define PG8_SCHED __builtin_amdgcn_sched_barrier(0)
    Unit cur, nxt; int ui = 0;
    if (!S.next(0, cur)) return;
    f32x4 acc[2][2][4][2];
#pragma unroll
    for (int a = 0; a < 2; ++a)
#pragma unroll
        for (int b = 0; b < 2; ++b)
#pragma unroll
            for (int m = 0; m < 4; ++m)
#pragma unroll
                for (int n = 0; n < 2; ++n) acc[a][b][m][n] = (f32x4){0.f, 0.f, 0.f, 0.f};
    bf16x8 At[4][2], B0[2][2], B1[2][2];
    const char* cA = (const char*)g.A + (size_t)cur.pm * tstep; const char* cB = (const char*)g.Bt + (size_t)cur.pn * tstep;
    S.a_ready(cur);
    if constexpr (SP2) {
        PG8_STAGE(PG8_SB(0, 0), cB, voffB); PG8_STAGE(PG8_SB(0, 1), cB + hstep, voffB); PG8_STAGE(PG8_SA(0, 0), cA, voffA); PG8_STAGE(PG8_SA(0, 1), cA + hstep, voffA);
        if (wr == 1) PG8_BAR;
        PG8_WAIT_V(2); PG8_BAR;
        PG8_STAGE(PG8_SB(1, 0), cB + kstep, voffB); PG8_STAGE(PG8_SA(1, 0), cA + kstep, voffA); PG8_STAGE(PG8_SB(1, 1), cB + hstep + kstep, voffB);
        PG8_WAIT_V(6); PG8_BAR;
    } else {
        PG8_STAGE(PG8_SB(0, 0), cB, voffB); PG8_STAGE(PG8_SA(0, 0), cA, voffA); PG8_STAGE(PG8_SB(0, 1), cB + hstep, voffB); PG8_STAGE(PG8_SA(0, 1), cA + hstep, voffA);
        if (wr == 1) PG8_BAR;
        PG8_WAIT_V(4); PG8_BAR;
        PG8_STAGE(PG8_SB(1, 0), cB + kstep, voffB); PG8_STAGE(PG8_SA(1, 0), cA + kstep, voffA); PG8_STAGE(PG8_SB(1, 1), cB + hstep + kstep, voffB);
        PG8_WAIT_V(6); PG8_BAR;
    }
    for (;;) {
        const bool has_next = S.next(ui + 1, nxt);
        const char* nA = has_next ? (const char*)g.A + (size_t)nxt.pm * tstep : cA; const char* nB = has_next ? (const char*)g.Bt + (size_t)nxt.pn * tstep : cB;
        for (int t = 0; t < nt; t += 2) {
            const bool last = (t == nt - 2);
            const char* a1 = cA + (size_t)(t + 1) * kstep;
            const char* a2 = last ? nA : cA + (size_t)(t + 2) * kstep; const char* b2 = last ? nB : cB + (size_t)(t + 2) * kstep;
            const char* a3 = a2 + kstep; const char* b3 = b2 + kstep;
            if (last && has_next) S.a_ready(nxt);
            if constexpr (SP2) {
            PG8_LDB(B0, 0, 0); PG8_LDB(B1, 0, 1); PG8_SCHED; PG8_LDA(At, 0, 0); PG8_STAGE(PG8_SA(1, 1), a1 + hstep, voffA);
            PG8_WAIT_V(8); PG8_WAIT_L(0); PG8_BAR; PG8_MMA(0, 0, At, B0); PG8_MMA(0, 1, At, B1); PG8_BAR; PG8_SCHED;
            PG8_LDA(At, 0, 1); PG8_STAGE(PG8_SB(0, 0), b2, voffB); PG8_STAGE(PG8_SB(0, 1), b2 + hstep, voffB); PG8_STAGE(PG8_SA(0, 0), a2, voffA);
            PG8_WAIT_V(8); PG8_WAIT_L(0); PG8_BAR; PG8_MMA(1, 0, At, B0); PG8_MMA(1, 1, At, B1); PG8_BAR; PG8_SCHED;
            PG8_LDB(B0, 1, 0); PG8_LDB(B1, 1, 1); PG8_SCHED; PG8_LDA(At, 1, 0); PG8_STAGE(PG8_SA(0, 1), a2 + hstep, voffA);
            PG8_WAIT_V(8); PG8_WAIT_L(0); PG8_BAR; PG8_MMA(0, 0, At, B0); PG8_MMA(0, 1, At, B1); PG8_BAR; PG8_SCHED;
            PG8_LDA(At, 1, 1); PG8_STAGE(PG8_SB(1, 0), b3, voffB); PG8_STAGE(PG8_SB(1, 1), b3 + hstep, voffB); PG8_STAGE(PG8_SA(1, 0), a3, voffA);
            PG8_WAIT_V(8); PG8_WAIT_L(0); PG8_BAR; PG8_MMA(1, 0, At, B0); PG8_MMA(1, 1, At, B1); PG8_BAR; PG8_SCHED;
            } else {
            PG8_LDB(B0, 0, 0); PG8_SCHED; PG8_LDA(At, 0, 0); PG8_STAGE(PG8_SA(1, 1), a1 + hstep, voffA);
            PG8_WAIT_L(8); PG8_BAR; PG8_WAIT_L(0); PG8_MMA(0, 0, At, B0); PG8_BAR; PG8_SCHED;
            PG8_LDB(B1, 0, 1); PG8_STAGE(PG8_SB(0, 0), b2, voffB);
            PG8_BAR; PG8_WAIT_L(0); PG8_MMA(0, 1, At, B1); PG8_BAR;
            PG8_LDA(At, 0, 1); PG8_STAGE(PG8_SA(0, 0), a2, voffA);
            PG8_BAR; PG8_WAIT_L(0); PG8_MMA(1, 0, At, B0); PG8_BAR; PG8_SCHED;
            PG8_STAGE(PG8_SB(0, 1), b2 + hstep, voffB);
            PG8_WAIT_V(6); PG8_BAR; PG8_MMA(1, 1, At, B1); PG8_BAR;
            PG8_LDB(B0, 1, 0); PG8_SCHED; PG8_LDA(At, 1, 0); PG8_STAGE(PG8_SA(0, 1), a2 + hstep, voffA);
            PG8_WAIT_L(8); PG8_BAR; PG8_WAIT_L(0); PG8_MMA(0, 0, At, B0); PG8_BAR; PG8_SCHED;
            PG8_LDB(B1, 1, 1); PG8_STAGE(PG8_SB(1, 0), b3, voffB);
            PG8_BAR; PG8_WAIT_L(0); PG8_MMA(0, 1, At, B1); PG8_BAR;
            PG8_LDA(At, 1, 1); PG8_STAGE(PG8_SA(1, 0), a3, voffA);
            PG8_BAR; PG8_WAIT_L(0); PG8_MMA(1, 0, At, B0); PG8_BAR; PG8_SCHED;
            PG8_STAGE(PG8_SB(1, 1), b3 + hstep, voffB);
            PG8_WAIT_V(6); PG8_BAR; PG8_MMA(1, 1, At, B1); PG8_BAR;
            }
        }
        if constexpr (ALIGN_EPI) { if (wr == 0) PG8_BAR; }
        if constexpr (!Epi::AFTER_DRAIN) { E(acc, cur, wr, wc, fr, fq); S.done(cur); }
        if (!has_next) break;
#pragma unroll
        for (int a = 0; a < 2; ++a)
#pragma unroll
            for (int b = 0; b < 2; ++b)
#pragma unroll
                for (int m = 0; m < 4; ++m)
#pragma unroll
                    for (int n = 0; n < 2; ++n) acc[a][b][m][n] = (f32x4){0.f, 0.f, 0.f, 0.f};
        cur = nxt; cA = nA; cB = nB; ++ui;
        if constexpr (ALIGN_EPI) { if (wr == 1) PG8_BAR; }
    }
    PG8_WAIT_V(0);
    if constexpr (!ALIGN_EPI) { if (wr == 0) PG8_BAR; }
    PG8_BAR;
    if constexpr (Epi::AFTER_DRAIN) { E.fused(acc, cur, wr, wc, fr, fq, lds, wid, lane); S.done(cur); }
#undef PG8_SA
#undef PG8_SB
#undef PG8_STAGE
#undef PG8_LDA
#undef PG8_LDB
#undef PG8_MMA
#undef PG8_WAIT_V
#undef PG8_WAIT_L
#undef PG8_BAR
#undef PG8_SCHED
}
}


#define GAS __attribute__((address_space(1)))
#define LAS __attribute__((address_space(3)))
typedef unsigned short bf16;
typedef unsigned v4u __attribute__((ext_vector_type(4)));
typedef float f32x4 __attribute__((ext_vector_type(4)));
typedef short bf16x8 __attribute__((ext_vector_type(8)));
typedef GAS unsigned gu32;
typedef GAS unsigned long long gu64;
#define RLX_AGENT __ATOMIC_RELAXED, __HIP_MEMORY_SCOPE_AGENT
#define LDS_WAIT() asm volatile("s_waitcnt lgkmcnt(0)" ::: "memory")
#define VM_WAIT() asm volatile("s_waitcnt vmcnt(0)" ::: "memory")
__device__ __forceinline__ unsigned long long rt() { return __builtin_amdgcn_s_memrealtime(); }
__device__ __forceinline__ unsigned f2bf(float f) { unsigned u = __builtin_bit_cast(unsigned, f); return (u + 0x7fffu + ((u >> 16) & 1u)) >> 16; }
__device__ __forceinline__ unsigned pk2(float lo, float hi) { return f2bf(lo) | (f2bf(hi) << 16); }

#define XB_TMO      128
#define XB_XCNT(j)  (256  + 64 * (j))
#define XB_XSUB(j)  (1280 + 64 * (j))
#define XB_XGEN(j)  (2304 + 64 * (j))
#define XB_TOP      3328
#define XB_TOPGEN   3392
#define XCD_BAR_WORDS 3456
#define XB_SPIN_CAP (1u << 18)

__device__ __forceinline__ unsigned xb_ld(unsigned* p)              { return __hip_atomic_load(p, __ATOMIC_RELAXED, __HIP_MEMORY_SCOPE_AGENT); }
__device__ __forceinline__ unsigned xb_add(unsigned* p, unsigned v) { return __hip_atomic_fetch_add(p, v, __ATOMIC_RELAXED, __HIP_MEMORY_SCOPE_AGENT); }
__device__ __forceinline__ unsigned xb_xcc_id() { return (unsigned)__builtin_amdgcn_s_getreg((3 << 11) | 20) & 0xFu; }
#define XB_SPIN(cond, bar) do { unsigned _sp = 0; while (cond) { __builtin_amdgcn_s_sleep(1); \
    if ((++_sp & 255u) == 0u) { if (xb_ld(&(bar)[XB_TMO])) break; if (_sp > XB_SPIN_CAP) { atomicAdd(&(bar)[XB_TMO], 1u); break; } } } } while (0)

struct XcdBarrier {
    unsigned* bar; unsigned x;
    volatile LAS unsigned* st;
};

__device__ __forceinline__ XcdBarrier xcd_barrier_post(unsigned* bar, volatile LAS unsigned* st) {
    XcdBarrier b; b.bar = bar; b.x = xb_xcc_id(); b.st = st;
    if (threadIdx.x == 0) (void)xb_add(&bar[XB_XCNT(b.x)], 1u);
    return b;
}
__device__ __forceinline__ void xcd_barrier_complete(unsigned* bar, unsigned x, unsigned& nloc, unsigned& nx) {
    const unsigned G = gridDim.x * gridDim.y * gridDim.z;
    unsigned sum, cnt, mine, sp = 0u;
    for (;;) {
        sum = 0u; cnt = 0u; mine = 0u;
#pragma unroll
        for (unsigned j = 0; j < 16; ++j) { const unsigned c = xb_ld(&bar[XB_XCNT(j)]); sum += c; cnt += (c > 0u) ? 1u : 0u; mine = (j == x) ? c : mine; }
        if (sum == G) break;
        __builtin_amdgcn_s_sleep(1);
        if ((++sp & 255u) == 0u) { if (xb_ld(&bar[XB_TMO])) break; if (sp > XB_SPIN_CAP) { atomicAdd(&bar[XB_TMO], 1u); break; } }
    }
    nloc = mine > 0u ? mine : 1u; nx = cnt > 0u ? cnt : 1u;
}

__device__ __forceinline__ void xcd_barrier(const XcdBarrier& b) {
    asm volatile("s_waitcnt vmcnt(0)" ::: "memory");
    __syncthreads();
    if (threadIdx.x == 0) {
        unsigned* bar = b.bar;
        __builtin_amdgcn_s_waitcnt(0);
        unsigned nloc = b.st[0], nx = b.st[1];
        if (nloc == 0u) { xcd_barrier_complete(bar, b.x, nloc, nx); b.st[0] = nloc; b.st[1] = nx; }
        const unsigned old = xb_add(&bar[XB_XSUB(b.x)], 1u);
        const unsigned gen = old / nloc;
        if (old + 1u == (gen + 1u) * nloc) {
            __builtin_amdgcn_fence(__ATOMIC_RELEASE, "agent");
            asm volatile("s_waitcnt vmcnt(0)" ::: "memory");
            const unsigned og = xb_add(&bar[XB_TOP], 1u);
            const unsigned tg = og / nx;
            if (og + 1u == (tg + 1u) * nx) xb_add(&bar[XB_TOPGEN], 1u);
            else XB_SPIN(xb_ld(&bar[XB_TOPGEN]) == tg, bar);
            __builtin_amdgcn_fence(__ATOMIC_ACQUIRE, "agent");
            xb_add(&bar[XB_XGEN(b.x)], 1u);
            asm volatile("s_waitcnt vmcnt(0)" ::: "memory");
        } else {
            XB_SPIN(xb_ld(&bar[XB_XGEN(b.x)]) == gen, bar);
            __builtin_amdgcn_fence(__ATOMIC_ACQUIRE, "agent");
            asm volatile("s_waitcnt vmcnt(0)" ::: "memory");
        }
    }
    __syncthreads();
}

constexpr int NWAVES = 8;
#ifndef MK_ONE_LAUNCH
#define MK_ONE_LAUNCH 1
#endif
constexpr int SEQ = 2048, DMODEL = 2048, MROWS = 8192;
constexpr int EV_IN = 6400, OD_IN = 12288, CWID = 4096;
constexpr float EPS = 1e-6f;
constexpr size_t MiB = 1u << 20;
constexpr size_t WS_CTL = 0, CTL_ZERO_BYTES = 1 * MiB;
constexpr size_t WS_EWIN = 2 * MiB, SZ_EWIN = 25 * MiB;
constexpr size_t WS_EWOUT = 52 * MiB, SZ_EWOUT = 8 * MiB;
constexpr size_t WS_OWIN = 68 * MiB, SZ_OWIN = 48 * MiB;
constexpr size_t WS_OWOUT = 164 * MiB, SZ_OWOUT = 16 * MiB;
constexpr size_t WS_XN = 196 * MiB;
constexpr size_t WS_Z = 228 * MiB;
constexpr size_t WS_Y = 420 * MiB;
constexpr size_t WS_END = 486 * MiB;
constexpr int CW_BAR = 4096;
constexpr int CW_SSX = 16384;
constexpr int CW_SSV = 49152;
static_assert((CW_SSV + 2 * 8192) * 4 <= (int)CTL_ZERO_BYTES, "CTL map");
constexpr int RING_OFF = 0, RING_BYTES = 131072;
constexpr int LDSCTL_OFF = RING_BYTES, MISC_OFF = LDSCTL_OFF + 320;
constexpr int LDS_BYTES = 147456;
constexpr int NPHASE = 13;
enum { PH_PRO = 0, PH_G1 = 1, PH_MID = 2, PH_G2 = 3 };

__device__ __forceinline__ float bf2f(unsigned short u) { return __uint_as_float((unsigned)u << 16); }
__device__ __forceinline__ float wave_sum(float v) {
#pragma unroll
    for (int o = 1; o < 64; o <<= 1) v += __shfl_xor(v, o);
    return v;
}
__device__ __forceinline__ int t5_bucket(int n) {
    if (n < 16) return n;
    return 16 + (n >= 22) + (n >= 30) + (n >= 40) + (n >= 54) + (n >= 73) + (n >= 99) + (n >= 134) + (n >= 182) + (n >= 246) + (n >= 332) + (n >= 450) + (n >= 609) + (n >= 825) + (n >= 1117) + (n >= 1513);
}

__device__ __forceinline__ void p0_transpose_item(const float* W, int K, int N, bf16* WT, LAS float* scr, int item, int lane, const int permkind, const float* gk = nullptr) {
    const int nblk = N / 32, kb = item / nblk, nb = item % nblk, k0 = 64 * kb, n0 = 32 * nb;
    int r0 = n0;
    if (permkind == 1) r0 = (n0 & ~255) + 128 * ((n0 >> 5) & 1) + 32 * ((n0 >> 6) & 3);
    else if (permkind == 2) r0 = (n0 < 4096) ? (256 * (n0 >> 7) + (n0 & 127))
                               : (n0 < 8192) ? (8192 + (n0 - 4096))
                               : (256 * ((n0 - 8192) >> 7) + 128 + ((n0 - 8192) & 127));
    { const int q4 = (lane & 7) * 4, rr = lane >> 3; const float* wp = W + (size_t)(k0 + rr) * N + n0 + q4; f32x4 v[8];
#pragma unroll
        for (int i = 0; i < 8; ++i) v[i] = *(const GAS f32x4*)(wp + (size_t)(8 * i) * N);
#pragma unroll
        for (int i = 0; i < 8; ++i) { LAS float* d = scr + (8 * i + rr) * 33 + q4; const float gs = gk ? gk[k0 + 8 * i + rr] : 1.0f;
            d[0] = v[i].x * gs; d[1] = v[i].y * gs; d[2] = v[i].z * gs; d[3] = v[i].w * gs; } }
    LDS_WAIT(); asm volatile("" ::: "memory");
    const int c = lane & 7;
#pragma unroll
    for (int j = 0; j < 4; ++j) { const int n = (lane >> 3) + 8 * j; const LAS float* s = scr + (8 * c) * 33 + n;
        v4u o; o.x = pk2(s[0 * 33], s[1 * 33]); o.y = pk2(s[2 * 33], s[3 * 33]); o.z = pk2(s[4 * 33], s[5 * 33]); o.w = pk2(s[6 * 33], s[7 * 33]);
        *(GAS v4u*)(WT + (size_t)(r0 + n) * K + k0 + 8 * c) = o; }
    LDS_WAIT(); asm volatile("" ::: "memory");
}
__device__ __forceinline__ void xg_row_to_bf16(const float* xrow, const float* g, bf16* orow, float* ss, int lane) {
    const GAS f32x4* xr = (const GAS f32x4*)xrow + lane; (void)g;
    GAS unsigned long long* o8 = (GAS unsigned long long*)orow + lane; float s = 0.f;
#pragma unroll
    for (int j = 0; j < 8; ++j) { const f32x4 v = xr[64 * j]; s += (v.x * v.x + v.y * v.y) + (v.z * v.z + v.w * v.w);
        o8[64 * j] = (unsigned long long)pk2(v.x, v.y) | ((unsigned long long)pk2(v.z, v.w) << 32); }
    s = wave_sum(s);
    if (lane == 0) *ss = s;
}
struct Weights { const float *ev_w_in, *ev_w_out, *od_w_in, *od_w_out, *ev_ln_g, *od_ln_g; };
__device__ __forceinline__ void convert_set(LAS unsigned char* lds, int wave, int lane, const Weights& W, unsigned char* ws, const int set, const int gw, const int NGW) {
    LAS float* scr = (LAS float*)(lds + RING_OFF + wave * 16384);
    constexpr int I_EI = (DMODEL / 64) * (EV_IN / 32), I_EO = (DMODEL / 64) * (DMODEL / 32), I_OI = (DMODEL / 64) * (OD_IN / 32), I_OO = (CWID / 64) * (DMODEL / 32);
    if (set == 0) {
        for (int it = gw; it < 2 * I_EI; it += NGW) { const int j = it / I_EI, r = it % I_EI;
            p0_transpose_item(W.ev_w_in + (size_t)j * DMODEL * EV_IN, DMODEL, EV_IN, (bf16*)(ws + WS_EWIN + j * SZ_EWIN), scr, r, lane, 1, W.ev_ln_g + j * DMODEL); }
    } else {
        const int j = set - 1;
        for (int it = gw; it < I_EO + I_OI + I_OO; it += NGW) { int r = it;
            if (r < I_OI) { p0_transpose_item(W.od_w_in + (size_t)j * DMODEL * OD_IN, DMODEL, OD_IN, (bf16*)(ws + WS_OWIN + j * SZ_OWIN), scr, r, lane, 2, W.od_ln_g + j * DMODEL); continue; } r -= I_OI;
            if (r < I_OO) { p0_transpose_item(W.od_w_out + (size_t)j * CWID * DMODEL, CWID, DMODEL, (bf16*)(ws + WS_OWOUT + j * SZ_OWOUT), scr, r, lane, 0); continue; } r -= I_OO;
            p0_transpose_item(W.ev_w_out + (size_t)j * DMODEL * DMODEL, DMODEL, DMODEL, (bf16*)(ws + WS_EWOUT + j * SZ_EWOUT), scr, r, lane, 0); }
    }
}
__device__ __forceinline__ void ph_prologue(LAS unsigned char* lds, int wave, int lane, int vcu, int G, const Weights& W, unsigned char* ws, const float* x, const float* g0) {
    const int gw = vcu * NWAVES + wave, NGW = G * NWAVES;
    convert_set(lds, wave, lane, W, ws, 0, gw, NGW);
#if PROBE_FULLPRO
    convert_set(lds, wave, lane, W, ws, 1, gw, NGW); convert_set(lds, wave, lane, W, ws, 2, gw, NGW);
#endif
    float* ssx0 = (float*)(ws + WS_CTL) + CW_SSX;
    for (int m = gw; m < MROWS; m += NGW) xg_row_to_bf16(x + (size_t)m * DMODEL, g0, (bf16*)(ws + WS_XN) + (size_t)m * DMODEL, ssx0 + m, lane);
}


namespace att {
using bf16x8 = __attribute__((ext_vector_type(8))) short;
using s16x4 = __attribute__((ext_vector_type(4))) short;
using f32x16 = __attribute__((ext_vector_type(16))) float;
using u32x4 = __attribute__((ext_vector_type(4))) unsigned;
typedef short v4i16_t __attribute__((ext_vector_type(4)));
typedef float f32x2_t __attribute__((ext_vector_type(2))); typedef __bf16 bf16x2_t __attribute__((ext_vector_type(2)));
constexpr int ZP = 6400, YP = 2048, SLOTB = 8192;
constexpr int L_K = 0, L_V = 16384, L_LUT = 32768, L_WS = 43008, L_OST = 45056, L_END = 77824;
constexpr int LUT_N = 2304, LUT_OFF = 256;
constexpr float LOG2E = 1.4426950408889634f;
__device__ __forceinline__ int crow(int r, int hi) { return (r & 3) + 8 * (r >> 2) + 4 * hi; }
__device__ __forceinline__ void glds16(const void* gsrc, unsigned lds_dst) { unsigned keep;
    asm volatile("s_mov_b32 %0, m0\n\ts_mov_b32 m0, %2\n\ts_nop 0\n\tglobal_load_lds_dwordx4 %1, off\n\ts_mov_b32 m0, %0" : "=&s"(keep) : "v"(gsrc), "s"(lds_dst) : "memory"); }
__device__ __forceinline__ unsigned cvtpk_s(float lo, float hi) { f32x2_t v = {lo, hi}; bf16x2_t b = __builtin_convertvector(v, bf16x2_t); return __builtin_bit_cast(unsigned, b); }
#define ATT_WAIT_BAR() asm volatile("s_waitcnt vmcnt(0) lgkmcnt(0)\n\ts_barrier" ::: "memory")
#define ATT_SBAR() __builtin_amdgcn_sched_barrier(0)
__device__ __forceinline__ void pv(f32x16* o, int vb, bf16x8 pa0, bf16x8 pa1, bf16x8 pa2, bf16x8 pa3) {
#pragma unroll
    for (int d0 = 0; d0 < 2; ++d0) { s16x4 lo[4], hi[4];
#pragma unroll
        for (int ks = 0; ks < 4; ++ks) {
            asm volatile("ds_read_b64_tr_b16 %0,%1 offset:%c2" : "=&v"(lo[ks]) : "v"(vb), "i"(d0 * 4096 + ks * 1024) : "memory");
            asm volatile("ds_read_b64_tr_b16 %0,%1 offset:%c2" : "=&v"(hi[ks]) : "v"(vb), "i"(d0 * 4096 + ks * 1024 + 512) : "memory"); }
        asm volatile("s_waitcnt lgkmcnt(0)" ::: "memory"); ATT_SBAR();
#define ATT_PK(k) (bf16x8){lo[k][0], lo[k][1], lo[k][2], lo[k][3], hi[k][0], hi[k][1], hi[k][2], hi[k][3]}
        o[d0] = __builtin_amdgcn_mfma_f32_32x32x16_bf16(pa0, ATT_PK(0), o[d0], 0, 0, 0);
        o[d0] = __builtin_amdgcn_mfma_f32_32x32x16_bf16(pa1, ATT_PK(1), o[d0], 0, 0, 0);
        o[d0] = __builtin_amdgcn_mfma_f32_32x32x16_bf16(pa2, ATT_PK(2), o[d0], 0, 0, 0);
        o[d0] = __builtin_amdgcn_mfma_f32_32x32x16_bf16(pa3, ATT_PK(3), o[d0], 0, 0, 0);
#undef ATT_PK
    }
}
__device__ __forceinline__ void attn_unit(const int b, const int hh, const int qb, const bf16* Z, bf16* Y, const float* qkg, const float* sinks, const float* relb, LAS unsigned char* shm, const int tid) {
    const bool isB = hh >= 16; const int h = hh & 15;
    const int lane = tid & 63, r32 = lane & 31, hi = lane >> 5; const int wid = __builtin_amdgcn_readfirstlane(tid >> 6);
    const int qcol = isB ? 2304 + h * 64 : h * 64;
    const int kcol = isB ? 3328 + h * 64 : 1024 + (h >> 3) * 64;
    const int vcol = isB ? 4352 + h * 64 : 1152 + (h >> 3) * 64;
    const int gcol = isB ? 5376 + h * 64 : 1280 + h * 64;
    const int ycol = (isB ? 1024 : 0) + h * 64;
    const float* gq = qkg + (isB ? 128 : 0); const float* gk = qkg + (isB ? 192 : 64);
    const long rowbase = (long)b * SEQ; const int q0 = qb * 256;
    const int t_hi = 4 * qb + 3, t_lo = isB ? 0 : (qb > 0 ? 4 * qb - 2 : 0);
    float maxg = 0.f, maxb = 0.f;
    for (int d = 0; d < 64; ++d) maxg = fmaxf(maxg, fabsf(gq[d] * gk[d]));
    for (int k = 0; k < 32; ++k) maxb = fmaxf(maxb, fabsf(relb[k * 32 + hh]));
    const float M0 = (8.0f * maxg + maxb) * LOG2E + 1.5849625f + 0.25f;
    LAS float* lut = (LAS float*)(shm + L_LUT);
    for (int i = tid; i < LUT_N; i += 512) { const int d = i - LUT_OFF; float val = -1e30f;
        if (d >= 0) { const int w = isB ? ((d <= 128 ? 1 : 0) + (((d & 3) == 0 && d <= 512) ? 1 : 0) + (((d & 15) == 0) ? 1 : 0)) : (d <= 127 ? 1 : 0);
            if (w > 0) val = relb[t5_bucket(d) * 32 + hh] * LOG2E + (w == 1 ? 0.f : (w == 2 ? 1.0f : 1.5849625f)) - M0; }
        lut[i] = val; }
    const bf16* Qw = Z + (rowbase + q0 + wid * 32) * ZP + qcol;
    bf16x8 qr[4];
#pragma unroll
    for (int d0 = 0; d0 < 4; ++d0) qr[d0] = *reinterpret_cast<const bf16x8*>(Qw + (long)r32 * ZP + d0 * 16 + hi * 8);
    const unsigned lds0 = (unsigned)(uintptr_t)shm;
    const bf16* ksrc = Z + (rowbase + lane) * ZP + kcol + wid * 8;
    const bf16* vsrc = Z + (rowbase + 16 * (wid & 3) + (lane >> 2)) * ZP + vcol + (wid >> 2) * 32 + (lane & 3) * 8;
    const unsigned kdst = lds0 + L_K + wid * 1024, vdst = lds0 + L_V + wid * 1024;
#define ATT_DMA(t, slot) do { glds16(ksrc + (long)(t) * 64 * ZP, (unsigned)__builtin_amdgcn_readfirstlane(kdst + (slot))); glds16(vsrc + (long)(t) * 64 * ZP, (unsigned)__builtin_amdgcn_readfirstlane(vdst + (slot))); } while (0)
    const int vb0 = (int)(lds0 + L_V) + ((lane >> 4) & 1) * 32 + (lane & 3) * 8 + (4 * hi + ((lane & 15) >> 2)) * 64;
    const LAS unsigned char* kp0 = shm + L_K + hi * 1024 + r32 * 16;
    ATT_DMA(t_lo, 0);
    f32x16 o[2]; o[0] = f32x16{}; o[1] = f32x16{}; float l_reg = 0.f;
    const int qlo = q0 + wid * 32;
    int slot = 0;
    for (int t = t_lo; t <= t_hi; ++t) {
        ATT_WAIT_BAR();
        if (t < t_hi) ATT_DMA(t + 1, slot ^ SLOTB);
        const int klo = 64 * t;
        const bool active = (klo <= qlo + 31) && (isB || (klo + 63 >= qlo - 127));
        if (active) {
            const LAS unsigned char* kp = kp0 + slot;
            f32x16 p0, p1;
#pragma unroll
            for (int d0 = 0; d0 < 4; ++d0) {
                const bf16x8 b0 = *(const LAS bf16x8*)(kp + d0 * 2048), b1 = *(const LAS bf16x8*)(kp + d0 * 2048 + 512);
                if (d0 == 0) { p0 = __builtin_amdgcn_mfma_f32_32x32x16_bf16(b0, qr[0], f32x16{}, 0, 0, 0); p1 = __builtin_amdgcn_mfma_f32_32x32x16_bf16(b1, qr[0], f32x16{}, 0, 0, 0); }
                else { p0 = __builtin_amdgcn_mfma_f32_32x32x16_bf16(b0, qr[d0], p0, 0, 0, 0); p1 = __builtin_amdgcn_mfma_f32_32x32x16_bf16(b1, qr[d0], p1, 0, 0, 0); } }
            const LAS float* lp = lut + (qlo + r32 - klo - 4 * hi + LUT_OFF);
            float sacc = 0.f;
#pragma unroll
            for (int r = 0; r < 16; ++r) { const int c = (r & 3) + 8 * (r >> 2);
                p0[r] = __builtin_amdgcn_exp2f(p0[r] + lp[-c]); p1[r] = __builtin_amdgcn_exp2f(p1[r] + lp[-c - 32]); sacc += p0[r] + p1[r]; }
            l_reg += sacc;
            u32x4 pw0, pw1, pw2, pw3;
            pw0 = (u32x4){cvtpk_s(p0[0], p0[1]), cvtpk_s(p0[2], p0[3]), cvtpk_s(p0[4], p0[5]), cvtpk_s(p0[6], p0[7])};
            pw1 = (u32x4){cvtpk_s(p0[8], p0[9]), cvtpk_s(p0[10], p0[11]), cvtpk_s(p0[12], p0[13]), cvtpk_s(p0[14], p0[15])};
            pw2 = (u32x4){cvtpk_s(p1[0], p1[1]), cvtpk_s(p1[2], p1[3]), cvtpk_s(p1[4], p1[5]), cvtpk_s(p1[6], p1[7])};
            pw3 = (u32x4){cvtpk_s(p1[8], p1[9]), cvtpk_s(p1[10], p1[11]), cvtpk_s(p1[12], p1[13]), cvtpk_s(p1[14], p1[15])};
            ATT_SBAR();
            pv(o, vb0 + slot, __builtin_bit_cast(bf16x8, pw0), __builtin_bit_cast(bf16x8, pw1), __builtin_bit_cast(bf16x8, pw2), __builtin_bit_cast(bf16x8, pw3));
        }
        slot ^= SLOTB;
    }
#undef ATT_DMA
    { auto rr = __builtin_amdgcn_permlane32_swap(__float_as_uint(l_reg), __float_as_uint(l_reg), false, false); l_reg = __uint_as_float(rr[0]) + __uint_as_float(rr[1]); }
    if (!isB) l_reg += __builtin_amdgcn_exp2f(sinks[h] * LOG2E - M0);
    LAS float* wsf = (LAS float*)(shm + L_WS) + wid * 64;
    if (hi == 0) wsf[32 + r32] = l_reg;
    asm volatile("s_waitcnt lgkmcnt(0)" ::: "memory");
    float rli[16];
#pragma unroll
    for (int r = 0; r < 16; ++r) rli[r] = __builtin_amdgcn_rcpf(wsf[32 + crow(r, hi)]);
    { LAS bf16* stg = (LAS bf16*)(shm + L_OST) + wid * 2048;
#pragma unroll
        for (int r = 0; r < 16; ++r) { const int orow = crow(r, hi);
#pragma unroll
            for (int d0 = 0; d0 < 2; ++d0) stg[orow * 64 + d0 * 32 + r32] = (bf16)f2bf(o[d0][r] * rli[r]); }
        asm volatile("s_waitcnt lgkmcnt(0)" ::: "memory");
#pragma unroll
        for (int i = 0; i < 4; ++i) { const int row = i * 8 + (lane >> 3), ch = lane & 7;
            const u32x4 v = *(const LAS u32x4*)(stg + row * 64 + ch * 8);
            const u32x4 g = *(const GAS u32x4*)(Z + (rowbase + q0 + wid * 32 + row) * ZP + gcol + ch * 8);
            u32x4 w;
            w.x = pk2(__uint_as_float(v.x << 16) * __uint_as_float(g.x << 16), __uint_as_float(v.x & 0xffff0000u) * __uint_as_float(g.x & 0xffff0000u));
            w.y = pk2(__uint_as_float(v.y << 16) * __uint_as_float(g.y << 16), __uint_as_float(v.y & 0xffff0000u) * __uint_as_float(g.y & 0xffff0000u));
            w.z = pk2(__uint_as_float(v.z << 16) * __uint_as_float(g.z << 16), __uint_as_float(v.z & 0xffff0000u) * __uint_as_float(g.z & 0xffff0000u));
            w.w = pk2(__uint_as_float(v.w << 16) * __uint_as_float(g.w << 16), __uint_as_float(v.w & 0xffff0000u) * __uint_as_float(g.w & 0xffff0000u));
            *(GAS u32x4*)(Y + (rowbase + q0 + wid * 32 + row) * YP + ycol + ch * 8) = w; } }
    asm volatile("s_waitcnt lgkmcnt(0)\n\ts_barrier" ::: "memory");
}
__device__ __forceinline__ void attn_phase(const bf16* Z, bf16* Y, const float* qkg, const float* sinks, const float* relb, LAS unsigned char* shm, int vcu, int G, int tid) {
    for (int u = vcu; u < 1024; u += G) {
        const int i = u >> 8, v = u & 255, bh = v >> 2, s = v & 3, b = bh >> 4, h = bh & 15;
        const int qb = (i == 0) ? 7 - s : (i == 1) ? s : (i == 2) ? 2 * s : 2 * s + 1;
        attn_unit(b, (i < 2) ? 16 + h : h, qb, Z, Y, qkg, sinks, relb, shm, tid);
    }
}
#undef ATT_WAIT_BAR
#undef ATT_SBAR
}

namespace mix {
using bf16x8 = __attribute__((ext_vector_type(8))) short;
using s16x4 = __attribute__((ext_vector_type(4))) short;
using f32x16 = __attribute__((ext_vector_type(16))) float;
using u32x4 = __attribute__((ext_vector_type(4))) unsigned;
constexpr int L_V = 0, L_STG = 65536, L_RS = RING_BYTES + 2048;
#define MIX_DMA_V(ch_, g_) do { const bf16* src_ = V + (size_t)((ch_) * 128 + (lane >> 2)) * CWID + 256 * (g_) + 32 * wid + (lane & 3) * 8; \
    _Pragma("unroll") for (int kg = 0; kg < 8; ++kg) att::glds16(src_ + (size_t)(16 * kg) * CWID, (unsigned)__builtin_amdgcn_readfirstlane(lds0 + L_V + (wid * 8 + kg) * 1024)); } while (0)
__device__ __forceinline__ void mix_phase(const bf16* UG, const bf16* V, bf16* Y, const float* ssv, const float* vg, const float* wsp, const float* bsp, LAS unsigned char* shm, int vcu, int G, const int tid) {
    const int lane = tid & 63, r32 = lane & 31, hi = lane >> 5; const int wid = __builtin_amdgcn_readfirstlane(tid >> 6);
    const int tb = wid & 3, ch2 = wid >> 2, nks = 2 * tb + 2;
    LAS float* rs = (LAS float*)(shm + L_RS);
    const unsigned lds0 = (unsigned)(uintptr_t)shm;
    const int vb = (int)(lds0 + L_V) + ch2 * 32768 + ((lane >> 4) & 1) * 32 + (lane & 3) * 8 + (4 * hi + ((lane & 15) >> 2)) * 64;
    LAS bf16* stg = (LAS bf16*)(shm + L_STG) + wid * 4096;
    int u = vcu;
    if (u < 1024) { if (tid < 128) rs[tid] = __builtin_amdgcn_rsqf(ssv[(u >> 4) * 128 + tid] * (1.f / 4096.f) + EPS); MIX_DMA_V(u >> 4, u & 15); }
    for (; u < 1024; u += G) {
        const int ch = u >> 4, g = u & 15, row0 = ch * 128;
        const int t = 32 * tb + r32; const float* wrow = wsp + ((size_t)g * 128 + t) * 128 + 4 * hi;
        f32x4 wa[8][2];
#pragma unroll
        for (int ks = 0; ks < 8; ++ks) if (ks < nks) { wa[ks][0] = *(const GAS f32x4*)(wrow + 16 * ks); wa[ks][1] = *(const GAS f32x4*)(wrow + 16 * ks + 8); }
        asm volatile("s_waitcnt vmcnt(0) lgkmcnt(0)\n\ts_barrier" ::: "memory");
        bf16x8 af[8];
#pragma unroll
        for (int ks = 0; ks < 8; ++ks) { af[ks] = bf16x8{};
            if (ks < nks) { const int s0 = 16 * ks + 4 * hi;
                f32x4 a = wa[ks][0] * *(const LAS f32x4*)(rs + s0), b = wa[ks][1] * *(const LAS f32x4*)(rs + s0 + 8);
                a.x = (s0 + 0 <= t) ? a.x : 0.f; a.y = (s0 + 1 <= t) ? a.y : 0.f; a.z = (s0 + 2 <= t) ? a.z : 0.f; a.w = (s0 + 3 <= t) ? a.w : 0.f;
                b.x = (s0 + 8 <= t) ? b.x : 0.f; b.y = (s0 + 9 <= t) ? b.y : 0.f; b.z = (s0 + 10 <= t) ? b.z : 0.f; b.w = (s0 + 11 <= t) ? b.w : 0.f;
                u32x4 w; w.x = pk2(a.x, a.y); w.y = pk2(a.z, a.w); w.z = pk2(b.x, b.y); w.w = pk2(b.z, b.w);
                af[ks] = __builtin_bit_cast(bf16x8, w); } }
        f32x16 acc[4];
#pragma unroll
        for (int nb = 0; nb < 4; ++nb) { acc[nb] = f32x16{};
#pragma unroll
            for (int ks = 0; ks < 8; ++ks) { if (ks < nks) { s16x4 lo, hh;
                asm volatile("ds_read_b64_tr_b16 %0,%1 offset:%c2" : "=&v"(lo) : "v"(vb), "i"(nb * 8192 + ks * 1024) : "memory");
                asm volatile("ds_read_b64_tr_b16 %0,%1 offset:%c2" : "=&v"(hh) : "v"(vb), "i"(nb * 8192 + ks * 1024 + 512) : "memory");
                asm volatile("s_waitcnt lgkmcnt(0)" ::: "memory"); __builtin_amdgcn_sched_barrier(0);
                const bf16x8 bfr = (bf16x8){lo[0], lo[1], lo[2], lo[3], hh[0], hh[1], hh[2], hh[3]};
                acc[nb] = __builtin_amdgcn_mfma_f32_32x32x16_bf16(af[ks], bfr, acc[nb], 0, 0, 0); } } }
        asm volatile("s_waitcnt lgkmcnt(0)\n\ts_barrier" ::: "memory");
        { const int un = u + G; if (un < 1024) { if (tid < 128) rs[tid] = __builtin_amdgcn_rsqf(ssv[(un >> 4) * 128 + tid] * (1.f / 4096.f) + EPS); MIX_DMA_V(un >> 4, un & 15); } }
#pragma unroll
        for (int nb = 0; nb < 4; ++nb) { const float gv = vg[256 * g + 128 * ch2 + 32 * nb + r32];
#pragma unroll
            for (int r = 0; r < 16; ++r) { const int tl = (r & 3) + 8 * (r >> 2) + 4 * hi;
                stg[tl * 128 + 32 * nb + r32] = (bf16)f2bf(acc[nb][r] * gv + bsp[g * 128 + 32 * tb + tl]); } }
        asm volatile("s_waitcnt lgkmcnt(0)" ::: "memory");
#pragma unroll
        for (int i = 0; i < 8; ++i) { const int row = i * 4 + (lane >> 4), chk = lane & 15;
            const u32x4 s = *(const LAS u32x4*)(stg + row * 128 + chk * 8);
            const size_t idx = (size_t)(row0 + 32 * tb + row) * CWID + 256 * g + 128 * ch2 + chk * 8;
            const u32x4 q = *(const GAS u32x4*)(UG + idx);
            u32x4 w;
            w.x = pk2(__uint_as_float(s.x << 16) * __uint_as_float(q.x << 16), __uint_as_float(s.x & 0xffff0000u) * __uint_as_float(q.x & 0xffff0000u));
            w.y = pk2(__uint_as_float(s.y << 16) * __uint_as_float(q.y << 16), __uint_as_float(s.y & 0xffff0000u) * __uint_as_float(q.y & 0xffff0000u));
            w.z = pk2(__uint_as_float(s.z << 16) * __uint_as_float(q.z << 16), __uint_as_float(s.z & 0xffff0000u) * __uint_as_float(q.z & 0xffff0000u));
            w.w = pk2(__uint_as_float(s.w << 16) * __uint_as_float(q.w << 16), __uint_as_float(s.w & 0xffff0000u) * __uint_as_float(q.w & 0xffff0000u));
            *(GAS u32x4*)(Y + idx) = w; }
        asm volatile("s_waitcnt lgkmcnt(0)" ::: "memory");
    }
}
#undef MIX_DMA_V
}

struct Args { const float* in[13]; float* out; unsigned char* ws; int ph_lo, ph_hi; };
__global__ void __launch_bounds__(NWAVES * 64, 2) skel_fwd(Args args) {
    extern __shared__ __attribute__((aligned(16))) unsigned char lds_raw[];
    LAS unsigned char* lds = (LAS unsigned char*)lds_raw;
    const int G = gridDim.x; int vcu; { const int bx = blockIdx.x; vcu = (G % 8 == 0) ? (bx % 8) * (G / 8) + bx / 8 : bx; }
    unsigned char* ws = args.ws;
    gu32* ctl = (gu32*)(ws + WS_CTL);
    for (int u = threadIdx.x; u < (LDS_BYTES - LDSCTL_OFF) / 4; u += NWAVES * 64) ((LAS unsigned*)(lds + LDSCTL_OFF))[u] = 0u;
    __syncthreads();
    const int lo = args.ph_lo, hi = args.ph_hi;
    XcdBarrier bar; bar.bar = (unsigned*)(ctl + CW_BAR); bar.x = 0; bar.st = nullptr;
    if (hi - lo > 1) bar = xcd_barrier_post((unsigned*)(ctl + CW_BAR), (volatile LAS unsigned*)(lds + MISC_OFF) + 8);
    const float* x_in = args.in[0];
    const float *ev_ln_g = args.in[1], *ev_w_in = args.in[2], *ev_qk_g = args.in[3], *ev_sinks = args.in[4], *ev_w_out = args.in[5];
    const float *od_ln_g = args.in[6], *od_w_in = args.in[7], *od_v_g = args.in[8], *od_w_s = args.in[9], *od_b_s = args.in[10], *od_w_out = args.in[11], *rel_bias = args.in[12];
    float* out = args.out;
    bf16* XN = (bf16*)(ws + WS_XN); bf16* Z = (bf16*)(ws + WS_Z); bf16* VB = (bf16*)(ws + WS_Z + 64 * MiB); bf16* Y = (bf16*)(ws + WS_Y);
    float* ssx = (float*)(ws + WS_CTL) + CW_SSX; float* ssv = (float*)(ws + WS_CTL) + CW_SSV;

    for (int p = lo; p < hi; ++p) {
        int kind = PH_PRO, layer = 0;
        if (p > 0) { layer = (p - 1) / 3; kind = 1 + (p - 1) % 3; }
        const int j = layer >> 1; const bool odd = (layer & 1) != 0;
#if DUP_MASK
        const int ndup = ((kind == PH_PRO && (DUP_MASK & 1)) || ((kind == PH_G1 || kind == PH_G2) && (DUP_MASK & 2)) || (kind == PH_G1 && !odd && (DUP_MASK & 16)) || (kind == PH_G1 && odd && (DUP_MASK & 32)) || (kind == PH_G2 && !odd && (DUP_MASK & 64)) || (kind == PH_G2 && odd && (DUP_MASK & 128)) || (kind == PH_MID && !odd && (DUP_MASK & 4)) || (kind == PH_MID && odd && (DUP_MASK & 8))) ? 2 : 1;
        for (int dup = 0; dup < ndup; ++dup) {
        if (dup > 0) xcd_barrier(bar);
        const bool dummy = (ndup == 2 && dup == 0);
#else
        const bool dummy = false;
#endif
        int tid = threadIdx.x; asm volatile("" : "+v"(tid));
        const int lane = tid & 63, wave = __builtin_amdgcn_readfirstlane(tid >> 6);
        if (kind == PH_PRO) {
            Weights W{ev_w_in, ev_w_out, od_w_in, od_w_out, ev_ln_g, od_ln_g};
            ph_prologue(lds, wave, lane, vcu, G, W, ws, x_in, ev_ln_g);
        } else if (kind == PH_G1) {
            pg8::Gemm g{XN, odd ? (const bf16*)(ws + WS_OWIN + j * SZ_OWIN) : (const bf16*)(ws + WS_EWIN + j * SZ_EWIN), MROWS, odd ? OD_IN : EV_IN, DMODEL};
            pg8::StaticOrder S; S.init(g.M, g.N, G, (int)blockIdx.x);
            if (odd) { pg8::EpiOdd E{Z, VB, ssx + layer * MROWS, dummy ? (float*)(ws + WS_Y) : ssv + j * MROWS}; pg8::gemm_phase<pg8::EpiOdd, pg8::StaticOrder, true, true>(lds + RING_OFF, g, S, E, tid); }
            else { pg8::EpiQKV E{Z, g.N, ev_qk_g + j * 256, ssx + layer * MROWS}; pg8::gemm_phase<pg8::EpiQKV, pg8::StaticOrder, true, true>(lds + RING_OFF, g, S, E, tid);
                if (!dummy && !(PROBE_FULLPRO)) { const int rem = (g.M / 256) * (g.N / 256) % G, c = (int)blockIdx.x;
                    Weights W{ev_w_in, ev_w_out, od_w_in, od_w_out, ev_ln_g, od_ln_g};
                    if (rem == 0) convert_set(lds, wave, lane, W, ws, 1 + j, c * NWAVES + wave, G * NWAVES);
                    else if (c >= rem) convert_set(lds, wave, lane, W, ws, 1 + j, (c - rem) * NWAVES + wave, (G - rem) * NWAVES); } }
        } else if (kind == PH_G2) {
            pg8::Gemm g{Y, odd ? (const bf16*)(ws + WS_OWOUT + j * SZ_OWOUT) : (const bf16*)(ws + WS_EWOUT + j * SZ_EWOUT), MROWS, DMODEL, odd ? CWID : DMODEL};
            pg8::StaticOrder S; S.init(g.M, g.N, G, (int)blockIdx.x);
            const int nl = layer + 1;
            pg8::EpiResB E{XN, (nl < 4 || dummy) ? (float*)nullptr : out, dummy ? (float*)(ws + WS_Z) : ssx + (nl & 3) * MROWS, dummy ? 1 : 0};
            pg8::gemm_phase<pg8::EpiResB, pg8::StaticOrder, true, true>(lds + RING_OFF, g, S, E, tid);
        } else if (!odd) {
            att::attn_phase(Z, Y, ev_qk_g + j * 256, ev_sinks + j * 16, rel_bias, lds + RING_OFF, vcu, G, tid);
        } else {
            mix::mix_phase(Z, VB, Y, ssv + j * MROWS, od_v_g + j * CWID, od_w_s + (size_t)j * 16 * 16384, od_b_s + j * 2048, lds + RING_OFF, vcu, G, tid);
        }
#if DUP_MASK
        }
#endif
        if (p + 1 < hi) xcd_barrier(bar);
    }
}

extern "C" void kernel_launch(void* const* d_in, const int* in_sizes, int n_in, void* d_out, int out_size, void* d_ws, size_t ws_size, hipStream_t stream) {
    static int grid = 0;
    if (grid == 0) {
        if (n_in != 13 || out_size != MROWS * DMODEL || ws_size < WS_END) { fprintf(stderr, "kernel_launch: unexpected shapes (n_in %d out %d ws %zu)\n", n_in, out_size, ws_size); grid = -1; return; }
        int dev = 0, cus = 0;
        if (hipGetDevice(&dev) != hipSuccess || hipDeviceGetAttribute(&cus, hipDeviceAttributeMultiprocessorCount, dev) != hipSuccess) { grid = -1; return; }
        if (hipFuncSetAttribute((const void*)skel_fwd, hipFuncAttributeMaxDynamicSharedMemorySize, LDS_BYTES) != hipSuccess) { fprintf(stderr, "kernel_launch: hipFuncSetAttribute failed\n"); grid = -1; return; }
        int per_cu = 0;
        (void)hipOccupancyMaxActiveBlocksPerMultiprocessor(&per_cu, (const void*)skel_fwd, NWAVES * 64, LDS_BYTES);
        (void)hipGetLastError();
        grid = cus;
    }
    if (grid < 0) return;
    (void)hipMemsetAsync((char*)d_ws + WS_CTL, 0, CTL_ZERO_BYTES, stream);
    Args a{};
    for (int i = 0; i < 13; ++i) a.in[i] = (const float*)d_in[i];
    a.out = (float*)d_out; a.ws = (unsigned char*)d_ws;
#if MK_ONE_LAUNCH
    a.ph_lo = 0; a.ph_hi = NPHASE;
    hipLaunchKernelGGL(skel_fwd, dim3(grid), dim3(NWAVES * 64), LDS_BYTES, stream, a);
#else
    for (int p = 0; p < NPHASE; ++p) { a.ph_lo = p; a.ph_hi = p + 1; hipLaunchKernelGGL(skel_fwd, dim3(grid), dim3(NWAVES * 64), LDS_BYTES, stream, a); }
#endif
}
```

```cpp
#include <hip/hip_runtime.h>
#include <cstdio>
#include <cstdint>
#define MK_ONE_LAUNCH 1
#define DUP_MASK 0
#define PROBE_FULLPRO 1

namespace pg8 {
#define PG8_LAS __attribute__((address_space(3)))
typedef unsigned short bf16_t;
typedef short bf16x8 __attribute__((ext_vector_type(8)));
typedef float f32x4 __attribute__((ext_vector_type(4)));
typedef unsigned u32x4 __attribute__((ext_vector_type(4)));
constexpr int BM = 256, BK = 64, HALF = 128, HTB = HALF * BK * 2  , STAGE_BYTES = 8 * HTB, NXCD = 8, WGM = 8;

__host__ __device__ __forceinline__ int lds_byte(int r, int c) { const int st = (r >> 4) * 2 + (c >> 5), rr = r & 15, cc = c & 31, ob = rr * 64 + cc * 2; return st * 1024 + (ob ^ (((ob >> 9) & 1) << 5)); }
__host__ __device__ __forceinline__ void stage_rc(int b, int& R, int& C) { const int st = b / 1024, sb = b % 1024, swz = sb ^ (((sb >> 9) & 1) << 5); R = (st >> 1) * 16 + swz / 64; C = (st & 1) * 32 + (swz % 64) / 2; }
__host__ __device__ __forceinline__ int perm32(int rho) { const int n = rho >> 4, i = rho & 15; return 8 * (i >> 2) + 4 * n + (i & 3); }

struct Unit { int pm, pn; };
struct Gemm { const bf16_t* A; const bf16_t* Bt; int M, N, K; };

struct StaticOrder {
    int nM, nN, nwg, G, c;
    __host__ __device__ void init(int M, int N, int G_, int c_) { nM = M / BM; nN = N / BM; nwg = nM * nN; G = G_; c = c_; }
    __host__ __device__ bool next(int i, Unit& u) const {
        const long L = (long)i * G + c; if (L >= nwg) return false;
        int wgid = (int)L; { const int q = nwg / NXCD, r = nwg % NXCD, xcd = wgid % NXCD, off = wgid / NXCD; wgid = (xcd < r ? xcd * (q + 1) : r * (q + 1) + (xcd - r) * q) + off; }
        const int nig = WGM * nN, gid = wgid / nig, fm = gid * WGM, gsz = (nM - fm) < WGM ? (nM - fm) : WGM;
        u.pm = fm + ((wgid % nig) % gsz); u.pn = (wgid % nig) / gsz; return true;
    }
    __device__ __forceinline__ void a_ready(const Unit&) const {}
    __device__ __forceinline__ void done(const Unit&) const {}
};

__device__ __forceinline__ unsigned cvt_pk_bf16(float lo, float hi) { unsigned r; asm volatile("v_cvt_pk_bf16_f32 %0, %1, %2" : "=v"(r) : "v"(lo), "v"(hi)); return r; }
typedef float f32x2 __attribute__((ext_vector_type(2)));
__device__ __forceinline__ f32x2 gelu_pk(f32x2 v) {
    const f32x2 av = __builtin_elementwise_abs(v), d = av * 0.2316418882f + 1.0f;
    f32x2 t; t.x = __builtin_amdgcn_rcpf(d.x); t.y = __builtin_amdgcn_rcpf(d.y);
    f32x2 q = t * 0.5307027145f + (-0.7265760135f); q = q * t + 0.7107068705f; q = q * t + (-0.142248368f); q = q * t + 0.127414796f; q = q * t;
    const f32x2 s = (v * v) * (-0.72134752044f);
    f32x2 e; e.x = __builtin_amdgcn_exp2f(s.x); e.y = __builtin_amdgcn_exp2f(s.y);
    const f32x2 m = v * (q * e), r = v - m;
    f32x2 o; o.x = v.x < 0.f ? m.x : r.x; o.y = v.y < 0.f ? m.y : r.y; return o;
}


__device__ __forceinline__ float silu_f(float x) { return x * __builtin_amdgcn_rcpf(1.0f + __builtin_amdgcn_exp2f(-1.4426950408889634f * x)); }
struct EpiAct {
    static constexpr bool PERM = true, AFTER_DRAIN = false;
    bf16_t* O; int ldc; int gelu_below; int silu_from;
    __device__ __forceinline__ void operator()(const f32x4 (&acc)[2][2][4][2], const Unit& u, int wr, int wc, int fr, int fq) const {
        const int row0 = u.pm * BM + wr * 64 + fr, col0 = u.pn * BM + wc * 32 + 8 * fq;
        const int mode = (u.pn < gelu_below) ? 1 : ((u.pn >= silu_from) ? 2 : 0);
#pragma unroll
        for (int ai = 0; ai < 2; ++ai)
#pragma unroll
            for (int m = 0; m < 4; ++m) { bf16_t* rowp = O + (size_t)(row0 + ai * HALF + m * 16) * ldc + col0;
#pragma unroll
                for (int bj = 0; bj < 2; ++bj) { f32x4 v0 = acc[ai][bj][m][0], v1 = acc[ai][bj][m][1];
                    if (mode == 1) { f32x2 a = gelu_pk((f32x2){v0[0], v0[1]}), b = gelu_pk((f32x2){v0[2], v0[3]}), c = gelu_pk((f32x2){v1[0], v1[1]}), d = gelu_pk((f32x2){v1[2], v1[3]});
                        v0 = (f32x4){a.x, a.y, b.x, b.y}; v1 = (f32x4){c.x, c.y, d.x, d.y}; }
                    else if (mode == 2) { v0 = (f32x4){silu_f(v0[0]), silu_f(v0[1]), silu_f(v0[2]), silu_f(v0[3])}; v1 = (f32x4){silu_f(v1[0]), silu_f(v1[1]), silu_f(v1[2]), silu_f(v1[3])}; }
                    u32x4 w; w.x = cvt_pk_bf16(v0[0], v0[1]); w.y = cvt_pk_bf16(v0[2], v0[3]); w.z = cvt_pk_bf16(v1[0], v1[1]); w.w = cvt_pk_bf16(v1[2], v1[3]);
                    *(u32x4*)(rowp + bj * HALF) = w; } }
    }
};
struct EpiRes {
    static constexpr bool PERM = false, AFTER_DRAIN = false;
    const float* base; float* out; int ldc;
    __device__ __forceinline__ void operator()(const f32x4 (&acc)[2][2][4][2], const Unit& u, int wr, int wc, int fr, int fq) const {
        const int row0 = u.pm * BM + wr * 64 + fr, col0 = u.pn * BM + wc * 32 + 4 * fq;
#pragma unroll
        for (int ai = 0; ai < 2; ++ai)
#pragma unroll
            for (int m = 0; m < 4; ++m) { const size_t off = (size_t)(row0 + ai * HALF + m * 16) * ldc + col0;
#pragma unroll
                for (int bj = 0; bj < 2; ++bj)
#pragma unroll
                    for (int n = 0; n < 2; ++n) { const f32x4 bs = *(const f32x4*)(base + off + bj * HALF + n * 16); *(f32x4*)(out + off + bj * HALF + n * 16) = bs + acc[ai][bj][m][n]; } }
    }
};

struct EpiQKV {
    static constexpr bool PERM = true, AFTER_DRAIN = false;
    bf16_t* O; int ldc; const float* qkg; const float* ssx;
    __device__ __forceinline__ void operator()(const f32x4 (&acc)[2][2][4][2], const Unit& u, int wr, int wc, int fr, int fq) const {
        const int row0 = u.pm * BM + wr * 64 + fr, colw = u.pn * BM + wc * 64;
        int mode = 0; const float* gv = qkg; float sc = 1.f;
        if (colw < 1024) { mode = 1; gv = qkg; sc = 0.125f * 1.4426950408889634f; }
        else if (colw < 1152) { mode = 1; gv = qkg + 64; }
        else if (colw < 1280) { mode = 0; }
        else if (colw < 2304) { mode = 2; }
        else if (colw < 3328) { mode = 1; gv = qkg + 128; sc = 0.125f * 1.4426950408889634f; }
        else if (colw < 4352) { mode = 1; gv = qkg + 192; }
        else if (colw < 5376) { mode = 0; }
        else { mode = 2; }
        f32x4 gg[2][2];
#pragma unroll
        for (int bj = 0; bj < 2; ++bj)
#pragma unroll
            for (int n = 0; n < 2; ++n) gg[bj][n] = (mode == 1) ? *(const f32x4*)(gv + 32 * bj + 8 * fq + 4 * n) * sc : (f32x4){1.f, 1.f, 1.f, 1.f};
#pragma unroll
        for (int ai = 0; ai < 2; ++ai)
#pragma unroll
            for (int m = 0; m < 4; ++m) { bf16_t* rowp = O + (size_t)(row0 + ai * HALF + m * 16) * ldc + colw + 8 * fq;
                f32x4 v[2][2];
                const float rx = __builtin_amdgcn_rsqf(ssx[row0 + ai * HALF + m * 16] * (1.f / 2048.f) + 1e-6f);
#pragma unroll
                for (int bj = 0; bj < 2; ++bj)
#pragma unroll
                    for (int n = 0; n < 2; ++n) v[bj][n] = acc[ai][bj][m][n] * rx;
                if (mode == 1) { float ss = 0.f;
#pragma unroll
                    for (int bj = 0; bj < 2; ++bj)
#pragma unroll
                        for (int n = 0; n < 2; ++n) ss += (v[bj][n][0] * v[bj][n][0] + v[bj][n][1] * v[bj][n][1]) + (v[bj][n][2] * v[bj][n][2] + v[bj][n][3] * v[bj][n][3]);
                    ss += __shfl_xor(ss, 16); ss += __shfl_xor(ss, 32);
                    const float r = __builtin_amdgcn_rsqf(ss * (1.f / 64.f) + 1e-6f);
#pragma unroll
                    for (int bj = 0; bj < 2; ++bj)
#pragma unroll
                        for (int n = 0; n < 2; ++n) v[bj][n] = v[bj][n] * r * gg[bj][n]; }
                else if (mode == 2) {
#pragma unroll
                    for (int bj = 0; bj < 2; ++bj)
#pragma unroll
                        for (int n = 0; n < 2; ++n) v[bj][n] = (f32x4){silu_f(v[bj][n][0]), silu_f(v[bj][n][1]), silu_f(v[bj][n][2]), silu_f(v[bj][n][3])}; }
#pragma unroll
                for (int bj = 0; bj < 2; ++bj) { u32x4 w; w.x = cvt_pk_bf16(v[bj][0][0], v[bj][0][1]); w.y = cvt_pk_bf16(v[bj][0][2], v[bj][0][3]); w.z = cvt_pk_bf16(v[bj][1][0], v[bj][1][1]); w.w = cvt_pk_bf16(v[bj][1][2], v[bj][1][3]);
                    *(u32x4*)(rowp + 32 * bj) = w; } }
    }
};

struct EpiOdd {
    static constexpr bool PERM = true, AFTER_DRAIN = false;
    bf16_t* UG; bf16_t* V; const float* ssx; float* ssv;
    __device__ __forceinline__ void operator()(const f32x4 (&acc)[2][2][4][2], const Unit& u, int wr, int wc, int fr, int fq) const {
        const int row0 = u.pm * BM + wr * 64 + fr;
        if (u.pn < 32) {
#pragma unroll
            for (int ai = 0; ai < 2; ++ai)
#pragma unroll
                for (int m = 0; m < 4; ++m) { const int row = row0 + ai * HALF + m * 16;
                    const float rx = __builtin_amdgcn_rsqf(ssx[row] * (1.f / 2048.f) + 1e-6f);
                    f32x4 o[2];
#pragma unroll
                    for (int n = 0; n < 2; ++n) { const f32x4 uu = acc[ai][0][m][n] * rx, gt = acc[ai][1][m][n] * rx;
                        const f32x2 a = gelu_pk((f32x2){uu[0], uu[1]}), b = gelu_pk((f32x2){uu[2], uu[3]});
                        o[n] = (f32x4){a.x * silu_f(gt[0]), a.y * silu_f(gt[1]), b.x * silu_f(gt[2]), b.y * silu_f(gt[3])}; }
                    u32x4 w; w.x = cvt_pk_bf16(o[0][0], o[0][1]); w.y = cvt_pk_bf16(o[0][2], o[0][3]); w.z = cvt_pk_bf16(o[1][0], o[1][1]); w.w = cvt_pk_bf16(o[1][2], o[1][3]);
                    *(u32x4*)(UG + (size_t)row * 4096 + u.pn * 128 + wc * 32 + 8 * fq) = w; }
        } else {
            const int colb = (u.pn - 32) * 256 + wc * 32 + 8 * fq;
#pragma unroll
            for (int ai = 0; ai < 2; ++ai)
#pragma unroll
                for (int m = 0; m < 4; ++m) { const int row = row0 + ai * HALF + m * 16;
                    const float rx = __builtin_amdgcn_rsqf(ssx[row] * (1.f / 2048.f) + 1e-6f);
                    float ss = 0.f;
#pragma unroll
                    for (int bj = 0; bj < 2; ++bj) { const f32x4 v0 = acc[ai][bj][m][0] * rx, v1 = acc[ai][bj][m][1] * rx;
                        const f32x2 a = gelu_pk((f32x2){v0[0], v0[1]}), b = gelu_pk((f32x2){v0[2], v0[3]}), c = gelu_pk((f32x2){v1[0], v1[1]}), d = gelu_pk((f32x2){v1[2], v1[3]});
                        ss += (a.x * a.x + a.y * a.y) + (b.x * b.x + b.y * b.y) + (c.x * c.x + c.y * c.y) + (d.x * d.x + d.y * d.y);
                        u32x4 w; w.x = cvt_pk_bf16(a.x, a.y); w.y = cvt_pk_bf16(b.x, b.y); w.z = cvt_pk_bf16(c.x, c.y); w.w = cvt_pk_bf16(d.x, d.y);
                        *(u32x4*)(V + (size_t)row * 4096 + colb + bj * HALF) = w; }
                    ss += __shfl_xor(ss, 16); ss += __shfl_xor(ss, 32);
                    if (fq == 0) atomicAdd(ssv + row, ss); }
        }
    }
};
struct EpiResN {
    static constexpr bool PERM = false, AFTER_DRAIN = false;
    const float* base; float* out; int ldc; bf16_t* xn; const float* gn; float* ssn;
    __device__ __forceinline__ void operator()(const f32x4 (&acc)[2][2][4][2], const Unit& u, int wr, int wc, int fr, int fq) const {
        typedef unsigned u32x2v __attribute__((ext_vector_type(2)));
        const int row0 = u.pm * BM + wr * 64 + fr, col0 = u.pn * BM + wc * 32 + 4 * fq;
        f32x4 gg[2][2];
#pragma unroll
        for (int bj = 0; bj < 2; ++bj)
#pragma unroll
            for (int n = 0; n < 2; ++n) gg[bj][n] = xn ? *(const f32x4*)(gn + col0 + bj * HALF + n * 16) : (f32x4){0.f, 0.f, 0.f, 0.f};
#pragma unroll
        for (int ai = 0; ai < 2; ++ai)
#pragma unroll
            for (int m = 0; m < 4; ++m) { const int row = row0 + ai * HALF + m * 16; const size_t off = (size_t)row * ldc + col0; float ss = 0.f;
#pragma unroll
                for (int bj = 0; bj < 2; ++bj)
#pragma unroll
                    for (int n = 0; n < 2; ++n) { const f32x4 o = *(const f32x4*)(base + off + bj * HALF + n * 16) + acc[ai][bj][m][n]; *(f32x4*)(out + off + bj * HALF + n * 16) = o;
                        if (xn) { ss += (o[0] * o[0] + o[1] * o[1]) + (o[2] * o[2] + o[3] * o[3]); const f32x4 t = o * gg[bj][n];
                            u32x2v w; w.x = cvt_pk_bf16(t[0], t[1]); w.y = cvt_pk_bf16(t[2], t[3]); *(u32x2v*)(xn + off + bj * HALF + n * 16) = w; } }
                if (xn) { ss += __shfl_xor(ss, 16); ss += __shfl_xor(ss, 32); if (fq == 0) atomicAdd(ssn + row, ss); } }
    }
};

struct EpiResB {
    static constexpr bool PERM = true, AFTER_DRAIN = false;
    bf16_t* xb; float* outf; float* ssn; int nowrite;
    __device__ __forceinline__ void operator()(const f32x4 (&acc)[2][2][4][2], const Unit& u, int wr, int wc, int fr, int fq) const {
        const int row0 = u.pm * BM + wr * 64 + fr, col0 = u.pn * BM + wc * 32 + 8 * fq;
#pragma unroll
        for (int ai = 0; ai < 2; ++ai)
#pragma unroll
            for (int m = 0; m < 4; ++m) { const int row = row0 + ai * HALF + m * 16; const size_t off = (size_t)row * 2048 + col0; float ss = 0.f;
#pragma unroll
                for (int bj = 0; bj < 2; ++bj) { const u32x4 b = *(const u32x4*)(xb + off + bj * HALF);
                    f32x4 o0 = acc[ai][bj][m][0], o1 = acc[ai][bj][m][1];
                    o0[0] += __uint_as_float(b.x << 16); o0[1] += __uint_as_float(b.x & 0xffff0000u); o0[2] += __uint_as_float(b.y << 16); o0[3] += __uint_as_float(b.y & 0xffff0000u);
                    o1[0] += __uint_as_float(b.z << 16); o1[1] += __uint_as_float(b.z & 0xffff0000u); o1[2] += __uint_as_float(b.w << 16); o1[3] += __uint_as_float(b.w & 0xffff0000u);
                    if (outf) { *(f32x4*)(outf + off + bj * HALF) = o0; *(f32x4*)(outf + off + bj * HALF + 4) = o1; }
                    else { ss += (o0[0] * o0[0] + o0[1] * o0[1]) + (o0[2] * o0[2] + o0[3] * o0[3]) + (o1[0] * o1[0] + o1[1] * o1[1]) + (o1[2] * o1[2] + o1[3] * o1[3]);
                        u32x4 w; w.x = cvt_pk_bf16(o0[0], o0[1]); w.y = cvt_pk_bf16(o0[2], o0[3]); w.z = cvt_pk_bf16(o1[0], o1[1]); w.w = cvt_pk_bf16(o1[2], o1[3]);
                        if (!nowrite) *(u32x4*)(xb + off + bj * HALF) = w; } }
                if (!outf) { ss += __shfl_xor(ss, 16); ss += __shfl_xor(ss, 32); if (fq == 0) atomicAdd(ssn + row, ss); } }
    }
};

template <class Epi, class Sched, bool ALIGN_EPI = false, bool SP2 = false>
__device__ __forceinline__ void gemm_phase(PG8_LAS unsigned char* lds, const Gemm g, const Sched& S, const Epi& E, const int tid) {
    const int wid = __builtin_amdgcn_readfirstlane(tid >> 6), lane = tid & 63, wr = wid >> 2, wc = wid & 3, fr = lane & 15, fq = lane >> 4;
    const int K = g.K, nt = K / BK;
    unsigned voffA[2], voffB[2];
#pragma unroll
    for (int i = 0; i < 2; ++i) { int R, C; stage_rc(tid * 16 + i * 8192, R, C); const int Rb = Epi::PERM ? ((R & ~31) + perm32(R & 31)) : R;
        voffA[i] = (unsigned)(R * K + C) * 2u; voffB[i] = (unsigned)(Rb * K + C) * 2u; }
    const size_t kstep = (size_t)(BK * 2);
    const size_t hstep = (size_t)HALF * K * 2;
    const size_t tstep = 2 * hstep;
    const unsigned ldsw = (unsigned)wid * 1024u;
    const int aoff = lds_byte(wr * 64 + fr, fq * 8), boff = lds_byte(wc * 32 + fr, fq * 8);
#define PG8_SA(b, h) (((b) * 2 + (h)) * HTB)
#define PG8_SB(b, h) ((4 + (b) * 2 + (h)) * HTB)
#define PG8_STAGE(bufoff, gbase, voff) do { _Pragma("unroll") for (int _i = 0; _i < 2; ++_i) \
        __builtin_amdgcn_global_load_lds((const unsigned*)((const char*)(gbase) + (voff)[_i]), (PG8_LAS unsigned*)(lds + (bufoff) + ldsw + _i * 8192), 16, 0, 0); } while (0)
#define PG8_LDA(dst, b, h) do { _Pragma("unroll") for (int m = 0; m < 4; ++m) _Pragma("unroll") for (int k = 0; k < 2; ++k) dst[m][k] = *(const PG8_LAS bf16x8*)(lds + PG8_SA(b, h) + aoff + m * 2048 + k * 1024); } while (0)
#define PG8_LDB(dst, b, h) do { _Pragma("unroll") for (int n = 0; n < 2; ++n) _Pragma("unroll") for (int k = 0; k < 2; ++k) dst[n][k] = *(const PG8_LAS bf16x8*)(lds + PG8_SB(b, h) + boff + n * 2048 + k * 1024); } while (0)
#define PG8_MMA(ai, bj, At, Bt) do { __builtin_amdgcn_s_setprio(1); _Pragma("unroll") for (int m = 0; m < 4; ++m) _Pragma("unroll") for (int n = 0; n < 2; ++n) _Pragma("unroll") for (int k = 0; k < 2; ++k) \
        acc[ai][bj][m][n] = __builtin_amdgcn_mfma_f32_16x16x32_bf16(Bt[n][k], At[m][k], acc[ai][bj][m][n], 0, 0, 0); __builtin_amdgcn_s_setprio(0); } while (0)
#define PG8_WAIT_V(n) asm volatile("s_waitcnt vmcnt(" #n ")" ::: "memory")
#define PG8_WAIT_L(n) asm volatile("s_waitcnt lgkmcnt(" #n ")" ::: "memory")
#define PG8_BAR __builtin_amdgcn_s_barrier()
#define PG8_SCHED __builtin_amdgcn_sched_barrier(0)
    Unit cur, nxt; int ui = 0;
    if (!S.next(0, cur)) return;
    f32x4 acc[2][2][4][2];
#pragma unroll
    for (int a = 0; a < 2; ++a)
#pragma unroll
        for (int b = 0; b < 2; ++b)
#pragma unroll
            for (int m = 0; m < 4; ++m)
#pragma unroll
                for (int n = 0; n < 2; ++n) acc[a][b][m][n] = (f32x4){0.f, 0.f, 0.f, 0.f};
    bf16x8 At[4][2], B0[2][2], B1[2][2];
    const char* cA = (const char*)g.A + (size_t)cur.pm * tstep; const char* cB = (const char*)g.Bt + (size_t)cur.pn * tstep;
    S.a_ready(cur);
    if constexpr (SP2) {
        PG8_STAGE(PG8_SB(0, 0), cB, voffB); PG8_STAGE(PG8_SB(0, 1), cB + hstep, voffB); PG8_STAGE(PG8_SA(0, 0), cA, voffA); PG8_STAGE(PG8_SA(0, 1), cA + hstep, voffA);
        if (wr == 1) PG8_BAR;
        PG8_WAIT_V(2); PG8_BAR;
        PG8_STAGE(PG8_SB(1, 0), cB + kstep, voffB); PG8_STAGE(PG8_SA(1, 0), cA + kstep, voffA); PG8_STAGE(PG8_SB(1, 1), cB + hstep + kstep, voffB);
        PG8_WAIT_V(6); PG8_BAR;
    } else {
        PG8_STAGE(PG8_SB(0, 0), cB, voffB); PG8_STAGE(PG8_SA(0, 0), cA, voffA); PG8_STAGE(PG8_SB(0, 1), cB + hstep, voffB); PG8_STAGE(PG8_SA(0, 1), cA + hstep, voffA);
        if (wr == 1) PG8_BAR;
        PG8_WAIT_V(4); PG8_BAR;
        PG8_STAGE(PG8_SB(1, 0), cB + kstep, voffB); PG8_STAGE(PG8_SA(1, 0), cA + kstep, voffA); PG8_STAGE(PG8_SB(1, 1), cB + hstep + kstep, voffB);
        PG8_WAIT_V(6); PG8_BAR;
    }
    for (;;) {
        const bool has_next = S.next(ui + 1, nxt);
        const char* nA = has_next ? (const char*)g.A + (size_t)nxt.pm * tstep : cA; const char* nB = has_next ? (const char*)g.Bt + (size_t)nxt.pn * tstep : cB;
        for (int t = 0; t < nt; t += 2) {
            const bool last = (t == nt - 2);
            const char* a1 = cA + (size_t)(t + 1) * kstep;
            const char* a2 = last ? nA : cA + (size_t)(t + 2) * kstep; const char* b2 = last ? nB : cB + (size_t)(t + 2) * kstep;
            const char* a3 = a2 + kstep; const char* b3 = b2 + kstep;
            if (last && has_next) S.a_ready(nxt);
            if constexpr (SP2) {
            PG8_LDB(B0, 0, 0); PG8_LDB(B1, 0, 1); PG8_SCHED; PG8_LDA(At, 0, 0); PG8_STAGE(PG8_SA(1, 1), a1 + hstep, voffA);
            PG8_WAIT_V(8); PG8_WAIT_L(0); PG8_BAR; PG8_MMA(0, 0, At, B0); PG8_MMA(0, 1, At, B1); PG8_BAR; PG8_SCHED;
            PG8_LDA(At, 0, 1); PG8_STAGE(PG8_SB(0, 0), b2, voffB); PG8_STAGE(PG8_SB(0, 1), b2 + hstep, voffB); PG8_STAGE(PG8_SA(0, 0), a2, voffA);
            PG8_WAIT_V(8); PG8_WAIT_L(0); PG8_BAR; PG8_MMA(1, 0, At, B0); PG8_MMA(1, 1, At, B1); PG8_BAR; PG8_SCHED;
            PG8_LDB(B0, 1, 0); PG8_LDB(B1, 1, 1); PG8_SCHED; PG8_LDA(At, 1, 0); PG8_STAGE(PG8_SA(0, 1), a2 + hstep, voffA);
            PG8_WAIT_V(8); PG8_WAIT_L(0); PG8_BAR; PG8_MMA(0, 0, At, B0); PG8_MMA(0, 1, At, B1); PG8_BAR; PG8_SCHED;
            PG8_LDA(At, 1, 1); PG8_STAGE(PG8_SB(1, 0), b3, voffB); PG8_STAGE(PG8_SB(1, 1), b3 + hstep, voffB); PG8_STAGE(PG8_SA(1, 0), a3, voffA);
            PG8_WAIT_V(8); PG8_WAIT_L(0); PG8_BAR; PG8_MMA(1, 0, At, B0); PG8_MMA(1, 1, At, B1); PG8_BAR; PG8_SCHED;
            } else {
            PG8_LDB(B0, 0, 0); PG8_SCHED; PG8_LDA(At, 0, 0); PG8_STAGE(PG8_SA(1, 1), a1 + hstep, voffA);
            PG8_WAIT_L(8); PG8_BAR; PG8_WAIT_L(0); PG8_MMA(0, 0, At, B0); PG8_BAR; PG8_SCHED;
            PG8_LDB(B1, 0, 1); PG8_STAGE(PG8_SB(0, 0), b2, voffB);
            PG8_BAR; PG8_WAIT_L(0); PG8_MMA(0, 1, At, B1); PG8_BAR;
            PG8_LDA(At, 0, 1); PG8_STAGE(PG8_SA(0, 0), a2, voffA);
            PG8_BAR; PG8_WAIT_L(0); PG8_MMA(1, 0, At, B0); PG8_BAR; PG8_SCHED;
            PG8_STAGE(PG8_SB(0, 1), b2 + hstep, voffB);
            PG8_WAIT_V(6); PG8_BAR; PG8_MMA(1, 1, At, B1); PG8_BAR;
            PG8_LDB(B0, 1, 0); PG8_SCHED; PG8_LDA(At, 1, 0); PG8_STAGE(PG8_SA(0, 1), a2 + hstep, voffA);
            PG8_WAIT_L(8); PG8_BAR; PG8_WAIT_L(0); PG8_MMA(0, 0, At, B0); PG8_BAR; PG8_SCHED;
            PG8_LDB(B1, 1, 1); PG8_STAGE(PG8_SB(1, 0), b3, voffB);
            PG8_BAR; PG8_WAIT_L(0); PG8_MMA(0, 1, At, B1); PG8_BAR;
            PG8_LDA(At, 1, 1); PG8_STAGE(PG8_SA(1, 0), a3, voffA);
            PG8_BAR; PG8_WAIT_L(0); PG8_MMA(1, 0, At, B0); PG8_BAR; PG8_SCHED;
            PG8_STAGE(PG8_SB(1, 1), b3 + hstep, voffB);
            PG8_WAIT_V(6); PG8_BAR; PG8_MMA(1, 1, At, B1); PG8_BAR;
            }
        }
        if constexpr (ALIGN_EPI) { if (wr == 0) PG8_BAR; }
        if constexpr (!Epi::AFTER_DRAIN) { E(acc, cur, wr, wc, fr, fq); S.done(cur); }
        if (!has_next) break;
#pragma unroll
        for (int a = 0; a < 2; ++a)
#pragma unroll
            for (int b = 0; b < 2; ++b)
#pragma unroll
                for (int m = 0; m < 4; ++m)
#pragma unroll
                    for (int n = 0; n < 2; ++n) acc[a][b][m][n] = (f32x4){0.f, 0.f, 0.f, 0.f};
        cur = nxt; cA = nA; cB = nB; ++ui;
        if constexpr (ALIGN_EPI) { if (wr == 1) PG8_BAR; }
    }
    PG8_WAIT_V(0);
    if constexpr (!ALIGN_EPI) { if (wr == 0) PG8_BAR; }
    PG8_BAR;
    if constexpr (Epi::AFTER_DRAIN) { E.fused(acc, cur, wr, wc, fr, fq, lds, wid, lane); S.done(cur); }
#undef PG8_SA
#undef PG8_SB
#undef PG8_STAGE
#undef PG8_LDA
#undef PG8_LDB
#undef PG8_MMA
#undef PG8_WAIT_V
#undef PG8_WAIT_L
#undef PG8_BAR
#undef PG8_SCHED
}
}


#define GAS __attribute__((address_space(1)))
#define LAS __attribute__((address_space(3)))
typedef unsigned short bf16;
typedef unsigned v4u __attribute__((ext_vector_type(4)));
typedef float f32x4 __attribute__((ext_vector_type(4)));
typedef short bf16x8 __attribute__((ext_vector_type(8)));
typedef GAS unsigned gu32;
typedef GAS unsigned long long gu64;
#define RLX_AGENT __ATOMIC_RELAXED, __HIP_MEMORY_SCOPE_AGENT
#define LDS_WAIT() asm volatile("s_waitcnt lgkmcnt(0)" ::: "memory")
#define VM_WAIT() asm volatile("s_waitcnt vmcnt(0)" ::: "memory")
__device__ __forceinline__ unsigned long long rt() { return __builtin_amdgcn_s_memrealtime(); }
__device__ __forceinline__ unsigned f2bf(float f) { unsigned u = __builtin_bit_cast(unsigned, f); return (u + 0x7fffu + ((u >> 16) & 1u)) >> 16; }
__device__ __forceinline__ unsigned pk2(float lo, float hi) { return f2bf(lo) | (f2bf(hi) << 16); }

#define XB_TMO      128
#define XB_XCNT(j)  (256  + 64 * (j))
#define XB_XSUB(j)  (1280 + 64 * (j))
#define XB_XGEN(j)  (2304 + 64 * (j))
#define XB_TOP      3328
#define XB_TOPGEN   3392
#define XCD_BAR_WORDS 3456
#define XB_SPIN_CAP (1u << 18)

__device__ __forceinline__ unsigned xb_ld(unsigned* p)              { return __hip_atomic_load(p, __ATOMIC_RELAXED, __HIP_MEMORY_SCOPE_AGENT); }
__device__ __forceinline__ unsigned xb_add(unsigned* p, unsigned v) { return __hip_atomic_fetch_add(p, v, __ATOMIC_RELAXED, __HIP_MEMORY_SCOPE_AGENT); }
__device__ __forceinline__ unsigned xb_xcc_id() { return (unsigned)__builtin_amdgcn_s_getreg((3 << 11) | 20) & 0xFu; }
#define XB_SPIN(cond, bar) do { unsigned _sp = 0; while (cond) { __builtin_amdgcn_s_sleep(1); \
    if ((++_sp & 255u) == 0u) { if (xb_ld(&(bar)[XB_TMO])) break; if (_sp > XB_SPIN_CAP) { atomicAdd(&(bar)[XB_TMO], 1u); break; } } } } while (0)

struct XcdBarrier {
    unsigned* bar; unsigned x;
    volatile LAS unsigned* st;
};

__device__ __forceinline__ XcdBarrier xcd_barrier_post(unsigned* bar, volatile LAS unsigned* st) {
    XcdBarrier b; b.bar = bar; b.x = xb_xcc_id(); b.st = st;
    if (threadIdx.x == 0) (void)xb_add(&bar[XB_XCNT(b.x)], 1u);
    return b;
}
__device__ __forceinline__ void xcd_barrier_complete(unsigned* bar, unsigned x, unsigned& nloc, unsigned& nx) {
    const unsigned G = gridDim.x * gridDim.y * gridDim.z;
    unsigned sum, cnt, mine, sp = 0u;
    for (;;) {
        sum = 0u; cnt = 0u; mine = 0u;
#pragma unroll
        for (unsigned j = 0; j < 16; ++j) { const unsigned c = xb_ld(&bar[XB_XCNT(j)]); sum += c; cnt += (c > 0u) ? 1u : 0u; mine = (j == x) ? c : mine; }
        if (sum == G) break;
        __builtin_amdgcn_s_sleep(1);
        if ((++sp & 255u) == 0u) { if (xb_ld(&bar[XB_TMO])) break; if (sp > XB_SPIN_CAP) { atomicAdd(&bar[XB_TMO], 1u); break; } }
    }
    nloc = mine > 0u ? mine : 1u; nx = cnt > 0u ? cnt : 1u;
}

__device__ __forceinline__ void xcd_barrier(const XcdBarrier& b) {
    asm volatile("s_waitcnt vmcnt(0)" ::: "memory");
    __syncthreads();
    if (threadIdx.x == 0) {
        unsigned* bar = b.bar;
        __builtin_amdgcn_s_waitcnt(0);
        unsigned nloc = b.st[0], nx = b.st[1];
        if (nloc == 0u) { xcd_barrier_complete(bar, b.x, nloc, nx); b.st[0] = nloc; b.st[1] = nx; }
        const unsigned old = xb_add(&bar[XB_XSUB(b.x)], 1u);
        const unsigned gen = old / nloc;
        if (old + 1u == (gen + 1u) * nloc) {
            __builtin_amdgcn_fence(__ATOMIC_RELEASE, "agent");
            asm volatile("s_waitcnt vmcnt(0)" ::: "memory");
            const unsigned og = xb_add(&bar[XB_TOP], 1u);
            const unsigned tg = og / nx;
            if (og + 1u == (tg + 1u) * nx) xb_add(&bar[XB_TOPGEN], 1u);
            else XB_SPIN(xb_ld(&bar[XB_TOPGEN]) == tg, bar);
            __builtin_amdgcn_fence(__ATOMIC_ACQUIRE, "agent");
            xb_add(&bar[XB_XGEN(b.x)], 1u);
            asm volatile("s_waitcnt vmcnt(0)" ::: "memory");
        } else {
            XB_SPIN(xb_ld(&bar[XB_XGEN(b.x)]) == gen, bar);
            __builtin_amdgcn_fence(__ATOMIC_ACQUIRE, "agent");
            asm volatile("s_waitcnt vmcnt(0)" ::: "memory");
        }
    }
    __syncthreads();
}

constexpr int NWAVES = 8;
#ifndef MK_ONE_LAUNCH
#define MK_ONE_LAUNCH 1
#endif
constexpr int SEQ = 2048, DMODEL = 2048, MROWS = 8192;
constexpr int EV_IN = 6400, OD_IN = 12288, CWID = 4096;
constexpr float EPS = 1e-6f;
constexpr size_t MiB = 1u << 20;
constexpr size_t WS_CTL = 0, CTL_ZERO_BYTES = 1 * MiB;
constexpr size_t WS_EWIN = 2 * MiB, SZ_EWIN = 25 * MiB;
constexpr size_t WS_EWOUT = 52 * MiB, SZ_EWOUT = 8 * MiB;
constexpr size_t WS_OWIN = 68 * MiB, SZ_OWIN = 48 * MiB;
constexpr size_t WS_OWOUT = 164 * MiB, SZ_OWOUT = 16 * MiB;
constexpr size_t WS_XN = 196 * MiB;
constexpr size_t WS_Z = 228 * MiB;
constexpr size_t WS_Y = 420 * MiB;
constexpr size_t WS_LUT = 484 * MiB;
constexpr size_t WS_END = 486 * MiB;
constexpr int CW_BAR = 4096;
constexpr int CW_SSX = 16384;
constexpr int CW_SSV = 49152;
static_assert((CW_SSV + 2 * 8192) * 4 <= (int)CTL_ZERO_BYTES, "CTL map");
constexpr int RING_OFF = 0, RING_BYTES = 131072;
constexpr int LDSCTL_OFF = RING_BYTES, MISC_OFF = LDSCTL_OFF + 320;
constexpr int LDS_BYTES = 147456;
constexpr int NPHASE = 13;
enum { PH_PRO = 0, PH_G1 = 1, PH_MID = 2, PH_G2 = 3 };

__device__ __forceinline__ float bf2f(unsigned short u) { return __uint_as_float((unsigned)u << 16); }
__device__ __forceinline__ float wave_sum(float v) {
#pragma unroll
    for (int o = 1; o < 64; o <<= 1) v += __shfl_xor(v, o);
    return v;
}
__device__ __forceinline__ int t5_bucket(int n) {
    if (n < 16) return n;
    return 16 + (n >= 22) + (n >= 30) + (n >= 40) + (n >= 54) + (n >= 73) + (n >= 99) + (n >= 134) + (n >= 182) + (n >= 246) + (n >= 332) + (n >= 450) + (n >= 609) + (n >= 825) + (n >= 1117) + (n >= 1513);
}

__device__ __forceinline__ void p0_transpose_item(const float* W, int K, int N, bf16* WT, LAS float* scr, int item, int lane, const int permkind, const float* gk = nullptr) {
    const int nblk = N / 32, kb = item / nblk, nb = item % nblk, k0 = 64 * kb, n0 = 32 * nb;
    int r0 = n0;
    if (permkind == 1) r0 = (n0 & ~255) + 128 * ((n0 >> 5) & 1) + 32 * ((n0 >> 6) & 3);
    else if (permkind == 2) r0 = (n0 < 4096) ? (256 * (n0 >> 7) + (n0 & 127))
                               : (n0 < 8192) ? (8192 + (n0 - 4096))
                               : (256 * ((n0 - 8192) >> 7) + 128 + ((n0 - 8192) & 127));
    { const int q4 = (lane & 7) * 4, rr = lane >> 3; const float* wp = W + (size_t)(k0 + rr) * N + n0 + q4; f32x4 v[8];
#pragma unroll
        for (int i = 0; i < 8; ++i) v[i] = *(const GAS f32x4*)(wp + (size_t)(8 * i) * N);
#pragma unroll
        for (int i = 0; i < 8; ++i) { LAS float* d = scr + (8 * i + rr) * 33 + q4; const float gs = gk ? gk[k0 + 8 * i + rr] : 1.0f;
            d[0] = v[i].x * gs; d[1] = v[i].y * gs; d[2] = v[i].z * gs; d[3] = v[i].w * gs; } }
    LDS_WAIT(); asm volatile("" ::: "memory");
    const int c = lane & 7;
#pragma unroll
    for (int j = 0; j < 4; ++j) { const int n = (lane >> 3) + 8 * j; const LAS float* s = scr + (8 * c) * 33 + n;
        v4u o; o.x = pk2(s[0 * 33], s[1 * 33]); o.y = pk2(s[2 * 33], s[3 * 33]); o.z = pk2(s[4 * 33], s[5 * 33]); o.w = pk2(s[6 * 33], s[7 * 33]);
        *(GAS v4u*)(WT + (size_t)(r0 + n) * K + k0 + 8 * c) = o; }
    LDS_WAIT(); asm volatile("" ::: "memory");
}
__device__ __forceinline__ void xg_row_to_bf16(const float* xrow, const float* g, bf16* orow, float* ss, int lane) {
    const GAS f32x4* xr = (const GAS f32x4*)xrow + lane; (void)g;
    GAS unsigned long long* o8 = (GAS unsigned long long*)orow + lane; float s = 0.f;
#pragma unroll
    for (int j = 0; j < 8; ++j) { const f32x4 v = xr[64 * j]; s += (v.x * v.x + v.y * v.y) + (v.z * v.z + v.w * v.w);
        o8[64 * j] = (unsigned long long)pk2(v.x, v.y) | ((unsigned long long)pk2(v.z, v.w) << 32); }
    s = wave_sum(s);
    if (lane == 0) *ss = s;
}
struct Weights { const float *ev_w_in, *ev_w_out, *od_w_in, *od_w_out, *ev_ln_g, *od_ln_g; };
__device__ __forceinline__ void convert_set(LAS unsigned char* lds, int wave, int lane, const Weights& W, unsigned char* ws, const int set, const int gw, const int NGW) {
    LAS float* scr = (LAS float*)(lds + RING_OFF + wave * 16384);
    constexpr int I_EI = (DMODEL / 64) * (EV_IN / 32), I_EO = (DMODEL / 64) * (DMODEL / 32), I_OI = (DMODEL / 64) * (OD_IN / 32), I_OO = (CWID / 64) * (DMODEL / 32);
    if (set == 0) {
        for (int it = gw; it < 2 * I_EI; it += NGW) { const int j = it / I_EI, r = it % I_EI;
            p0_transpose_item(W.ev_w_in + (size_t)j * DMODEL * EV_IN, DMODEL, EV_IN, (bf16*)(ws + WS_EWIN + j * SZ_EWIN), scr, r, lane, 1, W.ev_ln_g + j * DMODEL); }
    } else {
        const int j = set - 1;
        for (int it = gw; it < I_EO + I_OI + I_OO; it += NGW) { int r = it;
            if (r < I_OI) { p0_transpose_item(W.od_w_in + (size_t)j * DMODEL * OD_IN, DMODEL, OD_IN, (bf16*)(ws + WS_OWIN + j * SZ_OWIN), scr, r, lane, 2, W.od_ln_g + j * DMODEL); continue; } r -= I_OI;
            if (r < I_OO) { p0_transpose_item(W.od_w_out + (size_t)j * CWID * DMODEL, CWID, DMODEL, (bf16*)(ws + WS_OWOUT + j * SZ_OWOUT), scr, r, lane, 0); continue; } r -= I_OO;
            p0_transpose_item(W.ev_w_out + (size_t)j * DMODEL * DMODEL, DMODEL, DMODEL, (bf16*)(ws + WS_EWOUT + j * SZ_EWOUT), scr, r, lane, 0); }
    }
}
__device__ __forceinline__ void ph_prologue(LAS unsigned char* lds, int wave, int lane, int vcu, int G, const Weights& W, unsigned char* ws, const float* x, const float* g0) {
    const int gw = vcu * NWAVES + wave, NGW = G * NWAVES;
    convert_set(lds, wave, lane, W, ws, 0, gw, NGW);
#if PROBE_FULLPRO
    convert_set(lds, wave, lane, W, ws, 1, gw, NGW); convert_set(lds, wave, lane, W, ws, 2, gw, NGW);
#endif
    float* ssx0 = (float*)(ws + WS_CTL) + CW_SSX;
    for (int m = gw; m < MROWS; m += NGW) xg_row_to_bf16(x + (size_t)m * DMODEL, g0, (bf16*)(ws + WS_XN) + (size_t)m * DMODEL, ssx0 + m, lane);
}


namespace att {
using bf16x8 = __attribute__((ext_vector_type(8))) short;
using s16x4 = __attribute__((ext_vector_type(4))) short;
using f32x16 = __attribute__((ext_vector_type(16))) float;
using u32x4 = __attribute__((ext_vector_type(4))) unsigned;
typedef short v4i16_t __attribute__((ext_vector_type(4)));
typedef float f32x2_t __attribute__((ext_vector_type(2))); typedef __bf16 bf16x2_t __attribute__((ext_vector_type(2)));
typedef LAS const char* lds_cptr;
constexpr int ZP = 6400, YP = 2048, SLOTB = 8192, NSLOT = 3;
constexpr int L_K = 0, L_V = NSLOT * SLOTB, L_LUT = 2 * NSLOT * SLOTB, L_WS = L_LUT + 10240, L_OST = L_WS + 2048, L_END = L_OST + 32768;
static_assert(L_END <= 131072, "attention LDS map");
constexpr int LUT_N = 2304, LUT_OFF = 256;
constexpr float LOG2E = 1.4426950408889634f;
__device__ __forceinline__ int crow(int r, int hi) { return (r & 3) + 8 * (r >> 2) + 4 * hi; }
__device__ __forceinline__ void glds16(const void* gsrc, unsigned lds_dst) { unsigned keep;
    asm volatile("s_mov_b32 %0, m0\n\ts_mov_b32 m0, %2\n\ts_nop 0\n\tglobal_load_lds_dwordx4 %1, off\n\ts_mov_b32 m0, %0" : "=&s"(keep) : "v"(gsrc), "s"(lds_dst) : "memory"); }
__device__ __forceinline__ unsigned cvtpk_s(float lo, float hi) { f32x2_t v = {lo, hi}; bf16x2_t b = __builtin_convertvector(v, bf16x2_t); return __builtin_bit_cast(unsigned, b); }
#define ATT_WAIT_BAR(N) asm volatile("s_waitcnt vmcnt(" #N ") lgkmcnt(0)\n\ts_barrier" ::: "memory")
#define ATT_SBAR() __builtin_amdgcn_sched_barrier(0)
__device__ __forceinline__ void kload8(bf16x8* kf, lds_cptr kp) {
    kf[0] = *(const LAS bf16x8*)(kp);        kf[1] = *(const LAS bf16x8*)(kp + 512);
    kf[2] = *(const LAS bf16x8*)(kp + 2048); kf[3] = *(const LAS bf16x8*)(kp + 2560);
    kf[4] = *(const LAS bf16x8*)(kp + 4096); kf[5] = *(const LAS bf16x8*)(kp + 4608);
    kf[6] = *(const LAS bf16x8*)(kp + 6144); kf[7] = *(const LAS bf16x8*)(kp + 6656);
}
__device__ __forceinline__ void kload2(bf16x8* kf, lds_cptr kp, int j) { kf[2 * j] = *(const LAS bf16x8*)(kp + j * 2048); kf[2 * j + 1] = *(const LAS bf16x8*)(kp + j * 2048 + 512); }
__device__ __forceinline__ s16x4 vtr(lds_cptr p) { return __builtin_bit_cast(s16x4, __builtin_amdgcn_ds_read_tr16_b64_v4i16((LAS v4i16_t*)p)); }
__device__ __forceinline__ void pv(f32x16* o, int vb, bf16x8 pa0, bf16x8 pa1, bf16x8 pa2, bf16x8 pa3) {
#pragma unroll
    for (int d0 = 0; d0 < 2; ++d0) { s16x4 lo[4], hi[4];
#pragma unroll
        for (int ks = 0; ks < 4; ++ks) {
            asm volatile("ds_read_b64_tr_b16 %0,%1 offset:%c2" : "=&v"(lo[ks]) : "v"(vb), "i"(d0 * 4096 + ks * 1024) : "memory");
            asm volatile("ds_read_b64_tr_b16 %0,%1 offset:%c2" : "=&v"(hi[ks]) : "v"(vb), "i"(d0 * 4096 + ks * 1024 + 512) : "memory"); }
        asm volatile("s_waitcnt lgkmcnt(0)" ::: "memory"); ATT_SBAR();
#define ATT_PK(k) (bf16x8){lo[k][0], lo[k][1], lo[k][2], lo[k][3], hi[k][0], hi[k][1], hi[k][2], hi[k][3]}
        o[d0] = __builtin_amdgcn_mfma_f32_32x32x16_bf16(pa0, ATT_PK(0), o[d0], 0, 0, 0);
        o[d0] = __builtin_amdgcn_mfma_f32_32x32x16_bf16(pa1, ATT_PK(1), o[d0], 0, 0, 0);
        o[d0] = __builtin_amdgcn_mfma_f32_32x32x16_bf16(pa2, ATT_PK(2), o[d0], 0, 0, 0);
        o[d0] = __builtin_amdgcn_mfma_f32_32x32x16_bf16(pa3, ATT_PK(3), o[d0], 0, 0, 0);
#undef ATT_PK
    }
}
#define ATT_LUTV(lp, H, r) ((lp)[((H) ? 27 : 59) - (((r) & 3) + 8 * ((r) >> 2))])
#define ATT_LUT4(T, lp, H, B) do { T[0] = ATT_LUTV(lp, H, B); T[1] = ATT_LUTV(lp, H, (B) + 1); T[2] = ATT_LUTV(lp, H, (B) + 2); T[3] = ATT_LUTV(lp, H, (B) + 3); } while (0)
__device__ __forceinline__ void attn_unit(const int b, const int hh, const int qb, const bf16* Z, bf16* Y, const float* sinks, const float* lutg, const float* m0g, const bool newhead, LAS unsigned char* shm, const int tid) {
    const bool isB = hh >= 16; const int h = hh & 15;
    const int lane = tid & 63, r32 = lane & 31, hi = lane >> 5; const int wid = __builtin_amdgcn_readfirstlane(tid >> 6);
    const int qcol = isB ? 2304 + h * 64 : h * 64;
    const int kcol = isB ? 3328 + h * 64 : 1024 + (h >> 3) * 64;
    const int vcol = isB ? 4352 + h * 64 : 1152 + (h >> 3) * 64;
    const int gcol = isB ? 5376 + h * 64 : 1280 + h * 64;
    const int ycol = (isB ? 1024 : 0) + h * 64;
    const long rowbase = (long)b * SEQ; const int q0 = qb * 256;
    const int t_lo = isB ? 0 : (qb > 0 ? 4 * qb - 2 : 0), NT = 4 * qb + 4 - t_lo;
    const float M0 = m0g[hh];
    LAS float* lut = (LAS float*)(shm + L_LUT);
    if (newhead) { for (int i = tid; i < LUT_N; i += 512) lut[i] = lutg[hh * LUT_N + i] - M0; }
    const bf16* Qw = Z + (rowbase + q0 + wid * 32) * ZP + qcol;
    const unsigned lds0 = (unsigned)(uintptr_t)shm;
    const bf16* ksrc = Z + (rowbase + 64 * t_lo + lane) * ZP + kcol + wid * 8;
    const bf16* vsrc = Z + (rowbase + 64 * t_lo + 16 * (wid & 3) + (lane >> 2)) * ZP + vcol + (wid >> 2) * 32 + (lane & 3) * 8;
    const unsigned kdst = lds0 + L_K + wid * 1024, vdst = lds0 + L_V + wid * 1024;
#define ATT_DMA_K(i, slot) glds16(ksrc + (long)(i) * 64 * ZP, (unsigned)__builtin_amdgcn_readfirstlane(kdst + (slot)))
#define ATT_DMA_V(i, slot) glds16(vsrc + (long)(i) * 64 * ZP, (unsigned)__builtin_amdgcn_readfirstlane(vdst + (slot)))
    const int vb0 = (int)(lds0 + L_V) + ((lane >> 4) & 1) * 32 + (lane & 3) * 8 + (4 * hi + ((lane & 15) >> 2)) * 64;
    const lds_cptr shm3 = (lds_cptr)shm; const lds_cptr kp0 = shm3 + L_K + hi * 1024 + r32 * 16; const lds_cptr vp0 = shm3 + L_V + ((lane >> 4) & 1) * 32 + (lane & 3) * 8 + (4 * hi + ((lane & 15) >> 2)) * 64;
    bf16x8 kf[8];
    ATT_DMA_K(0, 0); ATT_DMA_V(0, 0); ATT_DMA_K(1, SLOTB);
    bf16x8 qr[4];
#pragma unroll
    for (int d0 = 0; d0 < 4; ++d0) qr[d0] = *reinterpret_cast<const bf16x8*>(Qw + (long)r32 * ZP + d0 * 16 + hi * 8);
    float l_reg = 0.f; f32x16 o[2]; o[0] = f32x16{}; o[1] = f32x16{};
    const LAS float* lp0 = lut + (q0 + wid * 32 + r32 - 64 * t_lo - 4 * hi + LUT_OFF - 59);
    f32x16 pA0, pA1, pB0, pB1;
    int sl_prev = 0, sl_cur = 0, sl_next = SLOTB;
#define ATT_ROT() do { sl_prev = sl_cur; sl_cur = sl_next; sl_next = (sl_next == (NSLOT - 1) * SLOTB) ? 0 : sl_next + SLOTB; } while (0)
    ATT_DMA_K(2, 2 * SLOTB);
    ATT_WAIT_BAR(3);
    { const lds_cptr kb = kp0;
#pragma unroll
        for (int d0 = 0; d0 < 4; ++d0) { const bf16x8 b0 = *(const LAS bf16x8*)(kb + d0 * 2048), b1 = *(const LAS bf16x8*)(kb + d0 * 2048 + 512);
            if (d0 == 0) { pA0 = __builtin_amdgcn_mfma_f32_32x32x16_bf16(b0, qr[0], f32x16{}, 0, 0, 0); pA1 = __builtin_amdgcn_mfma_f32_32x32x16_bf16(b1, qr[0], f32x16{}, 0, 0, 0); }
            else { pA0 = __builtin_amdgcn_mfma_f32_32x32x16_bf16(b0, qr[d0], pA0, 0, 0, 0); pA1 = __builtin_amdgcn_mfma_f32_32x32x16_bf16(b1, qr[d0], pA1, 0, 0, 0); } } }
#pragma unroll
    for (int r = 0; r < 16; ++r) { pA0[r] = __builtin_amdgcn_exp2f(pA0[r] + ATT_LUTV(lp0, 0, r)); pA1[r] = __builtin_amdgcn_exp2f(pA1[r] + ATT_LUTV(lp0, 1, r)); }
    ATT_WAIT_BAR(0);
    ATT_DMA_K(3, 0); ATT_DMA_V(1, SLOTB);
    ATT_ROT();
    kload8(kf, kp0 + sl_cur);
    ATT_WAIT_BAR(2);
    s16x4 vlo[8], vhi[8]; u32x4 pw0, pw1, pw2, pw3;
#define ATT_PKW(P, B) cvtpk_s(P[B], P[B + 1])
#define ATT_PAF(k) __builtin_bit_cast(bf16x8, pw##k)
#define ATT_VFR(i) (bf16x8){vlo[i][0], vlo[i][1], vlo[i][2], vlo[i][3], vhi[i][0], vhi[i][1], vhi[i][2], vhi[i][3]}
#define ATT_PIN(x) asm volatile("" : "+v"(x))
#define ATT_GAPA(MF, A0, A1, A2, A3, W0, W1, PW) do { MF; sacc += A0; sacc += A1; sacc += A2; sacc += A3; ATT_PIN(sacc); W0; W1; ATT_PIN(PW); ATT_SBAR(); } while (0)
#define ATT_EX(v) __builtin_amdgcn_exp2f(v)
#define ATT_GAPB(MF, X, B, TC, TN, HN, BN) do { MF; ATT_LUT4(TN, lpc_, HN, BN); \
    X[B] = ATT_EX(X[B] + TC[0]); X[B + 1] = ATT_EX(X[B + 1] + TC[1]); X[B + 2] = ATT_EX(X[B + 2] + TC[2]); X[B + 3] = ATT_EX(X[B + 3] + TC[3]); ATT_PIN(X); ATT_SBAR(); } while (0)
#define ATT_VRD(i) do { vlo[i] = vtr(vp_ + (((i) >> 2) * 4096 + ((i) & 3) * 1024)); vhi[i] = vtr(vp_ + (((i) >> 2) * 4096 + ((i) & 3) * 1024 + 512)); } while (0)
#define ATT_KRD(G, j) do { if (G) { kload2(kf, kp0 + sl_next, j); ATT_SBAR(); } } while (0)
#define ATT_STEP(C0, C1, P0, P1, i, GK, GV, GL) do { ATT_SBAR(); \
    const lds_cptr vp_ = vp0 + sl_prev; const LAS float* lpc_ = lp0 - 64 * (i); float ta_[4], tb_[4]; \
    ATT_VRD(0); ATT_SBAR(); float sacc = (P0[0] + P0[1]); \
    ATT_GAPA(C0 = __builtin_amdgcn_mfma_f32_32x32x16_bf16(kf[0], qr[0], f32x16{}, 0, 0, 0), P0[2], P0[3], P0[4], P0[5],     pw0[0] = ATT_PKW(P0, 0), pw0[1] = ATT_PKW(P0, 2), pw0); \
    ATT_VRD(4); ATT_SBAR(); ATT_GAPA(C1 = __builtin_amdgcn_mfma_f32_32x32x16_bf16(kf[1], qr[0], f32x16{}, 0, 0, 0), P0[6], P0[7], P0[8], P0[9],     pw0[2] = ATT_PKW(P0, 4), pw0[3] = ATT_PKW(P0, 6), pw0); \
    ATT_VRD(1); ATT_SBAR(); ATT_GAPA(C0 = __builtin_amdgcn_mfma_f32_32x32x16_bf16(kf[2], qr[1], C0, 0, 0, 0), P0[10], P0[11], P0[12], P0[13], pw1[0] = ATT_PKW(P0, 8), pw1[1] = ATT_PKW(P0, 10), pw1); \
    ATT_VRD(5); ATT_SBAR(); ATT_GAPA(C1 = __builtin_amdgcn_mfma_f32_32x32x16_bf16(kf[3], qr[1], C1, 0, 0, 0), P0[14], P0[15], P1[0], P1[1],   pw1[2] = ATT_PKW(P0, 12), pw1[3] = ATT_PKW(P0, 14), pw1); \
    ATT_VRD(2); ATT_SBAR(); ATT_GAPA(C0 = __builtin_amdgcn_mfma_f32_32x32x16_bf16(kf[4], qr[2], C0, 0, 0, 0), P1[2], P1[3], P1[4], P1[5],     pw2[0] = ATT_PKW(P1, 0), pw2[1] = ATT_PKW(P1, 2), pw2); \
    ATT_VRD(6); ATT_SBAR(); ATT_GAPA(C1 = __builtin_amdgcn_mfma_f32_32x32x16_bf16(kf[5], qr[2], C1, 0, 0, 0), P1[6], P1[7], P1[8], P1[9],     pw2[2] = ATT_PKW(P1, 4), pw2[3] = ATT_PKW(P1, 6), pw2); \
    ATT_VRD(3); ATT_SBAR(); ATT_GAPA(C0 = __builtin_amdgcn_mfma_f32_32x32x16_bf16(kf[6], qr[3], C0, 0, 0, 0), P1[10], P1[11], P1[12], P1[13], pw3[0] = ATT_PKW(P1, 8), pw3[1] = ATT_PKW(P1, 10), pw3); \
    ATT_VRD(7); ATT_SBAR(); ATT_GAPA(C1 = __builtin_amdgcn_mfma_f32_32x32x16_bf16(kf[7], qr[3], C1, 0, 0, 0), P1[14], P1[15], 0.f, 0.f,       pw3[2] = ATT_PKW(P1, 12), pw3[3] = ATT_PKW(P1, 14), pw3); \
    l_reg += sacc; \
    if (GK) { ATT_DMA_K((i) + 3, sl_cur); } if (GV) { ATT_DMA_V((i) + 1, sl_next); } \
    ATT_LUT4(ta_, lpc_, 0, 0); ATT_SBAR(); \
    ATT_GAPB(o[0] = __builtin_amdgcn_mfma_f32_32x32x16_bf16(ATT_PAF(0), ATT_VFR(0), o[0], 0, 0, 0), C0, 0, ta_, tb_, 0, 4); \
    ATT_GAPB(o[1] = __builtin_amdgcn_mfma_f32_32x32x16_bf16(ATT_PAF(0), ATT_VFR(4), o[1], 0, 0, 0), C0, 4, tb_, ta_, 0, 8); \
    ATT_KRD(GL, 0); ATT_GAPB(o[0] = __builtin_amdgcn_mfma_f32_32x32x16_bf16(ATT_PAF(1), ATT_VFR(1), o[0], 0, 0, 0), C0, 8, ta_, tb_, 0, 12); \
    ATT_KRD(GL, 1); ATT_GAPB(o[1] = __builtin_amdgcn_mfma_f32_32x32x16_bf16(ATT_PAF(1), ATT_VFR(5), o[1], 0, 0, 0), C0, 12, tb_, ta_, 1, 0); \
    ATT_KRD(GL, 2); ATT_GAPB(o[0] = __builtin_amdgcn_mfma_f32_32x32x16_bf16(ATT_PAF(2), ATT_VFR(2), o[0], 0, 0, 0), C1, 0, ta_, tb_, 1, 4); \
    ATT_KRD(GL, 3); ATT_GAPB(o[1] = __builtin_amdgcn_mfma_f32_32x32x16_bf16(ATT_PAF(2), ATT_VFR(6), o[1], 0, 0, 0), C1, 4, tb_, ta_, 1, 8); \
    ATT_GAPB(o[0] = __builtin_amdgcn_mfma_f32_32x32x16_bf16(ATT_PAF(3), ATT_VFR(3), o[0], 0, 0, 0), C1, 8, ta_, tb_, 1, 12); \
    ATT_GAPB(o[1] = __builtin_amdgcn_mfma_f32_32x32x16_bf16(ATT_PAF(3), ATT_VFR(7), o[1], 0, 0, 0), C1, 12, tb_, ta_, 1, 12); \
    } while (0)
#define ATT_ENDW(tt) do { if ((tt) + 3 < NT) { ATT_WAIT_BAR(2); } else if ((tt) + 2 < NT) { ATT_WAIT_BAR(1); } else { ATT_WAIT_BAR(0); } } while (0)
    int t = 1;
    for (; t + 1 < NT; t += 2) {
        ATT_STEP(pB0, pB1, pA0, pA1, t, (t + 3 < NT), (t + 1 < NT), (t + 1 < NT));         ATT_ENDW(t);     ATT_ROT();
        ATT_STEP(pA0, pA1, pB0, pB1, t + 1, (t + 4 < NT), (t + 2 < NT), (t + 2 < NT));     ATT_ENDW(t + 1); ATT_ROT();
    }
    ATT_STEP(pB0, pB1, pA0, pA1, NT - 1, false, false, false);
    { float sacc = pB0[0] + pB0[1];
#pragma unroll
        for (int r = 2; r < 16; ++r) sacc += pB0[r];
#pragma unroll
        for (int r = 0; r < 16; ++r) sacc += pB1[r];
        l_reg += sacc;
        pw0 = (u32x4){ATT_PKW(pB0, 0), ATT_PKW(pB0, 2), ATT_PKW(pB0, 4), ATT_PKW(pB0, 6)}; pw1 = (u32x4){ATT_PKW(pB0, 8), ATT_PKW(pB0, 10), ATT_PKW(pB0, 12), ATT_PKW(pB0, 14)};
        pw2 = (u32x4){ATT_PKW(pB1, 0), ATT_PKW(pB1, 2), ATT_PKW(pB1, 4), ATT_PKW(pB1, 6)}; pw3 = (u32x4){ATT_PKW(pB1, 8), ATT_PKW(pB1, 10), ATT_PKW(pB1, 12), ATT_PKW(pB1, 14)};
        ATT_SBAR(); pv(o, vb0 + sl_cur, ATT_PAF(0), ATT_PAF(1), ATT_PAF(2), ATT_PAF(3)); }
#undef ATT_PKW
#undef ATT_PAF
#undef ATT_VFR
#undef ATT_PIN
#undef ATT_GAPA
#undef ATT_GAPB
#undef ATT_EX
#undef ATT_VRD
#undef ATT_KRD
#undef ATT_STEP
#undef ATT_ENDW
#undef ATT_ROT
#undef ATT_DMA_K
#undef ATT_DMA_V
    { auto rr = __builtin_amdgcn_permlane32_swap(__float_as_uint(l_reg), __float_as_uint(l_reg), false, false); l_reg = __uint_as_float(rr[0]) + __uint_as_float(rr[1]); }
    if (!isB) l_reg += __builtin_amdgcn_exp2f(sinks[h] * LOG2E - M0);
    LAS float* wsf = (LAS float*)(shm + L_WS) + wid * 64;
    if (hi == 0) wsf[32 + r32] = l_reg;
    asm volatile("s_waitcnt lgkmcnt(0)" ::: "memory");
    float rli[16];
#pragma unroll
    for (int r = 0; r < 16; ++r) rli[r] = __builtin_amdgcn_rcpf(wsf[32 + crow(r, hi)]);
    { LAS bf16* stg = (LAS bf16*)(shm + L_OST) + wid * 2048;
#pragma unroll
        for (int r = 0; r < 16; ++r) { const int orow = crow(r, hi);
#pragma unroll
            for (int d0 = 0; d0 < 2; ++d0) stg[orow * 64 + d0 * 32 + r32] = (bf16)f2bf(o[d0][r] * rli[r]); }
        asm volatile("s_waitcnt lgkmcnt(0)" ::: "memory");
#pragma unroll
        for (int i = 0; i < 4; ++i) { const int row = i * 8 + (lane >> 3), ch = lane & 7;
            const u32x4 v = *(const LAS u32x4*)(stg + row * 64 + ch * 8);
            const u32x4 g = *(const GAS u32x4*)(Z + (rowbase + q0 + wid * 32 + row) * ZP + gcol + ch * 8);
            u32x4 w;
            w.x = pk2(__uint_as_float(v.x << 16) * __uint_as_float(g.x << 16), __uint_as_float(v.x & 0xffff0000u) * __uint_as_float(g.x & 0xffff0000u));
            w.y = pk2(__uint_as_float(v.y << 16) * __uint_as_float(g.y << 16), __uint_as_float(v.y & 0xffff0000u) * __uint_as_float(g.y & 0xffff0000u));
            w.z = pk2(__uint_as_float(v.z << 16) * __uint_as_float(g.z << 16), __uint_as_float(v.z & 0xffff0000u) * __uint_as_float(g.z & 0xffff0000u));
            w.w = pk2(__uint_as_float(v.w << 16) * __uint_as_float(g.w << 16), __uint_as_float(v.w & 0xffff0000u) * __uint_as_float(g.w & 0xffff0000u));
            *(GAS u32x4*)(Y + (rowbase + q0 + wid * 32 + row) * YP + ycol + ch * 8) = w; } }
    asm volatile("s_waitcnt lgkmcnt(0)\n\ts_barrier" ::: "memory");
}
__device__ __forceinline__ void attn_phase(const bf16* Z, bf16* Y, const float* sinks, const float* lutg, const float* m0g, LAS unsigned char* shm, int vcu, int G, int tid) {
    int prev_hh = -1;
    for (int u = vcu; u < 1024; u += G) {
        const int i = u >> 8, v = u & 255, bh = v >> 2, s = v & 3, b = bh >> 4, h = bh & 15;
        const int qb = (i == 0) ? 7 - s : (i == 1) ? s : (i == 2) ? 2 * s : 2 * s + 1, hh = (i < 2) ? 16 + h : h;
        attn_unit(b, hh, qb, Z, Y, sinks, lutg, m0g, hh != prev_hh, shm, tid);
        prev_hh = hh;
    }
}
__device__ __forceinline__ void build_tables(float* lutg, float* m0g, const float* relb, const float* ev_qk_g, int gtid, int gthreads) {
    for (int e = gtid; e < 32 * LUT_N; e += gthreads) { const int hh = e / LUT_N, i = e % LUT_N, d = i - LUT_OFF; float val = -1e30f;
        if (d >= 0) { const int w = (hh >= 16) ? ((d <= 128 ? 1 : 0) + (((d & 3) == 0 && d <= 512) ? 1 : 0) + (((d & 15) == 0) ? 1 : 0)) : (d <= 127 ? 1 : 0);
            if (w > 0) val = relb[t5_bucket(d) * 32 + hh] * LOG2E + (w == 1 ? 0.f : (w == 2 ? 1.0f : 1.5849625f)); }
        lutg[e] = val; }
    if (gtid < 64) { const int j = gtid >> 5, hh = gtid & 31; const float* gq = ev_qk_g + j * 256 + (hh >= 16 ? 128 : 0); const float* gk = gq + 64;
        float maxg = 0.f, maxb = 0.f;
        for (int d = 0; d < 64; ++d) maxg = fmaxf(maxg, fabsf(gq[d] * gk[d]));
        for (int k = 0; k < 32; ++k) maxb = fmaxf(maxb, fabsf(relb[k * 32 + hh]));
        m0g[gtid] = (8.0f * maxg + maxb) * LOG2E + 1.5849625f + 0.25f; }
}
#undef ATT_WAIT_BAR
#undef ATT_SBAR
#undef ATT_LUTV
#undef ATT_LUT4
}

namespace mix {
using bf16x8 = __attribute__((ext_vector_type(8))) short;
using s16x4 = __attribute__((ext_vector_type(4))) short;
using f32x16 = __attribute__((ext_vector_type(16))) float;
using u32x4 = __attribute__((ext_vector_type(4))) unsigned;
constexpr int L_V = 0, L_STG = 65536, L_RS = RING_BYTES + 2048;
#define MIX_DMA_V(ch_, g_) do { const bf16* src_ = V + (size_t)((ch_) * 128 + (lane >> 2)) * CWID + 256 * (g_) + 32 * wid + (lane & 3) * 8; \
    _Pragma("unroll") for (int kg = 0; kg < 8; ++kg) att::glds16(src_ + (size_t)(16 * kg) * CWID, (unsigned)__builtin_amdgcn_readfirstlane(lds0 + L_V + (wid * 8 + kg) * 1024)); } while (0)
__device__ __forceinline__ void mix_phase(const bf16* UG, const bf16* V, bf16* Y, const float* ssv, const float* vg, const float* wsp, const float* bsp, LAS unsigned char* shm, int vcu, int G, const int tid) {
    const int lane = tid & 63, r32 = lane & 31, hi = lane >> 5; const int wid = __builtin_amdgcn_readfirstlane(tid >> 6);
    const int tb = wid & 3, ch2 = wid >> 2, nks = 2 * tb + 2;
    LAS float* rs = (LAS float*)(shm + L_RS);
    const unsigned lds0 = (unsigned)(uintptr_t)shm;
    const int vb = (int)(lds0 + L_V) + ch2 * 32768 + ((lane >> 4) & 1) * 32 + (lane & 3) * 8 + (4 * hi + ((lane & 15) >> 2)) * 64;
    LAS bf16* stg = (LAS bf16*)(shm + L_STG) + wid * 4096;
    int u = vcu;
    if (u < 1024) { if (tid < 128) rs[tid] = __builtin_amdgcn_rsqf(ssv[(u >> 4) * 128 + tid] * (1.f / 4096.f) + EPS); MIX_DMA_V(u >> 4, u & 15); }
    for (; u < 1024; u += G) {
        const int ch = u >> 4, g = u & 15, row0 = ch * 128;
        const int t = 32 * tb + r32; const float* wrow = wsp + ((size_t)g * 128 + t) * 128 + 4 * hi;
        f32x4 wa[8][2];
#pragma unroll
        for (int ks = 0; ks < 8; ++ks) if (ks < nks) { wa[ks][0] = *(const GAS f32x4*)(wrow + 16 * ks); wa[ks][1] = *(const GAS f32x4*)(wrow + 16 * ks + 8); }
        asm volatile("s_waitcnt vmcnt(0) lgkmcnt(0)\n\ts_barrier" ::: "memory");
        bf16x8 af[8];
#pragma unroll
        for (int ks = 0; ks < 8; ++ks) { af[ks] = bf16x8{};
            if (ks < nks) { const int s0 = 16 * ks + 4 * hi;
                f32x4 a = wa[ks][0] * *(const LAS f32x4*)(rs + s0), b = wa[ks][1] * *(const LAS f32x4*)(rs + s0 + 8);
                a.x = (s0 + 0 <= t) ? a.x : 0.f; a.y = (s0 + 1 <= t) ? a.y : 0.f; a.z = (s0 + 2 <= t) ? a.z : 0.f; a.w = (s0 + 3 <= t) ? a.w : 0.f;
                b.x = (s0 + 8 <= t) ? b.x : 0.f; b.y = (s0 + 9 <= t) ? b.y : 0.f; b.z = (s0 + 10 <= t) ? b.z : 0.f; b.w = (s0 + 11 <= t) ? b.w : 0.f;
                u32x4 w; w.x = pk2(a.x, a.y); w.y = pk2(a.z, a.w); w.z = pk2(b.x, b.y); w.w = pk2(b.z, b.w);
                af[ks] = __builtin_bit_cast(bf16x8, w); } }
        f32x16 acc[4];
#pragma unroll
        for (int nb = 0; nb < 4; ++nb) { acc[nb] = f32x16{};
#pragma unroll
            for (int ks = 0; ks < 8; ++ks) { if (ks < nks) { s16x4 lo, hh;
                asm volatile("ds_read_b64_tr_b16 %0,%1 offset:%c2" : "=&v"(lo) : "v"(vb), "i"(nb * 8192 + ks * 1024) : "memory");
                asm volatile("ds_read_b64_tr_b16 %0,%1 offset:%c2" : "=&v"(hh) : "v"(vb), "i"(nb * 8192 + ks * 1024 + 512) : "memory");
                asm volatile("s_waitcnt lgkmcnt(0)" ::: "memory"); __builtin_amdgcn_sched_barrier(0);
                const bf16x8 bfr = (bf16x8){lo[0], lo[1], lo[2], lo[3], hh[0], hh[1], hh[2], hh[3]};
                acc[nb] = __builtin_amdgcn_mfma_f32_32x32x16_bf16(af[ks], bfr, acc[nb], 0, 0, 0); } } }
        asm volatile("s_waitcnt lgkmcnt(0)\n\ts_barrier" ::: "memory");
        { const int un = u + G; if (un < 1024) { if (tid < 128) rs[tid] = __builtin_amdgcn_rsqf(ssv[(un >> 4) * 128 + tid] * (1.f / 4096.f) + EPS); MIX_DMA_V(un >> 4, un & 15); } }
#pragma unroll
        for (int nb = 0; nb < 4; ++nb) { const float gv = vg[256 * g + 128 * ch2 + 32 * nb + r32];
#pragma unroll
            for (int r = 0; r < 16; ++r) { const int tl = (r & 3) + 8 * (r >> 2) + 4 * hi;
                stg[tl * 128 + 32 * nb + r32] = (bf16)f2bf(acc[nb][r] * gv + bsp[g * 128 + 32 * tb + tl]); } }
        asm volatile("s_waitcnt lgkmcnt(0)" ::: "memory");
#pragma unroll
        for (int i = 0; i < 8; ++i) { const int row = i * 4 + (lane >> 4), chk = lane & 15;
            const u32x4 s = *(const LAS u32x4*)(stg + row * 128 + chk * 8);
            const size_t idx = (size_t)(row0 + 32 * tb + row) * CWID + 256 * g + 128 * ch2 + chk * 8;
            const u32x4 q = *(const GAS u32x4*)(UG + idx);
            u32x4 w;
            w.x = pk2(__uint_as_float(s.x << 16) * __uint_as_float(q.x << 16), __uint_as_float(s.x & 0xffff0000u) * __uint_as_float(q.x & 0xffff0000u));
            w.y = pk2(__uint_as_float(s.y << 16) * __uint_as_float(q.y << 16), __uint_as_float(s.y & 0xffff0000u) * __uint_as_float(q.y & 0xffff0000u));
            w.z = pk2(__uint_as_float(s.z << 16) * __uint_as_float(q.z << 16), __uint_as_float(s.z & 0xffff0000u) * __uint_as_float(q.z & 0xffff0000u));
            w.w = pk2(__uint_as_float(s.w << 16) * __uint_as_float(q.w << 16), __uint_as_float(s.w & 0xffff0000u) * __uint_as_float(q.w & 0xffff0000u));
            *(GAS u32x4*)(Y + idx) = w; }
        asm volatile("s_waitcnt lgkmcnt(0)" ::: "memory");
    }
}
#undef MIX_DMA_V
}

struct Args { const float* in[13]; float* out; unsigned char* ws; int ph_lo, ph_hi; };
__global__ void __launch_bounds__(NWAVES * 64, 2) skel_fwd(Args args) {
    extern __shared__ __attribute__((aligned(16))) unsigned char lds_raw[];
    LAS unsigned char* lds = (LAS unsigned char*)lds_raw;
    const int G = gridDim.x; int vcu; { const int bx = blockIdx.x; vcu = (G % 8 == 0) ? (bx % 8) * (G / 8) + bx / 8 : bx; }
    unsigned char* ws = args.ws;
    gu32* ctl = (gu32*)(ws + WS_CTL);
    for (int u = threadIdx.x; u < (LDS_BYTES - LDSCTL_OFF) / 4; u += NWAVES * 64) ((LAS unsigned*)(lds + LDSCTL_OFF))[u] = 0u;
    __syncthreads();
    const int lo = args.ph_lo, hi = args.ph_hi;
    XcdBarrier bar; bar.bar = (unsigned*)(ctl + CW_BAR); bar.x = 0; bar.st = nullptr;
    if (hi - lo > 1) bar = xcd_barrier_post((unsigned*)(ctl + CW_BAR), (volatile LAS unsigned*)(lds + MISC_OFF) + 8);
    const float* x_in = args.in[0];
    const float *ev_ln_g = args.in[1], *ev_w_in = args.in[2], *ev_qk_g = args.in[3], *ev_sinks = args.in[4], *ev_w_out = args.in[5];
    const float *od_ln_g = args.in[6], *od_w_in = args.in[7], *od_v_g = args.in[8], *od_w_s = args.in[9], *od_b_s = args.in[10], *od_w_out = args.in[11], *rel_bias = args.in[12];
    float* out = args.out;
    bf16* XN = (bf16*)(ws + WS_XN); bf16* Z = (bf16*)(ws + WS_Z); bf16* VB = (bf16*)(ws + WS_Z + 64 * MiB); bf16* Y = (bf16*)(ws + WS_Y);
    float* ssx = (float*)(ws + WS_CTL) + CW_SSX; float* ssv = (float*)(ws + WS_CTL) + CW_SSV;

    for (int p = lo; p < hi; ++p) {
        int kind = PH_PRO, layer = 0;
        if (p > 0) { layer = (p - 1) / 3; kind = 1 + (p - 1) % 3; }
        const int j = layer >> 1; const bool odd = (layer & 1) != 0;
#if DUP_MASK
        const int ndup = ((kind == PH_PRO && (DUP_MASK & 1)) || ((kind == PH_G1 || kind == PH_G2) && (DUP_MASK & 2)) || (kind == PH_G1 && !odd && (DUP_MASK & 16)) || (kind == PH_G1 && odd && (DUP_MASK & 32)) || (kind == PH_G2 && !odd && (DUP_MASK & 64)) || (kind == PH_G2 && odd && (DUP_MASK & 128)) || (kind == PH_MID && !odd && (DUP_MASK & 4)) || (kind == PH_MID && odd && (DUP_MASK & 8))) ? 2 : 1;
        for (int dup = 0; dup < ndup; ++dup) {
        if (dup > 0) xcd_barrier(bar);
        const bool dummy = (ndup == 2 && dup == 0);
#else
        const bool dummy = false;
#endif
        int tid = threadIdx.x; asm volatile("" : "+v"(tid));
        const int lane = tid & 63, wave = __builtin_amdgcn_readfirstlane(tid >> 6);
        if (kind == PH_PRO) {
            Weights W{ev_w_in, ev_w_out, od_w_in, od_w_out, ev_ln_g, od_ln_g};
            ph_prologue(lds, wave, lane, vcu, G, W, ws, x_in, ev_ln_g);
            att::build_tables((float*)(ws + WS_LUT), (float*)(ws + WS_LUT + 512 * 1024), rel_bias, ev_qk_g, vcu * (NWAVES * 64) + tid, G * NWAVES * 64);
        } else if (kind == PH_G1) {
            pg8::Gemm g{XN, odd ? (const bf16*)(ws + WS_OWIN + j * SZ_OWIN) : (const bf16*)(ws + WS_EWIN + j * SZ_EWIN), MROWS, odd ? OD_IN : EV_IN, DMODEL};
            pg8::StaticOrder S; S.init(g.M, g.N, G, (int)blockIdx.x);
            if (odd) { pg8::EpiOdd E{Z, VB, ssx + layer * MROWS, dummy ? (float*)(ws + WS_Y) : ssv + j * MROWS}; pg8::gemm_phase<pg8::EpiOdd, pg8::StaticOrder, true, true>(lds + RING_OFF, g, S, E, tid); }
            else { pg8::EpiQKV E{Z, g.N, ev_qk_g + j * 256, ssx + layer * MROWS}; pg8::gemm_phase<pg8::EpiQKV, pg8::StaticOrder, true, true>(lds + RING_OFF, g, S, E, tid);
                if (!dummy && !(PROBE_FULLPRO)) { const int rem = (g.M / 256) * (g.N / 256) % G, c = (int)blockIdx.x;
                    Weights W{ev_w_in, ev_w_out, od_w_in, od_w_out, ev_ln_g, od_ln_g};
                    if (rem == 0) convert_set(lds, wave, lane, W, ws, 1 + j, c * NWAVES + wave, G * NWAVES);
                    else if (c >= rem) convert_set(lds, wave, lane, W, ws, 1 + j, (c - rem) * NWAVES + wave, (G - rem) * NWAVES); } }
        } else if (kind == PH_G2) {
            pg8::Gemm g{Y, odd ? (const bf16*)(ws + WS_OWOUT + j * SZ_OWOUT) : (const bf16*)(ws + WS_EWOUT + j * SZ_EWOUT), MROWS, DMODEL, odd ? CWID : DMODEL};
            pg8::StaticOrder S; S.init(g.M, g.N, G, (int)blockIdx.x);
            const int nl = layer + 1;
            pg8::EpiResB E{XN, (nl < 4 || dummy) ? (float*)nullptr : out, dummy ? (float*)(ws + WS_Z) : ssx + (nl & 3) * MROWS, dummy ? 1 : 0};
            pg8::gemm_phase<pg8::EpiResB, pg8::StaticOrder, true, true>(lds + RING_OFF, g, S, E, tid);
        } else if (!odd) {
            att::attn_phase(Z, Y, ev_sinks + j * 16, (const float*)(ws + WS_LUT), (const float*)(ws + WS_LUT + 512 * 1024) + j * 32, lds + RING_OFF, vcu, G, tid);
        } else {
            mix::mix_phase(Z, VB, Y, ssv + j * MROWS, od_v_g + j * CWID, od_w_s + (size_t)j * 16 * 16384, od_b_s + j * 2048, lds + RING_OFF, vcu, G, tid);
        }
#if DUP_MASK
        }
#endif
        if (p + 1 < hi) xcd_barrier(bar);
    }
}

extern "C" void kernel_launch(void* const* d_in, const int* in_sizes, int n_in, void* d_out, int out_size, void* d_ws, size_t ws_size, hipStream_t stream) {
    static int grid = 0;
    if (grid == 0) {
        if (n_in != 13 || out_size != MROWS * DMODEL || ws_size < WS_END) { fprintf(stderr, "kernel_launch: unexpected shapes (n_in %d out %d ws %zu)\n", n_in, out_size, ws_size); grid = -1; return; }
        int dev = 0, cus = 0;
        if (hipGetDevice(&dev) != hipSuccess || hipDeviceGetAttribute(&cus, hipDeviceAttributeMultiprocessorCount, dev) != hipSuccess) { grid = -1; return; }
        if (hipFuncSetAttribute((const void*)skel_fwd, hipFuncAttributeMaxDynamicSharedMemorySize, LDS_BYTES) != hipSuccess) { fprintf(stderr, "kernel_launch: hipFuncSetAttribute failed\n"); grid = -1; return; }
        int per_cu = 0;
        (void)hipOccupancyMaxActiveBlocksPerMultiprocessor(&per_cu, (const void*)skel_fwd, NWAVES * 64, LDS_BYTES);
        (void)hipGetLastError();
        grid = cus;
    }
    if (grid < 0) return;
    (void)hipMemsetAsync((char*)d_ws + WS_CTL, 0, CTL_ZERO_BYTES, stream);
    Args a{};
    for (int i = 0; i < 13; ++i) a.in[i] = (const float*)d_in[i];
    a.out = (float*)d_out; a.ws = (unsigned char*)d_ws;
#if MK_ONE_LAUNCH
    a.ph_lo = 0; a.ph_hi = NPHASE;
    hipLaunchKernelGGL(skel_fwd, dim3(grid), dim3(NWAVES * 64), LDS_BYTES, stream, a);
#else
    for (int p = 0; p < NPHASE; ++p) { a.ph_lo = p; a.ph_hi = p + 1; hipLaunchKernelGGL(skel_fwd, dim3(grid), dim3(NWAVES * 64), LDS_BYTES, stream, a); }
#endif
}
```

```cpp
#include <hip/hip_runtime.h>
#include <cstdio>
#include <cstdint>
#define MK_ONE_LAUNCH 1

namespace pg8 {
#define PG8_LAS __attribute__((address_space(3)))
typedef unsigned short bf16_t;
typedef short bf16x8 __attribute__((ext_vector_type(8)));
typedef float f32x4 __attribute__((ext_vector_type(4)));
typedef unsigned u32x4 __attribute__((ext_vector_type(4)));
constexpr int BM = 256, BK = 64, HALF = 128, HTB = HALF * BK * 2  , STAGE_BYTES = 8 * HTB, NXCD = 8, WGM = 8;

__host__ __device__ __forceinline__ int lds_byte(int r, int c) { const int st = (r >> 4) * 2 + (c >> 5), rr = r & 15, cc = c & 31, ob = rr * 64 + cc * 2; return st * 1024 + (ob ^ (((ob >> 9) & 1) << 5)); }
__host__ __device__ __forceinline__ void stage_rc(int b, int& R, int& C) { const int st = b / 1024, sb = b % 1024, swz = sb ^ (((sb >> 9) & 1) << 5); R = (st >> 1) * 16 + swz / 64; C = (st & 1) * 32 + (swz % 64) / 2; }
__host__ __device__ __forceinline__ int perm32(int rho) { const int n = rho >> 4, i = rho & 15; return 8 * (i >> 2) + 4 * n + (i & 3); }

struct Unit { int pm, pn; };
struct Gemm { const bf16_t* A; const bf16_t* Bt; int M, N, K; };

struct StaticOrder {
    int nM, nN, nwg, G, c;
    __host__ __device__ void init(int M, int N, int G_, int c_) { nM = M / BM; nN = N / BM; nwg = nM * nN; G = G_; c = c_; }
    __host__ __device__ bool next(int i, Unit& u) const {
        const long L = (long)i * G + c; if (L >= nwg) return false;
        int wgid = (int)L; { const int q = nwg / NXCD, r = nwg % NXCD, xcd = wgid % NXCD, off = wgid / NXCD; wgid = (xcd < r ? xcd * (q + 1) : r * (q + 1) + (xcd - r) * q) + off; }
        const int nig = WGM * nN, gid = wgid / nig, fm = gid * WGM, gsz = (nM - fm) < WGM ? (nM - fm) : WGM;
        u.pm = fm + ((wgid % nig) % gsz); u.pn = (wgid % nig) / gsz; return true;
    }
    __device__ __forceinline__ void a_ready(const Unit&) const {}
    __device__ __forceinline__ void done(const Unit&) const {}
};

struct WindowOrder : StaticOrder { int i0, n;
    __device__ __forceinline__ bool next(int i, Unit& u) const { if (i >= n) return false; return StaticOrder::next(i + i0, u); } };

__device__ __forceinline__ unsigned cvt_pk_bf16(float lo, float hi) { unsigned r; asm volatile("v_cvt_pk_bf16_f32 %0, %1, %2" : "=v"(r) : "v"(lo), "v"(hi)); return r; }
typedef float f32x2 __attribute__((ext_vector_type(2)));
__device__ __forceinline__ f32x2 gelu_pk(f32x2 v) {
    const f32x2 av = __builtin_elementwise_abs(v), d = av * 0.2316418882f + 1.0f;
    f32x2 t; t.x = __builtin_amdgcn_rcpf(d.x); t.y = __builtin_amdgcn_rcpf(d.y);
    f32x2 q = t * 0.5307027145f + (-0.7265760135f); q = q * t + 0.7107068705f; q = q * t + (-0.142248368f); q = q * t + 0.127414796f; q = q * t;
    const f32x2 s = (v * v) * (-0.72134752044f);
    f32x2 e; e.x = __builtin_amdgcn_exp2f(s.x); e.y = __builtin_amdgcn_exp2f(s.y);
    const f32x2 m = v * (q * e), r = v - m;
    f32x2 o; o.x = v.x < 0.f ? m.x : r.x; o.y = v.y < 0.f ? m.y : r.y; return o;
}


__device__ __forceinline__ float silu_f(float x) { return x * __builtin_amdgcn_rcpf(1.0f + __builtin_amdgcn_exp2f(-1.4426950408889634f * x)); }
struct EpiAct {
    static constexpr bool PERM = true, AFTER_DRAIN = false;
    bf16_t* O; int ldc; int gelu_below; int silu_from;
    __device__ __forceinline__ void operator()(const f32x4 (&acc)[2][2][4][2], const Unit& u, int wr, int wc, int fr, int fq) const {
        const int row0 = u.pm * BM + wr * 64 + fr, col0 = u.pn * BM + wc * 32 + 8 * fq;
        const int mode = (u.pn < gelu_below) ? 1 : ((u.pn >= silu_from) ? 2 : 0);
#pragma unroll
        for (int ai = 0; ai < 2; ++ai)
#pragma unroll
            for (int m = 0; m < 4; ++m) { bf16_t* rowp = O + (size_t)(row0 + ai * HALF + m * 16) * ldc + col0;
#pragma unroll
                for (int bj = 0; bj < 2; ++bj) { f32x4 v0 = acc[ai][bj][m][0], v1 = acc[ai][bj][m][1];
                    if (mode == 1) { f32x2 a = gelu_pk((f32x2){v0[0], v0[1]}), b = gelu_pk((f32x2){v0[2], v0[3]}), c = gelu_pk((f32x2){v1[0], v1[1]}), d = gelu_pk((f32x2){v1[2], v1[3]});
                        v0 = (f32x4){a.x, a.y, b.x, b.y}; v1 = (f32x4){c.x, c.y, d.x, d.y}; }
                    else if (mode == 2) { v0 = (f32x4){silu_f(v0[0]), silu_f(v0[1]), silu_f(v0[2]), silu_f(v0[3])}; v1 = (f32x4){silu_f(v1[0]), silu_f(v1[1]), silu_f(v1[2]), silu_f(v1[3])}; }
                    u32x4 w; w.x = cvt_pk_bf16(v0[0], v0[1]); w.y = cvt_pk_bf16(v0[2], v0[3]); w.z = cvt_pk_bf16(v1[0], v1[1]); w.w = cvt_pk_bf16(v1[2], v1[3]);
                    *(u32x4*)(rowp + bj * HALF) = w; } }
    }
};
struct EpiRes {
    static constexpr bool PERM = false, AFTER_DRAIN = false;
    const float* base; float* out; int ldc;
    __device__ __forceinline__ void operator()(const f32x4 (&acc)[2][2][4][2], const Unit& u, int wr, int wc, int fr, int fq) const {
        const int row0 = u.pm * BM + wr * 64 + fr, col0 = u.pn * BM + wc * 32 + 4 * fq;
#pragma unroll
        for (int ai = 0; ai < 2; ++ai)
#pragma unroll
            for (int m = 0; m < 4; ++m) { const size_t off = (size_t)(row0 + ai * HALF + m * 16) * ldc + col0;
#pragma unroll
                for (int bj = 0; bj < 2; ++bj)
#pragma unroll
                    for (int n = 0; n < 2; ++n) { const f32x4 bs = *(const f32x4*)(base + off + bj * HALF + n * 16); *(f32x4*)(out + off + bj * HALF + n * 16) = bs + acc[ai][bj][m][n]; } }
    }
};

struct EpiQKV {
    static constexpr bool PERM = true, AFTER_DRAIN = false;
    bf16_t* O; int ldc; const float* qkg; const float* ssx;
    __device__ __forceinline__ void operator()(const f32x4 (&acc)[2][2][4][2], const Unit& u, int wr, int wc, int fr, int fq) const {
        const int row0 = u.pm * BM + wr * 64 + fr, colw = u.pn * BM + wc * 64;
        int mode = 0; const float* gv = qkg; float sc = 1.f;
        if (colw < 1024) { mode = 1; gv = qkg; sc = 0.125f * 1.4426950408889634f; }
        else if (colw < 1152) { mode = 1; gv = qkg + 64; }
        else if (colw < 1280) { mode = 0; }
        else if (colw < 2304) { mode = 2; }
        else if (colw < 3328) { mode = 1; gv = qkg + 128; sc = 0.125f * 1.4426950408889634f; }
        else if (colw < 4352) { mode = 1; gv = qkg + 192; }
        else if (colw < 5376) { mode = 0; }
        else { mode = 2; }
        f32x4 gg[2][2];
#pragma unroll
        for (int bj = 0; bj < 2; ++bj)
#pragma unroll
            for (int n = 0; n < 2; ++n) gg[bj][n] = (mode == 1) ? *(const f32x4*)(gv + 32 * bj + 8 * fq + 4 * n) * sc : (f32x4){1.f, 1.f, 1.f, 1.f};
#pragma unroll
        for (int ai = 0; ai < 2; ++ai)
#pragma unroll
            for (int m = 0; m < 4; ++m) { bf16_t* rowp = O + (size_t)(row0 + ai * HALF + m * 16) * ldc + colw + 8 * fq;
                f32x4 v[2][2];
                const float rx = __builtin_amdgcn_rsqf(ssx[row0 + ai * HALF + m * 16] * (1.f / 2048.f) + 1e-6f);
#pragma unroll
                for (int bj = 0; bj < 2; ++bj)
#pragma unroll
                    for (int n = 0; n < 2; ++n) v[bj][n] = acc[ai][bj][m][n] * rx;
                if (mode == 1) { float ss = 0.f;
#pragma unroll
                    for (int bj = 0; bj < 2; ++bj)
#pragma unroll
                        for (int n = 0; n < 2; ++n) ss += (v[bj][n][0] * v[bj][n][0] + v[bj][n][1] * v[bj][n][1]) + (v[bj][n][2] * v[bj][n][2] + v[bj][n][3] * v[bj][n][3]);
                    ss += __shfl_xor(ss, 16); ss += __shfl_xor(ss, 32);
                    const float r = __builtin_amdgcn_rsqf(ss * (1.f / 64.f) + 1e-6f);
#pragma unroll
                    for (int bj = 0; bj < 2; ++bj)
#pragma unroll
                        for (int n = 0; n < 2; ++n) v[bj][n] = v[bj][n] * r * gg[bj][n]; }
                else if (mode == 2) {
#pragma unroll
                    for (int bj = 0; bj < 2; ++bj)
#pragma unroll
                        for (int n = 0; n < 2; ++n) v[bj][n] = (f32x4){silu_f(v[bj][n][0]), silu_f(v[bj][n][1]), silu_f(v[bj][n][2]), silu_f(v[bj][n][3])}; }
#pragma unroll
                for (int bj = 0; bj < 2; ++bj) { u32x4 w; w.x = cvt_pk_bf16(v[bj][0][0], v[bj][0][1]); w.y = cvt_pk_bf16(v[bj][0][2], v[bj][0][3]); w.z = cvt_pk_bf16(v[bj][1][0], v[bj][1][1]); w.w = cvt_pk_bf16(v[bj][1][2], v[bj][1][3]);
                    *(u32x4*)(rowp + 32 * bj) = w; } }
    }
};

struct EpiOdd {
    static constexpr bool PERM = true, AFTER_DRAIN = false;
    bf16_t* UG; bf16_t* V; const float* ssx; float* ssv;
    __device__ __forceinline__ void operator()(const f32x4 (&acc)[2][2][4][2], const Unit& u, int wr, int wc, int fr, int fq) const {
        const int row0 = u.pm * BM + wr * 64 + fr;
        if (u.pn < 32) {
#pragma unroll
            for (int ai = 0; ai < 2; ++ai)
#pragma unroll
                for (int m = 0; m < 4; ++m) { const int row = row0 + ai * HALF + m * 16;
                    const float rx = __builtin_amdgcn_rsqf(ssx[row] * (1.f / 2048.f) + 1e-6f);
                    f32x4 o[2];
#pragma unroll
                    for (int n = 0; n < 2; ++n) { const f32x4 uu = acc[ai][0][m][n] * rx, gt = acc[ai][1][m][n] * rx;
                        const f32x2 a = gelu_pk((f32x2){uu[0], uu[1]}), b = gelu_pk((f32x2){uu[2], uu[3]});
                        o[n] = (f32x4){a.x * silu_f(gt[0]), a.y * silu_f(gt[1]), b.x * silu_f(gt[2]), b.y * silu_f(gt[3])}; }
                    u32x4 w; w.x = cvt_pk_bf16(o[0][0], o[0][1]); w.y = cvt_pk_bf16(o[0][2], o[0][3]); w.z = cvt_pk_bf16(o[1][0], o[1][1]); w.w = cvt_pk_bf16(o[1][2], o[1][3]);
                    *(u32x4*)(UG + (size_t)row * 4096 + u.pn * 128 + wc * 32 + 8 * fq) = w; }
        } else {
            const int colb = (u.pn - 32) * 256 + wc * 32 + 8 * fq;
#pragma unroll
            for (int ai = 0; ai < 2; ++ai)
#pragma unroll
                for (int m = 0; m < 4; ++m) { const int row = row0 + ai * HALF + m * 16;
                    const float rx = __builtin_amdgcn_rsqf(ssx[row] * (1.f / 2048.f) + 1e-6f);
                    float ss = 0.f;
#pragma unroll
                    for (int bj = 0; bj < 2; ++bj) { const f32x4 v0 = acc[ai][bj][m][0] * rx, v1 = acc[ai][bj][m][1] * rx;
                        const f32x2 a = gelu_pk((f32x2){v0[0], v0[1]}), b = gelu_pk((f32x2){v0[2], v0[3]}), c = gelu_pk((f32x2){v1[0], v1[1]}), d = gelu_pk((f32x2){v1[2], v1[3]});
                        ss += (a.x * a.x + a.y * a.y) + (b.x * b.x + b.y * b.y) + (c.x * c.x + c.y * c.y) + (d.x * d.x + d.y * d.y);
                        u32x4 w; w.x = cvt_pk_bf16(a.x, a.y); w.y = cvt_pk_bf16(b.x, b.y); w.z = cvt_pk_bf16(c.x, c.y); w.w = cvt_pk_bf16(d.x, d.y);
                        *(u32x4*)(V + (size_t)row * 4096 + colb + bj * HALF) = w; }
                    ss += __shfl_xor(ss, 16); ss += __shfl_xor(ss, 32);
                    if (fq == 0) atomicAdd(ssv + row, ss); }
        }
    }
};
struct EpiResN {
    static constexpr bool PERM = false, AFTER_DRAIN = false;
    const float* base; float* out; int ldc; bf16_t* xn; const float* gn; float* ssn;
    __device__ __forceinline__ void operator()(const f32x4 (&acc)[2][2][4][2], const Unit& u, int wr, int wc, int fr, int fq) const {
        typedef unsigned u32x2v __attribute__((ext_vector_type(2)));
        const int row0 = u.pm * BM + wr * 64 + fr, col0 = u.pn * BM + wc * 32 + 4 * fq;
        f32x4 gg[2][2];
#pragma unroll
        for (int bj = 0; bj < 2; ++bj)
#pragma unroll
            for (int n = 0; n < 2; ++n) gg[bj][n] = xn ? *(const f32x4*)(gn + col0 + bj * HALF + n * 16) : (f32x4){0.f, 0.f, 0.f, 0.f};
#pragma unroll
        for (int ai = 0; ai < 2; ++ai)
#pragma unroll
            for (int m = 0; m < 4; ++m) { const int row = row0 + ai * HALF + m * 16; const size_t off = (size_t)row * ldc + col0; float ss = 0.f;
#pragma unroll
                for (int bj = 0; bj < 2; ++bj)
#pragma unroll
                    for (int n = 0; n < 2; ++n) { const f32x4 o = *(const f32x4*)(base + off + bj * HALF + n * 16) + acc[ai][bj][m][n]; *(f32x4*)(out + off + bj * HALF + n * 16) = o;
                        if (xn) { ss += (o[0] * o[0] + o[1] * o[1]) + (o[2] * o[2] + o[3] * o[3]); const f32x4 t = o * gg[bj][n];
                            u32x2v w; w.x = cvt_pk_bf16(t[0], t[1]); w.y = cvt_pk_bf16(t[2], t[3]); *(u32x2v*)(xn + off + bj * HALF + n * 16) = w; } }
                if (xn) { ss += __shfl_xor(ss, 16); ss += __shfl_xor(ss, 32); if (fq == 0) atomicAdd(ssn + row, ss); } }
    }
};

struct EpiResB {
    static constexpr bool PERM = true, AFTER_DRAIN = false;
    bf16_t* xb; float* outf; float* ssn; int nowrite;
    __device__ __forceinline__ void operator()(const f32x4 (&acc)[2][2][4][2], const Unit& u, int wr, int wc, int fr, int fq) const {
        const int row0 = u.pm * BM + wr * 64 + fr, col0 = u.pn * BM + wc * 32 + 8 * fq;
#pragma unroll
        for (int ai = 0; ai < 2; ++ai)
#pragma unroll
            for (int m = 0; m < 4; ++m) { const int row = row0 + ai * HALF + m * 16; const size_t off = (size_t)row * 2048 + col0; float ss = 0.f;
#pragma unroll
                for (int bj = 0; bj < 2; ++bj) { const u32x4 b = *(const u32x4*)(xb + off + bj * HALF);
                    f32x4 o0 = acc[ai][bj][m][0], o1 = acc[ai][bj][m][1];
                    o0[0] += __uint_as_float(b.x << 16); o0[1] += __uint_as_float(b.x & 0xffff0000u); o0[2] += __uint_as_float(b.y << 16); o0[3] += __uint_as_float(b.y & 0xffff0000u);
                    o1[0] += __uint_as_float(b.z << 16); o1[1] += __uint_as_float(b.z & 0xffff0000u); o1[2] += __uint_as_float(b.w << 16); o1[3] += __uint_as_float(b.w & 0xffff0000u);
                    if (outf) { *(f32x4*)(outf + off + bj * HALF) = o0; *(f32x4*)(outf + off + bj * HALF + 4) = o1; }
                    else { ss += (o0[0] * o0[0] + o0[1] * o0[1]) + (o0[2] * o0[2] + o0[3] * o0[3]) + (o1[0] * o1[0] + o1[1] * o1[1]) + (o1[2] * o1[2] + o1[3] * o1[3]);
                        u32x4 w; w.x = cvt_pk_bf16(o0[0], o0[1]); w.y = cvt_pk_bf16(o0[2], o0[3]); w.z = cvt_pk_bf16(o1[0], o1[1]); w.w = cvt_pk_bf16(o1[2], o1[3]);
                        if (!nowrite) *(u32x4*)(xb + off + bj * HALF) = w; } }
                if (!outf) { ss += __shfl_xor(ss, 16); ss += __shfl_xor(ss, 32); if (fq == 0) atomicAdd(ssn + row, ss); } }
    }
};

template <class Epi, class Sched, bool ALIGN_EPI = false, bool SP2 = false>
__device__ __forceinline__ void gemm_phase(PG8_LAS unsigned char* lds, const Gemm g, const Sched& S, const Epi& E, const int tid) {
    const int wid = __builtin_amdgcn_readfirstlane(tid >> 6), lane = tid & 63, wr = wid >> 2, wc = wid & 3, fr = lane & 15, fq = lane >> 4;
    const int K = g.K, nt = K / BK;
    unsigned voffA[2], voffB[2];
#pragma unroll
    for (int i = 0; i < 2; ++i) { int R, C; stage_rc(tid * 16 + i * 8192, R, C); const int Rb = Epi::PERM ? ((R & ~31) + perm32(R & 31)) : R;
        voffA[i] = (unsigned)(R * K + C) * 2u; voffB[i] = (unsigned)(Rb * K + C) * 2u; }
    const size_t kstep = (size_t)(BK * 2);
    const size_t hstep = (size_t)HALF * K * 2;
    const size_t tstep = 2 * hstep;
    const unsigned ldsw = (unsigned)wid * 1024u;
    const int aoff = lds_byte(wr * 64 + fr, fq * 8), boff = lds_byte(wc * 32 + fr, fq * 8);
#define PG8_SA(b, h) (((b) * 2 + (h)) * HTB)
#define PG8_SB(b, h) ((4 + (b) * 2 + (h)) * HTB)
#define PG8_STAGE(bufoff, gbase, voff) do { _Pragma("unroll") for (int _i = 0; _i < 2; ++_i) \
        __builtin_amdgcn_global_load_lds((const unsigned*)((const char*)(gbase) + (voff)[_i]), (PG8_LAS unsigned*)(lds + (bufoff) + ldsw + _i * 8192), 16, 0, 0); } while (0)
#define PG8_LDA(dst, b, h) do { _Pragma("unroll") for (int m = 0; m < 4; ++m) _Pragma("unroll") for (int k = 0; k < 2; ++k) dst[m][k] = *(const PG8_LAS bf16x8*)(lds + PG8_SA(b, h) + aoff + m * 2048 + k * 1024); } while (0)
#define PG8_LDB(dst, b, h) do { _Pragma("unroll") for (int n = 0; n < 2; ++n) _Pragma("unroll") for (int k = 0; k < 2; ++k) dst[n][k] = *(const PG8_LAS bf16x8*)(lds + PG8_SB(b, h) + boff + n * 2048 + k * 1024); } while (0)
#define PG8_MMA(ai, bj, At, Bt) do { __builtin_amdgcn_s_setprio(1); _Pragma("unroll") for (int m = 0; m < 4; ++m) _Pragma("unroll") for (int n = 0; n < 2; ++n) _Pragma("unroll") for (int k = 0; k < 2; ++k) \
        acc[ai][bj][m][n] = __builtin_amdgcn_mfma_f32_16x16x32_bf16(Bt[n][k], At[m][k], acc[ai][bj][m][n], 0, 0, 0); __builtin_amdgcn_s_setprio(0); } while (0)
#define PG8_WAIT_V(n) asm volatile("s_waitcnt vmcnt(" #n ")" ::: "memory")
#define PG8_WAIT_L(n) asm volatile("s_waitcnt lgkmcnt(" #n ")" ::: "memory")
#define PG8_BAR __builtin_amdgcn_s_barrier()
#define PG8_SCHED __builtin_amdgcn_sched_barrier(0)
    Unit cur, nxt; int ui = 0;
    if (!S.next(0, cur)) return;
    f32x4 acc[2][2][4][2];
#pragma unroll
    for (int a = 0; a < 2; ++a)
#pragma unroll
        for (int b = 0; b < 2; ++b)
#pragma unroll
            for (int m = 0; m < 4; ++m)
#pragma unroll
                for (int n = 0; n < 2; ++n) acc[a][b][m][n] = (f32x4){0.f, 0.f, 0.f, 0.f};
    bf16x8 At[4][2], B0[2][2], B1[2][2];
    const char* cA = (const char*)g.A + (size_t)cur.pm * tstep; const char* cB = (const char*)g.Bt + (size_t)cur.pn * tstep;
    S.a_ready(cur);
    if constexpr (SP2) {
        PG8_STAGE(PG8_SB(0, 0), cB, voffB); PG8_STAGE(PG8_SB(0, 1), cB + hstep, voffB); PG8_STAGE(PG8_SA(0, 0), cA, voffA); PG8_STAGE(PG8_SA(0, 1), cA + hstep, voffA);
        if (wr == 1) PG8_BAR;
        PG8_WAIT_V(2); PG8_BAR;
        PG8_STAGE(PG8_SB(1, 0), cB + kstep, voffB); PG8_STAGE(PG8_SA(1, 0), cA + kstep, voffA); PG8_STAGE(PG8_SB(1, 1), cB + hstep + kstep, voffB);
        PG8_WAIT_V(6); PG8_BAR;
    } else {
        PG8_STAGE(PG8_SB(0, 0), cB, voffB); PG8_STAGE(PG8_SA(0, 0), cA, voffA); PG8_STAGE(PG8_SB(0, 1), cB + hstep, voffB); PG8_STAGE(PG8_SA(0, 1), cA + hstep, voffA);
        if (wr == 1) PG8_BAR;
        PG8_WAIT_V(4); PG8_BAR;
        PG8_STAGE(PG8_SB(1, 0), cB + kstep, voffB); PG8_STAGE(PG8_SA(1, 0), cA + kstep, voffA); PG8_STAGE(PG8_SB(1, 1), cB + hstep + kstep, voffB);
        PG8_WAIT_V(6); PG8_BAR;
    }
    for (;;) {
        const bool has_next = S.next(ui + 1, nxt);
        const char* nA = has_next ? (const char*)g.A + (size_t)nxt.pm * tstep : cA; const char* nB = has_next ? (const char*)g.Bt + (size_t)nxt.pn * tstep : cB;
        for (int t = 0; t < nt; t += 2) {
            const bool last = (t == nt - 2);
            const char* a1 = cA + (size_t)(t + 1) * kstep;
            const char* a2 = last ? nA : cA + (size_t)(t + 2) * kstep; const char* b2 = last ? nB : cB + (size_t)(t + 2) * kstep;
            const char* a3 = a2 + kstep; const char* b3 = b2 + kstep;
            if (last && has_next) S.a_ready(nxt);
            if constexpr (SP2) {
            PG8_LDB(B0, 0, 0); PG8_LDB(B1, 0, 1); PG8_SCHED; PG8_LDA(At, 0, 0); PG8_STAGE(PG8_SA(1, 1), a1 + hstep, voffA);
            PG8_WAIT_V(8); PG8_WAIT_L(0); PG8_BAR; PG8_MMA(0, 0, At, B0); PG8_MMA(0, 1, At, B1); PG8_BAR; PG8_SCHED;
            PG8_LDA(At, 0, 1); PG8_STAGE(PG8_SB(0, 0), b2, voffB); PG8_STAGE(PG8_SB(0, 1), b2 + hstep, voffB); PG8_STAGE(PG8_SA(0, 0), a2, voffA);
            PG8_WAIT_V(8); PG8_WAIT_L(0); PG8_BAR; PG8_MMA(1, 0, At, B0); PG8_MMA(1, 1, At, B1); PG8_BAR; PG8_SCHED;
            PG8_LDB(B0, 1, 0); PG8_LDB(B1, 1, 1); PG8_SCHED; PG8_LDA(At, 1, 0); PG8_STAGE(PG8_SA(0, 1), a2 + hstep, voffA);
            PG8_WAIT_V(8); PG8_WAIT_L(0); PG8_BAR; PG8_MMA(0, 0, At, B0); PG8_MMA(0, 1, At, B1); PG8_BAR; PG8_SCHED;
            PG8_LDA(At, 1, 1); PG8_STAGE(PG8_SB(1, 0), b3, voffB); PG8_STAGE(PG8_SB(1, 1), b3 + hstep, voffB); PG8_STAGE(PG8_SA(1, 0), a3, voffA);
            PG8_WAIT_V(8); PG8_WAIT_L(0); PG8_BAR; PG8_MMA(1, 0, At, B0); PG8_MMA(1, 1, At, B1); PG8_BAR; PG8_SCHED;
            } else {
            PG8_LDB(B0, 0, 0); PG8_SCHED; PG8_LDA(At, 0, 0); PG8_STAGE(PG8_SA(1, 1), a1 + hstep, voffA);
            PG8_WAIT_L(8); PG8_BAR; PG8_WAIT_L(0); PG8_MMA(0, 0, At, B0); PG8_BAR; PG8_SCHED;
            PG8_LDB(B1, 0, 1); PG8_STAGE(PG8_SB(0, 0), b2, voffB);
            PG8_BAR; PG8_WAIT_L(0); PG8_MMA(0, 1, At, B1); PG8_BAR;
            PG8_LDA(At, 0, 1); PG8_STAGE(PG8_SA(0, 0), a2, voffA);
            PG8_BAR; PG8_WAIT_L(0); PG8_MMA(1, 0, At, B0); PG8_BAR; PG8_SCHED;
            PG8_STAGE(PG8_SB(0, 1), b2 + hstep, voffB);
            PG8_WAIT_V(6); PG8_BAR; PG8_MMA(1, 1, At, B1); PG8_BAR;
            PG8_LDB(B0, 1, 0); PG8_SCHED; PG8_LDA(At, 1, 0); PG8_STAGE(PG8_SA(0, 1), a2 + hstep, voffA);
            PG8_WAIT_L(8); PG8_BAR; PG8_WAIT_L(0); PG8_MMA(0, 0, At, B0); PG8_BAR; PG8_SCHED;
            PG8_LDB(B1, 1, 1); PG8_STAGE(PG8_SB(1, 0), b3, voffB);
            PG8_BAR; PG8_WAIT_L(0); PG8_MMA(0, 1, At, B1); PG8_BAR;
            PG8_LDA(At, 1, 1); PG8_STAGE(PG8_SA(1, 0), a3, voffA);
            PG8_BAR; PG8_WAIT_L(0); PG8_MMA(1, 0, At, B0); PG8_BAR; PG8_SCHED;
            PG8_STAGE(PG8_SB(1, 1), b3 + hstep, voffB);
            PG8_WAIT_V(6); PG8_BAR; PG8_MMA(1, 1, At, B1); PG8_BAR;
            }
        }
        if constexpr (ALIGN_EPI) { if (wr == 0) PG8_BAR; }
        if constexpr (!Epi::AFTER_DRAIN) { E(acc, cur, wr, wc, fr, fq); S.done(cur); }
        if (!has_next) break;
#pragma unroll
        for (int a = 0; a < 2; ++a)
#pragma unroll
            for (int b = 0; b < 2; ++b)
#pragma unroll
                for (int m = 0; m < 4; ++m)
#pragma unroll
                    for (int n = 0; n < 2; ++n) acc[a][b][m][n] = (f32x4){0.f, 0.f, 0.f, 0.f};
        cur = nxt; cA = nA; cB = nB; ++ui;
        if constexpr (ALIGN_EPI) { if (wr == 1) PG8_BAR; }
    }
    PG8_WAIT_V(0);
    if constexpr (!ALIGN_EPI) { if (wr == 0) PG8_BAR; }
    PG8_BAR;
    if constexpr (Epi::AFTER_DRAIN) { E.fused(acc, cur, wr, wc, fr, fq, lds, wid, lane); S.done(cur); }
#undef PG8_SA
#undef PG8_SB
#undef PG8_STAGE
#undef PG8_LDA
#undef PG8_LDB
#undef PG8_MMA
#undef PG8_WAIT_V
#undef PG8_WAIT_L
#undef PG8_BAR
#undef PG8_SCHED
}
}


#define GAS __attribute__((address_space(1)))
#define LAS __attribute__((address_space(3)))
typedef unsigned short bf16;
typedef unsigned v4u __attribute__((ext_vector_type(4)));
typedef float f32x4 __attribute__((ext_vector_type(4)));
typedef short bf16x8 __attribute__((ext_vector_type(8)));
typedef GAS unsigned gu32;
typedef GAS unsigned long long gu64;
#define RLX_AGENT __ATOMIC_RELAXED, __HIP_MEMORY_SCOPE_AGENT
#define LDS_WAIT() asm volatile("s_waitcnt lgkmcnt(0)" ::: "memory")
#define VM_WAIT() asm volatile("s_waitcnt vmcnt(0)" ::: "memory")
__device__ __forceinline__ unsigned long long rt() { return __builtin_amdgcn_s_memrealtime(); }
__device__ __forceinline__ unsigned f2bf(float f) { unsigned u = __builtin_bit_cast(unsigned, f); return (u + 0x7fffu + ((u >> 16) & 1u)) >> 16; }
__device__ __forceinline__ unsigned pk2(float lo, float hi) { return f2bf(lo) | (f2bf(hi) << 16); }

#define XB_TMO      128
#define XB_XCNT(j)  (256  + 64 * (j))
#define XB_XSUB(j)  (1280 + 64 * (j))
#define XB_XGEN(j)  (2304 + 64 * (j))
#define XB_TOP      3328
#define XB_TOPGEN   3392
#define XCD_BAR_WORDS 3456
#define XB_SPIN_CAP (1u << 18)

__device__ __forceinline__ unsigned xb_ld(unsigned* p)              { return __hip_atomic_load(p, __ATOMIC_RELAXED, __HIP_MEMORY_SCOPE_AGENT); }
__device__ __forceinline__ unsigned xb_add(unsigned* p, unsigned v) { return __hip_atomic_fetch_add(p, v, __ATOMIC_RELAXED, __HIP_MEMORY_SCOPE_AGENT); }
__device__ __forceinline__ unsigned xb_xcc_id() { return (unsigned)__builtin_amdgcn_s_getreg((3 << 11) | 20) & 0xFu; }
#define XB_SPIN(cond, bar) do { unsigned _sp = 0; while (cond) { __builtin_amdgcn_s_sleep(1); \
    if ((++_sp & 255u) == 0u) { if (xb_ld(&(bar)[XB_TMO])) break; if (_sp > XB_SPIN_CAP) { atomicAdd(&(bar)[XB_TMO], 1u); break; } } } } while (0)

struct XcdBarrier {
    unsigned* bar; unsigned x;
    volatile LAS unsigned* st;
};

__device__ __forceinline__ XcdBarrier xcd_barrier_post(unsigned* bar, volatile LAS unsigned* st) {
    XcdBarrier b; b.bar = bar; b.x = xb_xcc_id(); b.st = st;
    if (threadIdx.x == 0) (void)xb_add(&bar[XB_XCNT(b.x)], 1u);
    return b;
}
__device__ __forceinline__ void xcd_barrier_complete(unsigned* bar, unsigned x, unsigned& nloc, unsigned& nx) {
    const unsigned G = gridDim.x * gridDim.y * gridDim.z;
    unsigned sum, cnt, mine, sp = 0u;
    for (;;) {
        sum = 0u; cnt = 0u; mine = 0u;
#pragma unroll
        for (unsigned j = 0; j < 16; ++j) { const unsigned c = xb_ld(&bar[XB_XCNT(j)]); sum += c; cnt += (c > 0u) ? 1u : 0u; mine = (j == x) ? c : mine; }
        if (sum == G) break;
        __builtin_amdgcn_s_sleep(1);
        if ((++sp & 255u) == 0u) { if (xb_ld(&bar[XB_TMO])) break; if (sp > XB_SPIN_CAP) { atomicAdd(&bar[XB_TMO], 1u); break; } }
    }
    nloc = mine > 0u ? mine : 1u; nx = cnt > 0u ? cnt : 1u;
}

__device__ __forceinline__ void xcd_barrier(const XcdBarrier& b) {
    asm volatile("s_waitcnt vmcnt(0)" ::: "memory");
    __syncthreads();
    if (threadIdx.x == 0) {
        unsigned* bar = b.bar;
        __builtin_amdgcn_s_waitcnt(0);
        unsigned nloc = b.st[0], nx = b.st[1];
        if (nloc == 0u) { xcd_barrier_complete(bar, b.x, nloc, nx); b.st[0] = nloc; b.st[1] = nx; }
        const unsigned old = xb_add(&bar[XB_XSUB(b.x)], 1u);
        const unsigned gen = old / nloc;
        if (old + 1u == (gen + 1u) * nloc) {
            __builtin_amdgcn_fence(__ATOMIC_RELEASE, "agent");
            asm volatile("s_waitcnt vmcnt(0)" ::: "memory");
            const unsigned og = xb_add(&bar[XB_TOP], 1u);
            const unsigned tg = og / nx;
            if (og + 1u == (tg + 1u) * nx) xb_add(&bar[XB_TOPGEN], 1u);
            else XB_SPIN(xb_ld(&bar[XB_TOPGEN]) == tg, bar);
            __builtin_amdgcn_fence(__ATOMIC_ACQUIRE, "agent");
            xb_add(&bar[XB_XGEN(b.x)], 1u);
            asm volatile("s_waitcnt vmcnt(0)" ::: "memory");
        } else {
            XB_SPIN(xb_ld(&bar[XB_XGEN(b.x)]) == gen, bar);
            __builtin_amdgcn_fence(__ATOMIC_ACQUIRE, "agent");
            asm volatile("s_waitcnt vmcnt(0)" ::: "memory");
        }
    }
    __syncthreads();
}

constexpr int NWAVES = 8;
#ifndef MK_ONE_LAUNCH
#define MK_ONE_LAUNCH 1
#endif
constexpr int SEQ = 2048, DMODEL = 2048, MROWS = 8192;
constexpr int EV_IN = 6400, OD_IN = 12288, CWID = 4096;
constexpr float EPS = 1e-6f;
constexpr size_t MiB = 1u << 20;
constexpr size_t WS_CTL = 0, CTL_ZERO_BYTES = 1 * MiB;
constexpr size_t WS_EWIN = 2 * MiB, SZ_EWIN = 25 * MiB;
constexpr size_t WS_EWOUT = 52 * MiB, SZ_EWOUT = 8 * MiB;
constexpr size_t WS_OWIN = 68 * MiB, SZ_OWIN = 48 * MiB;
constexpr size_t WS_OWOUT = 164 * MiB, SZ_OWOUT = 16 * MiB;
constexpr size_t WS_XN = 196 * MiB;
constexpr size_t WS_Z = 228 * MiB;
constexpr size_t WS_Y = 420 * MiB;
constexpr size_t WS_LUT = 484 * MiB;
constexpr size_t WS_END = 486 * MiB;
constexpr int CW_BAR = 4096;
constexpr int CW_SSX = 16384;
constexpr int CW_SSV = 49152;
static_assert((CW_SSV + 2 * 8192) * 4 <= (int)CTL_ZERO_BYTES, "CTL map");
constexpr int RING_OFF = 0, RING_BYTES = 131072;
constexpr int LDSCTL_OFF = RING_BYTES, MISC_OFF = LDSCTL_OFF + 320;
constexpr int LDS_BYTES = 147456;
constexpr int NPHASE = 15;
enum { PH_PRO = 0, PH_G1A, PH_G1B, PH_ATTB, PH_G2E, PH_G1O, PH_MIX, PH_G2O };

__device__ __forceinline__ float bf2f(unsigned short u) { return __uint_as_float((unsigned)u << 16); }
__device__ __forceinline__ float wave_sum(float v) {
#pragma unroll
    for (int o = 1; o < 64; o <<= 1) v += __shfl_xor(v, o);
    return v;
}
__device__ __forceinline__ int t5_bucket(int n) {
    if (n < 16) return n;
    return 16 + (n >= 22) + (n >= 30) + (n >= 40) + (n >= 54) + (n >= 73) + (n >= 99) + (n >= 134) + (n >= 182) + (n >= 246) + (n >= 332) + (n >= 450) + (n >= 609) + (n >= 825) + (n >= 1117) + (n >= 1513);
}

__device__ __forceinline__ void p0_transpose_item(const float* W, int K, int N, bf16* WT, LAS float* scr, int item, int lane, const int permkind, const float* gk = nullptr) {
    const int nblk = N / 32, kb = item / nblk, nb = item % nblk, k0 = 64 * kb, n0 = 32 * nb;
    int r0 = n0;
    if (permkind == 1) r0 = (n0 & ~255) + 128 * ((n0 >> 5) & 1) + 32 * ((n0 >> 6) & 3);
    else if (permkind == 2) r0 = (n0 < 4096) ? (256 * (n0 >> 7) + (n0 & 127))
                               : (n0 < 8192) ? (8192 + (n0 - 4096))
                               : (256 * ((n0 - 8192) >> 7) + 128 + ((n0 - 8192) & 127));
    { const int q4 = (lane & 7) * 4, rr = lane >> 3; const float* wp = W + (size_t)(k0 + rr) * N + n0 + q4; f32x4 v[8];
#pragma unroll
        for (int i = 0; i < 8; ++i) v[i] = *(const GAS f32x4*)(wp + (size_t)(8 * i) * N);
#pragma unroll
        for (int i = 0; i < 8; ++i) { LAS float* d = scr + (8 * i + rr) * 33 + q4; const float gs = gk ? gk[k0 + 8 * i + rr] : 1.0f;
            d[0] = v[i].x * gs; d[1] = v[i].y * gs; d[2] = v[i].z * gs; d[3] = v[i].w * gs; } }
    LDS_WAIT(); asm volatile("" ::: "memory");
    const int c = lane & 7;
#pragma unroll
    for (int j = 0; j < 4; ++j) { const int n = (lane >> 3) + 8 * j; const LAS float* s = scr + (8 * c) * 33 + n;
        v4u o; o.x = pk2(s[0 * 33], s[1 * 33]); o.y = pk2(s[2 * 33], s[3 * 33]); o.z = pk2(s[4 * 33], s[5 * 33]); o.w = pk2(s[6 * 33], s[7 * 33]);
        *(GAS v4u*)(WT + (size_t)(r0 + n) * K + k0 + 8 * c) = o; }
    LDS_WAIT(); asm volatile("" ::: "memory");
}
__device__ __forceinline__ void x_row_to_bf16(const float* xrow, bf16* orow, float* ss, int lane) {
    const GAS f32x4* xr = (const GAS f32x4*)xrow + lane;
    GAS unsigned long long* o8 = (GAS unsigned long long*)orow + lane; float s = 0.f;
#pragma unroll
    for (int j = 0; j < 8; ++j) { const f32x4 v = xr[64 * j]; s += (v.x * v.x + v.y * v.y) + (v.z * v.z + v.w * v.w);
        o8[64 * j] = (unsigned long long)pk2(v.x, v.y) | ((unsigned long long)pk2(v.z, v.w) << 32); }
    s = wave_sum(s);
    if (lane == 0) *ss = s;
}
struct Weights { const float *ev_w_in, *ev_w_out, *od_w_in, *od_w_out, *ev_ln_g, *od_ln_g; };
__device__ __forceinline__ void ph_prologue(LAS unsigned char* lds, int wave, int lane, int vcu, int G, const Weights& W, unsigned char* ws, const float* x) {
    LAS float* scr = (LAS float*)(lds + RING_OFF + wave * 16384);
    const int gw = vcu * NWAVES + wave, NGW = G * NWAVES;
    constexpr int I_EI = (DMODEL / 64) * (EV_IN / 32), I_EO = (DMODEL / 64) * (DMODEL / 32), I_OI = (DMODEL / 64) * (OD_IN / 32), I_OO = (CWID / 64) * (DMODEL / 32);
    constexpr int I_PAIR = I_EI + I_EO + I_OI + I_OO, NITEMS = 2 * I_PAIR;
    for (int it = gw; it < NITEMS; it += NGW) {
        const int j = it / I_PAIR; int r = it % I_PAIR;
        if (r < I_EI) { p0_transpose_item(W.ev_w_in + (size_t)j * DMODEL * EV_IN, DMODEL, EV_IN, (bf16*)(ws + WS_EWIN + j * SZ_EWIN), scr, r, lane, 1, W.ev_ln_g + j * DMODEL); continue; } r -= I_EI;
        if (r < I_EO) { p0_transpose_item(W.ev_w_out + (size_t)j * DMODEL * DMODEL, DMODEL, DMODEL, (bf16*)(ws + WS_EWOUT + j * SZ_EWOUT), scr, r, lane, 0); continue; } r -= I_EO;
        if (r < I_OI) { p0_transpose_item(W.od_w_in + (size_t)j * DMODEL * OD_IN, DMODEL, OD_IN, (bf16*)(ws + WS_OWIN + j * SZ_OWIN), scr, r, lane, 2, W.od_ln_g + j * DMODEL); continue; } r -= I_OI;
        p0_transpose_item(W.od_w_out + (size_t)j * CWID * DMODEL, CWID, DMODEL, (bf16*)(ws + WS_OWOUT + j * SZ_OWOUT), scr, r, lane, 0);
    }
    float* ssx0 = (float*)(ws + WS_CTL) + CW_SSX;
    for (int m = gw; m < MROWS; m += NGW) x_row_to_bf16(x + (size_t)m * DMODEL, (bf16*)(ws + WS_XN) + (size_t)m * DMODEL, ssx0 + m, lane);
}


namespace att {
using bf16x8 = __attribute__((ext_vector_type(8))) short;
using s16x4 = __attribute__((ext_vector_type(4))) short;
using f32x16 = __attribute__((ext_vector_type(16))) float;
using u32x4 = __attribute__((ext_vector_type(4))) unsigned;
typedef short v4i16_t __attribute__((ext_vector_type(4)));
typedef float f32x2_t __attribute__((ext_vector_type(2))); typedef __bf16 bf16x2_t __attribute__((ext_vector_type(2)));
typedef LAS const char* lds_cptr;
constexpr int ZP = 6400, YP = 2048, SLOTB = 8192, NSLOT = 3;
constexpr int L_K = 0, L_V = NSLOT * SLOTB, L_LUT = 2 * NSLOT * SLOTB, L_WS = L_LUT + 10240, L_OST = L_WS + 2048, L_END = L_OST + 32768;
static_assert(L_END <= 131072, "attention LDS map");
constexpr int LUT_N = 2304, LUT_OFF = 256;
constexpr float LOG2E = 1.4426950408889634f;
__device__ __forceinline__ int crow(int r, int hi) { return (r & 3) + 8 * (r >> 2) + 4 * hi; }
__device__ __forceinline__ void glds16(const void* gsrc, unsigned lds_dst) { unsigned keep;
    asm volatile("s_mov_b32 %0, m0\n\ts_mov_b32 m0, %2\n\ts_nop 0\n\tglobal_load_lds_dwordx4 %1, off\n\ts_mov_b32 m0, %0" : "=&s"(keep) : "v"(gsrc), "s"(lds_dst) : "memory"); }
__device__ __forceinline__ unsigned cvtpk_s(float lo, float hi) { f32x2_t v = {lo, hi}; bf16x2_t b = __builtin_convertvector(v, bf16x2_t); return __builtin_bit_cast(unsigned, b); }
#define ATT_WAIT_BAR(N) asm volatile("s_waitcnt vmcnt(" #N ") lgkmcnt(0)\n\ts_barrier" ::: "memory")
#define ATT_SBAR() __builtin_amdgcn_sched_barrier(0)
__device__ __forceinline__ void kload8(bf16x8* kf, lds_cptr kp) {
    kf[0] = *(const LAS bf16x8*)(kp);        kf[1] = *(const LAS bf16x8*)(kp + 512);
    kf[2] = *(const LAS bf16x8*)(kp + 2048); kf[3] = *(const LAS bf16x8*)(kp + 2560);
    kf[4] = *(const LAS bf16x8*)(kp + 4096); kf[5] = *(const LAS bf16x8*)(kp + 4608);
    kf[6] = *(const LAS bf16x8*)(kp + 6144); kf[7] = *(const LAS bf16x8*)(kp + 6656);
}
__device__ __forceinline__ void kload2(bf16x8* kf, lds_cptr kp, int j) { kf[2 * j] = *(const LAS bf16x8*)(kp + j * 2048); kf[2 * j + 1] = *(const LAS bf16x8*)(kp + j * 2048 + 512); }
__device__ __forceinline__ s16x4 vtr(lds_cptr p) { return __builtin_bit_cast(s16x4, __builtin_amdgcn_ds_read_tr16_b64_v4i16((LAS v4i16_t*)p)); }
__device__ __forceinline__ void pv(f32x16* o, int vb, bf16x8 pa0, bf16x8 pa1, bf16x8 pa2, bf16x8 pa3) {
#pragma unroll
    for (int d0 = 0; d0 < 2; ++d0) { s16x4 lo[4], hi[4];
#pragma unroll
        for (int ks = 0; ks < 4; ++ks) {
            asm volatile("ds_read_b64_tr_b16 %0,%1 offset:%c2" : "=&v"(lo[ks]) : "v"(vb), "i"(d0 * 4096 + ks * 1024) : "memory");
            asm volatile("ds_read_b64_tr_b16 %0,%1 offset:%c2" : "=&v"(hi[ks]) : "v"(vb), "i"(d0 * 4096 + ks * 1024 + 512) : "memory"); }
        asm volatile("s_waitcnt lgkmcnt(0)" ::: "memory"); ATT_SBAR();
#define ATT_PK(k) (bf16x8){lo[k][0], lo[k][1], lo[k][2], lo[k][3], hi[k][0], hi[k][1], hi[k][2], hi[k][3]}
        o[d0] = __builtin_amdgcn_mfma_f32_32x32x16_bf16(pa0, ATT_PK(0), o[d0], 0, 0, 0);
        o[d0] = __builtin_amdgcn_mfma_f32_32x32x16_bf16(pa1, ATT_PK(1), o[d0], 0, 0, 0);
        o[d0] = __builtin_amdgcn_mfma_f32_32x32x16_bf16(pa2, ATT_PK(2), o[d0], 0, 0, 0);
        o[d0] = __builtin_amdgcn_mfma_f32_32x32x16_bf16(pa3, ATT_PK(3), o[d0], 0, 0, 0);
#undef ATT_PK
    }
}
#define ATT_LUTV(lp, H, r) ((lp)[((H) ? 27 : 59) - (((r) & 3) + 8 * ((r) >> 2))])
#define ATT_LUT4(T, lp, H, B) do { T[0] = ATT_LUTV(lp, H, B); T[1] = ATT_LUTV(lp, H, (B) + 1); T[2] = ATT_LUTV(lp, H, (B) + 2); T[3] = ATT_LUTV(lp, H, (B) + 3); } while (0)
__device__ __forceinline__ void attn_unit(const int b, const int hh, const int qb, const bf16* Z, bf16* Y, const float* sinks, const float* lutg, const float* m0g, const bool newhead, LAS unsigned char* shm, const int tid) {
    const bool isB = hh >= 16; const int h = hh & 15;
    const int lane = tid & 63, r32 = lane & 31, hi = lane >> 5; const int wid = __builtin_amdgcn_readfirstlane(tid >> 6);
    const int qcol = isB ? 2304 + h * 64 : h * 64;
    const int kcol = isB ? 3328 + h * 64 : 1024 + (h >> 3) * 64;
    const int vcol = isB ? 4352 + h * 64 : 1152 + (h >> 3) * 64;
    const int gcol = isB ? 5376 + h * 64 : 1280 + h * 64;
    const int ycol = (isB ? 1024 : 0) + h * 64;
    const long rowbase = (long)b * SEQ; const int q0 = qb * 256;
    const int t_lo = isB ? 0 : (qb > 0 ? 4 * qb - 2 : 0), NT = 4 * qb + 4 - t_lo;
    const float M0 = m0g[hh];
    LAS float* lut = (LAS float*)(shm + L_LUT);
    if (newhead) { for (int i = tid; i < LUT_N; i += 512) lut[i] = lutg[hh * LUT_N + i] - M0; }
    const bf16* Qw = Z + (rowbase + q0 + wid * 32) * ZP + qcol;
    const unsigned lds0 = (unsigned)(uintptr_t)shm;
    const bf16* ksrc = Z + (rowbase + 64 * t_lo + lane) * ZP + kcol + wid * 8;
    const bf16* vsrc = Z + (rowbase + 64 * t_lo + 16 * (wid & 3) + (lane >> 2)) * ZP + vcol + (wid >> 2) * 32 + (lane & 3) * 8;
    const unsigned kdst = lds0 + L_K + wid * 1024, vdst = lds0 + L_V + wid * 1024;
#define ATT_DMA_K(i, slot) glds16(ksrc + (long)(i) * 64 * ZP, (unsigned)__builtin_amdgcn_readfirstlane(kdst + (slot)))
#define ATT_DMA_V(i, slot) glds16(vsrc + (long)(i) * 64 * ZP, (unsigned)__builtin_amdgcn_readfirstlane(vdst + (slot)))
    const int vb0 = (int)(lds0 + L_V) + ((lane >> 4) & 1) * 32 + (lane & 3) * 8 + (4 * hi + ((lane & 15) >> 2)) * 64;
    const lds_cptr shm3 = (lds_cptr)shm; const lds_cptr kp0 = shm3 + L_K + hi * 1024 + r32 * 16; const lds_cptr vp0 = shm3 + L_V + ((lane >> 4) & 1) * 32 + (lane & 3) * 8 + (4 * hi + ((lane & 15) >> 2)) * 64;
    bf16x8 kf[8];
    ATT_DMA_K(0, 0); ATT_DMA_V(0, 0); ATT_DMA_K(1, SLOTB);
    bf16x8 qr[4];
#pragma unroll
    for (int d0 = 0; d0 < 4; ++d0) qr[d0] = *reinterpret_cast<const bf16x8*>(Qw + (long)r32 * ZP + d0 * 16 + hi * 8);
    float l_reg = 0.f; f32x16 o[2]; o[0] = f32x16{}; o[1] = f32x16{};
    const LAS float* lp0 = lut + (q0 + wid * 32 + r32 - 64 * t_lo - 4 * hi + LUT_OFF - 59);
    f32x16 pA0, pA1, pB0, pB1;
    int sl_prev = 0, sl_cur = 0, sl_next = SLOTB;
#define ATT_ROT() do { sl_prev = sl_cur; sl_cur = sl_next; sl_next = (sl_next == (NSLOT - 1) * SLOTB) ? 0 : sl_next + SLOTB; } while (0)
    ATT_DMA_K(2, 2 * SLOTB);
    ATT_WAIT_BAR(3);
    { const lds_cptr kb = kp0;
#pragma unroll
        for (int d0 = 0; d0 < 4; ++d0) { const bf16x8 b0 = *(const LAS bf16x8*)(kb + d0 * 2048), b1 = *(const LAS bf16x8*)(kb + d0 * 2048 + 512);
            if (d0 == 0) { pA0 = __builtin_amdgcn_mfma_f32_32x32x16_bf16(b0, qr[0], f32x16{}, 0, 0, 0); pA1 = __builtin_amdgcn_mfma_f32_32x32x16_bf16(b1, qr[0], f32x16{}, 0, 0, 0); }
            else { pA0 = __builtin_amdgcn_mfma_f32_32x32x16_bf16(b0, qr[d0], pA0, 0, 0, 0); pA1 = __builtin_amdgcn_mfma_f32_32x32x16_bf16(b1, qr[d0], pA1, 0, 0, 0); } } }
#pragma unroll
    for (int r = 0; r < 16; ++r) { pA0[r] = __builtin_amdgcn_exp2f(pA0[r] + ATT_LUTV(lp0, 0, r)); pA1[r] = __builtin_amdgcn_exp2f(pA1[r] + ATT_LUTV(lp0, 1, r)); }
    ATT_WAIT_BAR(0);
    ATT_DMA_K(3, 0); ATT_DMA_V(1, SLOTB);
    ATT_ROT();
    kload8(kf, kp0 + sl_cur);
    ATT_WAIT_BAR(2);
    s16x4 vlo[8], vhi[8]; u32x4 pw0, pw1, pw2, pw3;
#define ATT_PKW(P, B) cvtpk_s(P[B], P[B + 1])
#define ATT_PAF(k) __builtin_bit_cast(bf16x8, pw##k)
#define ATT_VFR(i) (bf16x8){vlo[i][0], vlo[i][1], vlo[i][2], vlo[i][3], vhi[i][0], vhi[i][1], vhi[i][2], vhi[i][3]}
#define ATT_PIN(x) asm volatile("" : "+v"(x))
#define ATT_GAPA(MF, A0, A1, A2, A3, W0, W1, PW) do { MF; sacc += A0; sacc += A1; sacc += A2; sacc += A3; ATT_PIN(sacc); W0; W1; ATT_PIN(PW); ATT_SBAR(); } while (0)
#define ATT_EX(v) __builtin_amdgcn_exp2f(v)
#define ATT_GAPB(MF, X, B, TC, TN, HN, BN) do { MF; ATT_LUT4(TN, lpc_, HN, BN); \
    X[B] = ATT_EX(X[B] + TC[0]); X[B + 1] = ATT_EX(X[B + 1] + TC[1]); X[B + 2] = ATT_EX(X[B + 2] + TC[2]); X[B + 3] = ATT_EX(X[B + 3] + TC[3]); ATT_PIN(X); ATT_SBAR(); } while (0)
#define ATT_VRD(i) do { vlo[i] = vtr(vp_ + (((i) >> 2) * 4096 + ((i) & 3) * 1024)); vhi[i] = vtr(vp_ + (((i) >> 2) * 4096 + ((i) & 3) * 1024 + 512)); } while (0)
#define ATT_KRD(G, j) do { if (G) { kload2(kf, kp0 + sl_next, j); ATT_SBAR(); } } while (0)
#define ATT_STEP(C0, C1, P0, P1, i, GK, GV, GL) do { ATT_SBAR(); \
    const lds_cptr vp_ = vp0 + sl_prev; const LAS float* lpc_ = lp0 - 64 * (i); float ta_[4], tb_[4]; \
    ATT_VRD(0); ATT_SBAR(); float sacc = (P0[0] + P0[1]); \
    ATT_GAPA(C0 = __builtin_amdgcn_mfma_f32_32x32x16_bf16(kf[0], qr[0], f32x16{}, 0, 0, 0), P0[2], P0[3], P0[4], P0[5],     pw0[0] = ATT_PKW(P0, 0), pw0[1] = ATT_PKW(P0, 2), pw0); \
    ATT_VRD(4); ATT_SBAR(); ATT_GAPA(C1 = __builtin_amdgcn_mfma_f32_32x32x16_bf16(kf[1], qr[0], f32x16{}, 0, 0, 0), P0[6], P0[7], P0[8], P0[9],     pw0[2] = ATT_PKW(P0, 4), pw0[3] = ATT_PKW(P0, 6), pw0); \
    ATT_VRD(1); ATT_SBAR(); ATT_GAPA(C0 = __builtin_amdgcn_mfma_f32_32x32x16_bf16(kf[2], qr[1], C0, 0, 0, 0), P0[10], P0[11], P0[12], P0[13], pw1[0] = ATT_PKW(P0, 8), pw1[1] = ATT_PKW(P0, 10), pw1); \
    ATT_VRD(5); ATT_SBAR(); ATT_GAPA(C1 = __builtin_amdgcn_mfma_f32_32x32x16_bf16(kf[3], qr[1], C1, 0, 0, 0), P0[14], P0[15], P1[0], P1[1],   pw1[2] = ATT_PKW(P0, 12), pw1[3] = ATT_PKW(P0, 14), pw1); \
    ATT_VRD(2); ATT_SBAR(); ATT_GAPA(C0 = __builtin_amdgcn_mfma_f32_32x32x16_bf16(kf[4], qr[2], C0, 0, 0, 0), P1[2], P1[3], P1[4], P1[5],     pw2[0] = ATT_PKW(P1, 0), pw2[1] = ATT_PKW(P1, 2), pw2); \
    ATT_VRD(6); ATT_SBAR(); ATT_GAPA(C1 = __builtin_amdgcn_mfma_f32_32x32x16_bf16(kf[5], qr[2], C1, 0, 0, 0), P1[6], P1[7], P1[8], P1[9],     pw2[2] = ATT_PKW(P1, 4), pw2[3] = ATT_PKW(P1, 6), pw2); \
    ATT_VRD(3); ATT_SBAR(); ATT_GAPA(C0 = __builtin_amdgcn_mfma_f32_32x32x16_bf16(kf[6], qr[3], C0, 0, 0, 0), P1[10], P1[11], P1[12], P1[13], pw3[0] = ATT_PKW(P1, 8), pw3[1] = ATT_PKW(P1, 10), pw3); \
    ATT_VRD(7); ATT_SBAR(); ATT_GAPA(C1 = __builtin_amdgcn_mfma_f32_32x32x16_bf16(kf[7], qr[3], C1, 0, 0, 0), P1[14], P1[15], 0.f, 0.f,       pw3[2] = ATT_PKW(P1, 12), pw3[3] = ATT_PKW(P1, 14), pw3); \
    l_reg += sacc; \
    if (GK) { ATT_DMA_K((i) + 3, sl_cur); } if (GV) { ATT_DMA_V((i) + 1, sl_next); } \
    ATT_LUT4(ta_, lpc_, 0, 0); ATT_SBAR(); \
    ATT_GAPB(o[0] = __builtin_amdgcn_mfma_f32_32x32x16_bf16(ATT_PAF(0), ATT_VFR(0), o[0], 0, 0, 0), C0, 0, ta_, tb_, 0, 4); \
    ATT_GAPB(o[1] = __builtin_amdgcn_mfma_f32_32x32x16_bf16(ATT_PAF(0), ATT_VFR(4), o[1], 0, 0, 0), C0, 4, tb_, ta_, 0, 8); \
    ATT_KRD(GL, 0); ATT_GAPB(o[0] = __builtin_amdgcn_mfma_f32_32x32x16_bf16(ATT_PAF(1), ATT_VFR(1), o[0], 0, 0, 0), C0, 8, ta_, tb_, 0, 12); \
    ATT_KRD(GL, 1); ATT_GAPB(o[1] = __builtin_amdgcn_mfma_f32_32x32x16_bf16(ATT_PAF(1), ATT_VFR(5), o[1], 0, 0, 0), C0, 12, tb_, ta_, 1, 0); \
    ATT_KRD(GL, 2); ATT_GAPB(o[0] = __builtin_amdgcn_mfma_f32_32x32x16_bf16(ATT_PAF(2), ATT_VFR(2), o[0], 0, 0, 0), C1, 0, ta_, tb_, 1, 4); \
    ATT_KRD(GL, 3); ATT_GAPB(o[1] = __builtin_amdgcn_mfma_f32_32x32x16_bf16(ATT_PAF(2), ATT_VFR(6), o[1], 0, 0, 0), C1, 4, tb_, ta_, 1, 8); \
    ATT_GAPB(o[0] = __builtin_amdgcn_mfma_f32_32x32x16_bf16(ATT_PAF(3), ATT_VFR(3), o[0], 0, 0, 0), C1, 8, ta_, tb_, 1, 12); \
    ATT_GAPB(o[1] = __builtin_amdgcn_mfma_f32_32x32x16_bf16(ATT_PAF(3), ATT_VFR(7), o[1], 0, 0, 0), C1, 12, tb_, ta_, 1, 12); \
    } while (0)
#define ATT_ENDW(tt) do { if ((tt) + 3 < NT) { ATT_WAIT_BAR(2); } else if ((tt) + 2 < NT) { ATT_WAIT_BAR(1); } else { ATT_WAIT_BAR(0); } } while (0)
    int t = 1;
    for (; t + 1 < NT; t += 2) {
        ATT_STEP(pB0, pB1, pA0, pA1, t, (t + 3 < NT), (t + 1 < NT), (t + 1 < NT));         ATT_ENDW(t);     ATT_ROT();
        ATT_STEP(pA0, pA1, pB0, pB1, t + 1, (t + 4 < NT), (t + 2 < NT), (t + 2 < NT));     ATT_ENDW(t + 1); ATT_ROT();
    }
    ATT_STEP(pB0, pB1, pA0, pA1, NT - 1, false, false, false);
    { float sacc = pB0[0] + pB0[1];
#pragma unroll
        for (int r = 2; r < 16; ++r) sacc += pB0[r];
#pragma unroll
        for (int r = 0; r < 16; ++r) sacc += pB1[r];
        l_reg += sacc;
        pw0 = (u32x4){ATT_PKW(pB0, 0), ATT_PKW(pB0, 2), ATT_PKW(pB0, 4), ATT_PKW(pB0, 6)}; pw1 = (u32x4){ATT_PKW(pB0, 8), ATT_PKW(pB0, 10), ATT_PKW(pB0, 12), ATT_PKW(pB0, 14)};
        pw2 = (u32x4){ATT_PKW(pB1, 0), ATT_PKW(pB1, 2), ATT_PKW(pB1, 4), ATT_PKW(pB1, 6)}; pw3 = (u32x4){ATT_PKW(pB1, 8), ATT_PKW(pB1, 10), ATT_PKW(pB1, 12), ATT_PKW(pB1, 14)};
        ATT_SBAR(); pv(o, vb0 + sl_cur, ATT_PAF(0), ATT_PAF(1), ATT_PAF(2), ATT_PAF(3)); }
#undef ATT_PKW
#undef ATT_PAF
#undef ATT_VFR
#undef ATT_PIN
#undef ATT_GAPA
#undef ATT_GAPB
#undef ATT_EX
#undef ATT_VRD
#undef ATT_KRD
#undef ATT_STEP
#undef ATT_ENDW
#undef ATT_ROT
#undef ATT_DMA_K
#undef ATT_DMA_V
    { auto rr = __builtin_amdgcn_permlane32_swap(__float_as_uint(l_reg), __float_as_uint(l_reg), false, false); l_reg = __uint_as_float(rr[0]) + __uint_as_float(rr[1]); }
    if (!isB) l_reg += __builtin_amdgcn_exp2f(sinks[h] * LOG2E - M0);
    LAS float* wsf = (LAS float*)(shm + L_WS) + wid * 64;
    if (hi == 0) wsf[32 + r32] = l_reg;
    asm volatile("s_waitcnt lgkmcnt(0)" ::: "memory");
    float rli[16];
#pragma unroll
    for (int r = 0; r < 16; ++r) rli[r] = __builtin_amdgcn_rcpf(wsf[32 + crow(r, hi)]);
    { LAS bf16* stg = (LAS bf16*)(shm + L_OST) + wid * 2048;
#pragma unroll
        for (int r = 0; r < 16; ++r) { const int orow = crow(r, hi);
#pragma unroll
            for (int d0 = 0; d0 < 2; ++d0) stg[orow * 64 + d0 * 32 + r32] = (bf16)f2bf(o[d0][r] * rli[r]); }
        asm volatile("s_waitcnt lgkmcnt(0)" ::: "memory");
#pragma unroll
        for (int i = 0; i < 4; ++i) { const int row = i * 8 + (lane >> 3), ch = lane & 7;
            const u32x4 v = *(const LAS u32x4*)(stg + row * 64 + ch * 8);
            const u32x4 g = *(const GAS u32x4*)(Z + (rowbase + q0 + wid * 32 + row) * ZP + gcol + ch * 8);
            u32x4 w;
            w.x = pk2(__uint_as_float(v.x << 16) * __uint_as_float(g.x << 16), __uint_as_float(v.x & 0xffff0000u) * __uint_as_float(g.x & 0xffff0000u));
            w.y = pk2(__uint_as_float(v.y << 16) * __uint_as_float(g.y << 16), __uint_as_float(v.y & 0xffff0000u) * __uint_as_float(g.y & 0xffff0000u));
            w.z = pk2(__uint_as_float(v.z << 16) * __uint_as_float(g.z << 16), __uint_as_float(v.z & 0xffff0000u) * __uint_as_float(g.z & 0xffff0000u));
            w.w = pk2(__uint_as_float(v.w << 16) * __uint_as_float(g.w << 16), __uint_as_float(v.w & 0xffff0000u) * __uint_as_float(g.w & 0xffff0000u));
            *(GAS u32x4*)(Y + (rowbase + q0 + wid * 32 + row) * YP + ycol + ch * 8) = w; } }
    asm volatile("s_waitcnt lgkmcnt(0)\n\ts_barrier" ::: "memory");
}
__device__ __forceinline__ void attn_phase_b(const bf16* Z, bf16* Y, const float* sinks, const float* lutg, const float* m0g, LAS unsigned char* shm, int vcu, int G, int tid) {
    int prev_hh = -1;
    for (int u = vcu; u < 512; u += G) {
        const int i = u >> 8, v = u & 255, bh = v >> 2, s = v & 3, b = bh >> 4, h = bh & 15;
        attn_unit(b, 16 + h, (i == 0) ? 7 - s : s, Z, Y, sinks, lutg, m0g, (16 + h) != prev_hh, shm, tid);
        prev_hh = 16 + h;
    }
}
__device__ __forceinline__ void attn_phase_a(const bf16* Z, bf16* Y, const float* sinks, const float* lutg, const float* m0g, LAS unsigned char* shm, int a, int na, int tid) {
    int prev_hh = -1;
    for (int u = a; u < 512; u += na) {
        const int bh = u >> 3, qb = u & 7, b = bh >> 4, h = bh & 15;
        attn_unit(b, h, qb, Z, Y, sinks, lutg, m0g, h != prev_hh, shm, tid);
        prev_hh = h;
    }
}
__device__ __forceinline__ void build_tables(float* lutg, float* m0g, const float* relb, const float* ev_qk_g, int gtid, int gthreads) {
    for (int e = gtid; e < 32 * LUT_N; e += gthreads) { const int hh = e / LUT_N, i = e % LUT_N, d = i - LUT_OFF; float val = -1e30f;
        if (d >= 0) { const int w = (hh >= 16) ? ((d <= 128 ? 1 : 0) + (((d & 3) == 0 && d <= 512) ? 1 : 0) + (((d & 15) == 0) ? 1 : 0)) : (d <= 127 ? 1 : 0);
            if (w > 0) val = relb[t5_bucket(d) * 32 + hh] * LOG2E + (w == 1 ? 0.f : (w == 2 ? 1.0f : 1.5849625f)); }
        lutg[e] = val; }
    if (gtid < 64) { const int j = gtid >> 5, hh = gtid & 31; const float* gq = ev_qk_g + j * 256 + (hh >= 16 ? 128 : 0); const float* gk = gq + 64;
        float maxg = 0.f, maxb = 0.f;
        for (int d = 0; d < 64; ++d) maxg = fmaxf(maxg, fabsf(gq[d] * gk[d]));
        for (int k = 0; k < 32; ++k) maxb = fmaxf(maxb, fabsf(relb[k * 32 + hh]));
        m0g[gtid] = (8.0f * maxg + maxb) * LOG2E + 1.5849625f + 0.25f; }
}
#undef ATT_WAIT_BAR
#undef ATT_SBAR
#undef ATT_LUTV
#undef ATT_LUT4
}

namespace mix {
using bf16x8 = __attribute__((ext_vector_type(8))) short;
using s16x4 = __attribute__((ext_vector_type(4))) short;
using f32x16 = __attribute__((ext_vector_type(16))) float;
using u32x4 = __attribute__((ext_vector_type(4))) unsigned;
constexpr int L_V = 0, L_STG = 65536, L_RS = RING_BYTES + 2048;
#define MIX_DMA_V(ch_, g_) do { const bf16* src_ = V + (size_t)((ch_) * 128 + (lane >> 2)) * CWID + 256 * (g_) + 32 * wid + (lane & 3) * 8; \
    _Pragma("unroll") for (int kg = 0; kg < 8; ++kg) att::glds16(src_ + (size_t)(16 * kg) * CWID, (unsigned)__builtin_amdgcn_readfirstlane(lds0 + L_V + (wid * 8 + kg) * 1024)); } while (0)
__device__ __forceinline__ void mix_phase(const bf16* UG, const bf16* V, bf16* Y, const float* ssv, const float* vg, const float* wsp, const float* bsp, LAS unsigned char* shm, int vcu, int G, const int tid) {
    const int lane = tid & 63, r32 = lane & 31, hi = lane >> 5; const int wid = __builtin_amdgcn_readfirstlane(tid >> 6);
    const int tb = wid & 3, ch2 = wid >> 2, nks = 2 * tb + 2;
    LAS float* rs = (LAS float*)(shm + L_RS);
    const unsigned lds0 = (unsigned)(uintptr_t)shm;
    const int vb = (int)(lds0 + L_V) + ch2 * 32768 + ((lane >> 4) & 1) * 32 + (lane & 3) * 8 + (4 * hi + ((lane & 15) >> 2)) * 64;
    LAS bf16* stg = (LAS bf16*)(shm + L_STG) + wid * 4096;
    int u = vcu;
    if (u < 1024) { if (tid < 128) rs[tid] = __builtin_amdgcn_rsqf(ssv[(u >> 4) * 128 + tid] * (1.f / 4096.f) + EPS); MIX_DMA_V(u >> 4, u & 15); }
    for (; u < 1024; u += G) {
        const int ch = u >> 4, g = u & 15, row0 = ch * 128;
        const int t = 32 * tb + r32; const float* wrow = wsp + ((size_t)g * 128 + t) * 128 + 4 * hi;
        f32x4 wa[8][2];
#pragma unroll
        for (int ks = 0; ks < 8; ++ks) if (ks < nks) { wa[ks][0] = *(const GAS f32x4*)(wrow + 16 * ks); wa[ks][1] = *(const GAS f32x4*)(wrow + 16 * ks + 8); }
        asm volatile("s_waitcnt vmcnt(0) lgkmcnt(0)\n\ts_barrier" ::: "memory");
        bf16x8 af[8];
#pragma unroll
        for (int ks = 0; ks < 8; ++ks) { af[ks] = bf16x8{};
            if (ks < nks) { const int s0 = 16 * ks + 4 * hi;
                f32x4 a = wa[ks][0] * *(const LAS f32x4*)(rs + s0), b = wa[ks][1] * *(const LAS f32x4*)(rs + s0 + 8);
                a.x = (s0 + 0 <= t) ? a.x : 0.f; a.y = (s0 + 1 <= t) ? a.y : 0.f; a.z = (s0 + 2 <= t) ? a.z : 0.f; a.w = (s0 + 3 <= t) ? a.w : 0.f;
                b.x = (s0 + 8 <= t) ? b.x : 0.f; b.y = (s0 + 9 <= t) ? b.y : 0.f; b.z = (s0 + 10 <= t) ? b.z : 0.f; b.w = (s0 + 11 <= t) ? b.w : 0.f;
                u32x4 w; w.x = pk2(a.x, a.y); w.y = pk2(a.z, a.w); w.z = pk2(b.x, b.y); w.w = pk2(b.z, b.w);
                af[ks] = __builtin_bit_cast(bf16x8, w); } }
        f32x16 acc[4];
#pragma unroll
        for (int nb = 0; nb < 4; ++nb) { acc[nb] = f32x16{};
#pragma unroll
            for (int ks = 0; ks < 8; ++ks) { if (ks < nks) { s16x4 lo, hh;
                asm volatile("ds_read_b64_tr_b16 %0,%1 offset:%c2" : "=&v"(lo) : "v"(vb), "i"(nb * 8192 + ks * 1024) : "memory");
                asm volatile("ds_read_b64_tr_b16 %0,%1 offset:%c2" : "=&v"(hh) : "v"(vb), "i"(nb * 8192 + ks * 1024 + 512) : "memory");
                asm volatile("s_waitcnt lgkmcnt(0)" ::: "memory"); __builtin_amdgcn_sched_barrier(0);
                const bf16x8 bfr = (bf16x8){lo[0], lo[1], lo[2], lo[3], hh[0], hh[1], hh[2], hh[3]};
                acc[nb] = __builtin_amdgcn_mfma_f32_32x32x16_bf16(af[ks], bfr, acc[nb], 0, 0, 0); } } }
        asm volatile("s_waitcnt lgkmcnt(0)\n\ts_barrier" ::: "memory");
        { const int un = u + G; if (un < 1024) { if (tid < 128) rs[tid] = __builtin_amdgcn_rsqf(ssv[(un >> 4) * 128 + tid] * (1.f / 4096.f) + EPS); MIX_DMA_V(un >> 4, un & 15); } }
#pragma unroll
        for (int nb = 0; nb < 4; ++nb) { const float gv = vg[256 * g + 128 * ch2 + 32 * nb + r32];
#pragma unroll
            for (int r = 0; r < 16; ++r) { const int tl = (r & 3) + 8 * (r >> 2) + 4 * hi;
                stg[tl * 128 + 32 * nb + r32] = (bf16)f2bf(acc[nb][r] * gv + bsp[g * 128 + 32 * tb + tl]); } }
        asm volatile("s_waitcnt lgkmcnt(0)" ::: "memory");
#pragma unroll
        for (int i = 0; i < 8; ++i) { const int row = i * 4 + (lane >> 4), chk = lane & 15;
            const u32x4 s = *(const LAS u32x4*)(stg + row * 128 + chk * 8);
            const size_t idx = (size_t)(row0 + 32 * tb + row) * CWID + 256 * g + 128 * ch2 + chk * 8;
            const u32x4 q = *(const GAS u32x4*)(UG + idx);
            u32x4 w;
            w.x = pk2(__uint_as_float(s.x << 16) * __uint_as_float(q.x << 16), __uint_as_float(s.x & 0xffff0000u) * __uint_as_float(q.x & 0xffff0000u));
            w.y = pk2(__uint_as_float(s.y << 16) * __uint_as_float(q.y << 16), __uint_as_float(s.y & 0xffff0000u) * __uint_as_float(q.y & 0xffff0000u));
            w.z = pk2(__uint_as_float(s.z << 16) * __uint_as_float(q.z << 16), __uint_as_float(s.z & 0xffff0000u) * __uint_as_float(q.z & 0xffff0000u));
            w.w = pk2(__uint_as_float(s.w << 16) * __uint_as_float(q.w << 16), __uint_as_float(s.w & 0xffff0000u) * __uint_as_float(q.w & 0xffff0000u));
            *(GAS u32x4*)(Y + idx) = w; }
        asm volatile("s_waitcnt lgkmcnt(0)" ::: "memory");
    }
}
#undef MIX_DMA_V
}

struct Args { const float* in[13]; float* out; unsigned char* ws; int ph_lo, ph_hi; };
__global__ void __launch_bounds__(NWAVES * 64, 2) skel_fwd(Args args) {
    extern __shared__ __attribute__((aligned(16))) unsigned char lds_raw[];
    LAS unsigned char* lds = (LAS unsigned char*)lds_raw;
    const int G = gridDim.x; int vcu; { const int bx = blockIdx.x; vcu = (G % 8 == 0) ? (bx % 8) * (G / 8) + bx / 8 : bx; }
    unsigned char* ws = args.ws;
    gu32* ctl = (gu32*)(ws + WS_CTL);
    for (int u = threadIdx.x; u < (LDS_BYTES - LDSCTL_OFF) / 4; u += NWAVES * 64) ((LAS unsigned*)(lds + LDSCTL_OFF))[u] = 0u;
    __syncthreads();
    const int lo = args.ph_lo, hi = args.ph_hi;
    XcdBarrier bar; bar.bar = (unsigned*)(ctl + CW_BAR); bar.x = 0; bar.st = nullptr;
    if (hi - lo > 1) bar = xcd_barrier_post((unsigned*)(ctl + CW_BAR), (volatile LAS unsigned*)(lds + MISC_OFF) + 8);
    const float* x_in = args.in[0];
    const float *ev_ln_g = args.in[1], *ev_w_in = args.in[2], *ev_qk_g = args.in[3], *ev_sinks = args.in[4], *ev_w_out = args.in[5];
    const float *od_ln_g = args.in[6], *od_w_in = args.in[7], *od_v_g = args.in[8], *od_w_s = args.in[9], *od_b_s = args.in[10], *od_w_out = args.in[11], *rel_bias = args.in[12];
    float* out = args.out;
    bf16* XN = (bf16*)(ws + WS_XN); bf16* Z = (bf16*)(ws + WS_Z); bf16* VB = (bf16*)(ws + WS_Z + 64 * MiB); bf16* Y = (bf16*)(ws + WS_Y);
    float* ssx = (float*)(ws + WS_CTL) + CW_SSX; float* ssv = (float*)(ws + WS_CTL) + CW_SSV;

    for (int p = lo; p < hi; ++p) {
        int kind = PH_PRO, layer = 0;
        if (p > 0) { const int q = p - 1, pair = q / 7, r = q % 7; layer = 2 * pair + (r >= 4 ? 1 : 0); kind = 1 + r; }
        const int j = layer >> 1;
        int tid = threadIdx.x; asm volatile("" : "+v"(tid));
        const int lane = tid & 63, wave = __builtin_amdgcn_readfirstlane(tid >> 6);
        const float* lutg = (const float*)(ws + WS_LUT); const float* m0g = (const float*)(ws + WS_LUT + 512 * 1024) + j * 32;
        if (kind == PH_PRO) {
            Weights W{ev_w_in, ev_w_out, od_w_in, od_w_out, ev_ln_g, od_ln_g};
            ph_prologue(lds, wave, lane, vcu, G, W, ws, x_in);
            att::build_tables((float*)(ws + WS_LUT), (float*)(ws + WS_LUT + 512 * 1024), rel_bias, ev_qk_g, vcu * (NWAVES * 64) + tid, G * NWAVES * 64);
        } else if (kind == PH_G1A || kind == PH_G1B) {
            pg8::Gemm g{XN, (const bf16*)(ws + WS_EWIN + j * SZ_EWIN), MROWS, EV_IN, DMODEL};
            const int nwg = (MROWS / 256) * (EV_IN / 256), full = nwg / G, rem = nwg % G, c = (int)blockIdx.x;
            pg8::WindowOrder S; S.init(g.M, g.N, G, c); S.i0 = (kind == PH_G1A) ? 0 : full; S.n = (kind == PH_G1A) ? full : 1;
            if (kind == PH_G1A || c < rem) { pg8::EpiQKV E{Z, g.N, ev_qk_g + j * 256, ssx + layer * MROWS}; pg8::gemm_phase<pg8::EpiQKV, pg8::WindowOrder, true, true>(lds + RING_OFF, g, S, E, tid); }
            else att::attn_phase_a(Z, Y, ev_sinks + j * 16, lutg, m0g, lds + RING_OFF, c - rem, G - rem, tid);
        } else if (kind == PH_ATTB) {
            att::attn_phase_b(Z, Y, ev_sinks + j * 16, lutg, m0g, lds + RING_OFF, vcu, G, tid);
        } else if (kind == PH_G1O) {
            pg8::Gemm g{XN, (const bf16*)(ws + WS_OWIN + j * SZ_OWIN), MROWS, OD_IN, DMODEL};
            pg8::StaticOrder S; S.init(g.M, g.N, G, (int)blockIdx.x);
            pg8::EpiOdd E{Z, VB, ssx + layer * MROWS, ssv + j * MROWS}; pg8::gemm_phase<pg8::EpiOdd, pg8::StaticOrder, true, true>(lds + RING_OFF, g, S, E, tid);
        } else if (kind == PH_MIX) {
            mix::mix_phase(Z, VB, Y, ssv + j * MROWS, od_v_g + j * CWID, od_w_s + (size_t)j * 16 * 16384, od_b_s + j * 2048, lds + RING_OFF, vcu, G, tid);
        } else {
            const bool odd = (kind == PH_G2O);
            pg8::Gemm g{Y, odd ? (const bf16*)(ws + WS_OWOUT + j * SZ_OWOUT) : (const bf16*)(ws + WS_EWOUT + j * SZ_EWOUT), MROWS, DMODEL, odd ? CWID : DMODEL};
            pg8::StaticOrder S; S.init(g.M, g.N, G, (int)blockIdx.x);
            const int nl = layer + 1;
            pg8::EpiResB E{XN, (nl < 4) ? (float*)nullptr : out, ssx + (nl & 3) * MROWS, 0};
            pg8::gemm_phase<pg8::EpiResB, pg8::StaticOrder, true, true>(lds + RING_OFF, g, S, E, tid);
        }
        if (p + 1 < hi) xcd_barrier(bar);
    }
}

extern "C" void kernel_launch(void* const* d_in, const int* in_sizes, int n_in, void* d_out, int out_size, void* d_ws, size_t ws_size, hipStream_t stream) {
    static int grid = 0;
    if (grid == 0) {
        if (n_in != 13 || out_size != MROWS * DMODEL || ws_size < WS_END) { fprintf(stderr, "kernel_launch: unexpected shapes (n_in %d out %d ws %zu)\n", n_in, out_size, ws_size); grid = -1; return; }
        int dev = 0, cus = 0;
        if (hipGetDevice(&dev) != hipSuccess || hipDeviceGetAttribute(&cus, hipDeviceAttributeMultiprocessorCount, dev) != hipSuccess) { grid = -1; return; }
        if (hipFuncSetAttribute((const void*)skel_fwd, hipFuncAttributeMaxDynamicSharedMemorySize, LDS_BYTES) != hipSuccess) { fprintf(stderr, "kernel_launch: hipFuncSetAttribute failed\n"); grid = -1; return; }
        int per_cu = 0;
        (void)hipOccupancyMaxActiveBlocksPerMultiprocessor(&per_cu, (const void*)skel_fwd, NWAVES * 64, LDS_BYTES);
        (void)hipGetLastError();
        grid = cus;
    }
    if (grid < 0) return;
    (void)hipMemsetAsync((char*)d_ws + WS_CTL, 0, CTL_ZERO_BYTES, stream);
    Args a{};
    for (int i = 0; i < 13; ++i) a.in[i] = (const float*)d_in[i];
    a.out = (float*)d_out; a.ws = (unsigned char*)d_ws;
#if MK_ONE_LAUNCH
    a.ph_lo = 0; a.ph_hi = NPHASE;
    hipLaunchKernelGGL(skel_fwd, dim3(grid), dim3(NWAVES * 64), LDS_BYTES, stream, a);
#else
    for (int p = 0; p < NPHASE; ++p) { a.ph_lo = p; a.ph_hi = p + 1; hipLaunchKernelGGL(skel_fwd, dim3(grid), dim3(NWAVES * 64), LDS_BYTES, stream, a); }
#endif
}
```

```cpp
#include <hip/hip_runtime.h>
#include <cstdio>
#include <cstdint>
#define MK_ONE_LAUNCH 1
#define PROBE_CLK -1
#define PROBE_T0 0.f
#define PROBE_DT 1.f

namespace pg8 {
#define PG8_LAS __attribute__((address_space(3)))
typedef unsigned short bf16_t;
typedef short bf16x8 __attribute__((ext_vector_type(8)));
typedef float f32x4 __attribute__((ext_vector_type(4)));
typedef unsigned u32x4 __attribute__((ext_vector_type(4)));
constexpr int BM = 256, BK = 64, HALF = 128, HTB = HALF * BK * 2  , STAGE_BYTES = 8 * HTB, NXCD = 8, WGM = 8;

__host__ __device__ __forceinline__ int lds_byte(int r, int c) { const int st = (r >> 4) * 2 + (c >> 5), rr = r & 15, cc = c & 31, ob = rr * 64 + cc * 2; return st * 1024 + (ob ^ (((ob >> 9) & 1) << 5)); }
__host__ __device__ __forceinline__ void stage_rc(int b, int& R, int& C) { const int st = b / 1024, sb = b % 1024, swz = sb ^ (((sb >> 9) & 1) << 5); R = (st >> 1) * 16 + swz / 64; C = (st & 1) * 32 + (swz % 64) / 2; }
__host__ __device__ __forceinline__ int perm32(int rho) { const int n = rho >> 4, i = rho & 15; return 8 * (i >> 2) + 4 * n + (i & 3); }

struct Unit { int pm, pn; };
struct Gemm { const bf16_t* A; const bf16_t* Bt; int M, N, K; };

struct StaticOrder {
    int nM, nN, nwg, G, c;
    __host__ __device__ void init(int M, int N, int G_, int c_) { nM = M / BM; nN = N / BM; nwg = nM * nN; G = G_; c = c_; }
    __host__ __device__ bool next(int i, Unit& u) const {
        const long L = (long)i * G + c; if (L >= nwg) return false;
        int wgid = (int)L; { const int q = nwg / NXCD, r = nwg % NXCD, xcd = wgid % NXCD, off = wgid / NXCD; wgid = (xcd < r ? xcd * (q + 1) : r * (q + 1) + (xcd - r) * q) + off; }
        const int nig = WGM * nN, gid = wgid / nig, fm = gid * WGM, gsz = (nM - fm) < WGM ? (nM - fm) : WGM;
        u.pm = fm + ((wgid % nig) % gsz); u.pn = (wgid % nig) / gsz; return true;
    }
    __device__ __forceinline__ void a_ready(const Unit&) const {}
    __device__ __forceinline__ void done(const Unit&) const {}
};

struct WindowOrder : StaticOrder { int i0, n;
    __device__ __forceinline__ bool next(int i, Unit& u) const { if (i >= n) return false; return StaticOrder::next(i + i0, u); } };

__device__ __forceinline__ unsigned cvt_pk_bf16(float lo, float hi) { unsigned r; asm volatile("v_cvt_pk_bf16_f32 %0, %1, %2" : "=v"(r) : "v"(lo), "v"(hi)); return r; }
typedef float f32x2 __attribute__((ext_vector_type(2)));
__device__ __forceinline__ f32x2 gelu_pk(f32x2 v) {
    const f32x2 av = __builtin_elementwise_abs(v), d = av * 0.2316418882f + 1.0f;
    f32x2 t; t.x = __builtin_amdgcn_rcpf(d.x); t.y = __builtin_amdgcn_rcpf(d.y);
    f32x2 q = t * 0.5307027145f + (-0.7265760135f); q = q * t + 0.7107068705f; q = q * t + (-0.142248368f); q = q * t + 0.127414796f; q = q * t;
    const f32x2 s = (v * v) * (-0.72134752044f);
    f32x2 e; e.x = __builtin_amdgcn_exp2f(s.x); e.y = __builtin_amdgcn_exp2f(s.y);
    const f32x2 m = v * (q * e), r = v - m;
    f32x2 o; o.x = v.x < 0.f ? m.x : r.x; o.y = v.y < 0.f ? m.y : r.y; return o;
}


__device__ __forceinline__ void st16_wt(void* p, u32x4 v) { asm volatile("global_store_dwordx4 %0, %1, off sc1\n\ts_nop 1" :: "v"(p), "v"(v) : "memory"); }

__device__ __forceinline__ float silu_f(float x) { return x * __builtin_amdgcn_rcpf(1.0f + __builtin_amdgcn_exp2f(-1.4426950408889634f * x)); }
struct EpiAct {
    static constexpr bool PERM = true, AFTER_DRAIN = false;
    bf16_t* O; int ldc; int gelu_below; int silu_from;
    __device__ __forceinline__ void operator()(const f32x4 (&acc)[2][2][4][2], const Unit& u, int wr, int wc, int fr, int fq) const {
        const int row0 = u.pm * BM + wr * 64 + fr, col0 = u.pn * BM + wc * 32 + 8 * fq;
        const int mode = (u.pn < gelu_below) ? 1 : ((u.pn >= silu_from) ? 2 : 0);
#pragma unroll
        for (int ai = 0; ai < 2; ++ai)
#pragma unroll
            for (int m = 0; m < 4; ++m) { bf16_t* rowp = O + (size_t)(row0 + ai * HALF + m * 16) * ldc + col0;
#pragma unroll
                for (int bj = 0; bj < 2; ++bj) { f32x4 v0 = acc[ai][bj][m][0], v1 = acc[ai][bj][m][1];
                    if (mode == 1) { f32x2 a = gelu_pk((f32x2){v0[0], v0[1]}), b = gelu_pk((f32x2){v0[2], v0[3]}), c = gelu_pk((f32x2){v1[0], v1[1]}), d = gelu_pk((f32x2){v1[2], v1[3]});
                        v0 = (f32x4){a.x, a.y, b.x, b.y}; v1 = (f32x4){c.x, c.y, d.x, d.y}; }
                    else if (mode == 2) { v0 = (f32x4){silu_f(v0[0]), silu_f(v0[1]), silu_f(v0[2]), silu_f(v0[3])}; v1 = (f32x4){silu_f(v1[0]), silu_f(v1[1]), silu_f(v1[2]), silu_f(v1[3])}; }
                    u32x4 w; w.x = cvt_pk_bf16(v0[0], v0[1]); w.y = cvt_pk_bf16(v0[2], v0[3]); w.z = cvt_pk_bf16(v1[0], v1[1]); w.w = cvt_pk_bf16(v1[2], v1[3]);
                    *(u32x4*)(rowp + bj * HALF) = w; } }
    }
};
struct EpiRes {
    static constexpr bool PERM = false, AFTER_DRAIN = false;
    const float* base; float* out; int ldc;
    __device__ __forceinline__ void operator()(const f32x4 (&acc)[2][2][4][2], const Unit& u, int wr, int wc, int fr, int fq) const {
        const int row0 = u.pm * BM + wr * 64 + fr, col0 = u.pn * BM + wc * 32 + 4 * fq;
#pragma unroll
        for (int ai = 0; ai < 2; ++ai)
#pragma unroll
            for (int m = 0; m < 4; ++m) { const size_t off = (size_t)(row0 + ai * HALF + m * 16) * ldc + col0;
#pragma unroll
                for (int bj = 0; bj < 2; ++bj)
#pragma unroll
                    for (int n = 0; n < 2; ++n) { const f32x4 bs = *(const f32x4*)(base + off + bj * HALF + n * 16); *(f32x4*)(out + off + bj * HALF + n * 16) = bs + acc[ai][bj][m][n]; } }
    }
};

struct EpiQKV {
    static constexpr bool PERM = true, AFTER_DRAIN = false;
    bf16_t* O; int ldc; const float* qkg; const float* ssx;
    __device__ __forceinline__ void operator()(const f32x4 (&acc)[2][2][4][2], const Unit& u, int wr, int wc, int fr, int fq) const {
        const int row0 = u.pm * BM + wr * 64 + fr, colw = u.pn * BM + wc * 64;
        int mode = 0; const float* gv = qkg; float sc = 1.f;
        if (colw < 1024) { mode = 1; gv = qkg; sc = 0.125f * 1.4426950408889634f; }
        else if (colw < 1152) { mode = 1; gv = qkg + 64; }
        else if (colw < 1280) { mode = 0; }
        else if (colw < 2304) { mode = 2; }
        else if (colw < 3328) { mode = 1; gv = qkg + 128; sc = 0.125f * 1.4426950408889634f; }
        else if (colw < 4352) { mode = 1; gv = qkg + 192; }
        else if (colw < 5376) { mode = 0; }
        else { mode = 2; }
        f32x4 gg[2][2];
#pragma unroll
        for (int bj = 0; bj < 2; ++bj)
#pragma unroll
            for (int n = 0; n < 2; ++n) gg[bj][n] = (mode == 1) ? *(const f32x4*)(gv + 32 * bj + 8 * fq + 4 * n) * sc : (f32x4){1.f, 1.f, 1.f, 1.f};
#pragma unroll
        for (int ai = 0; ai < 2; ++ai)
#pragma unroll
            for (int m = 0; m < 4; ++m) { bf16_t* rowp = O + (size_t)(row0 + ai * HALF + m * 16) * ldc + colw + 8 * fq;
                f32x4 v[2][2];
                const float rx = __builtin_amdgcn_rsqf(ssx[row0 + ai * HALF + m * 16] * (1.f / 2048.f) + 1e-6f);
#pragma unroll
                for (int bj = 0; bj < 2; ++bj)
#pragma unroll
                    for (int n = 0; n < 2; ++n) v[bj][n] = acc[ai][bj][m][n] * rx;
                if (mode == 1) { float ss = 0.f;
#pragma unroll
                    for (int bj = 0; bj < 2; ++bj)
#pragma unroll
                        for (int n = 0; n < 2; ++n) ss += (v[bj][n][0] * v[bj][n][0] + v[bj][n][1] * v[bj][n][1]) + (v[bj][n][2] * v[bj][n][2] + v[bj][n][3] * v[bj][n][3]);
                    ss += __shfl_xor(ss, 16); ss += __shfl_xor(ss, 32);
                    const float r = __builtin_amdgcn_rsqf(ss * (1.f / 64.f) + 1e-6f);
#pragma unroll
                    for (int bj = 0; bj < 2; ++bj)
#pragma unroll
                        for (int n = 0; n < 2; ++n) v[bj][n] = v[bj][n] * r * gg[bj][n]; }
                else if (mode == 2) {
#pragma unroll
                    for (int bj = 0; bj < 2; ++bj)
#pragma unroll
                        for (int n = 0; n < 2; ++n) v[bj][n] = (f32x4){silu_f(v[bj][n][0]), silu_f(v[bj][n][1]), silu_f(v[bj][n][2]), silu_f(v[bj][n][3])}; }
#pragma unroll
                for (int bj = 0; bj < 2; ++bj) { u32x4 w; w.x = cvt_pk_bf16(v[bj][0][0], v[bj][0][1]); w.y = cvt_pk_bf16(v[bj][0][2], v[bj][0][3]); w.z = cvt_pk_bf16(v[bj][1][0], v[bj][1][1]); w.w = cvt_pk_bf16(v[bj][1][2], v[bj][1][3]);
                    *(u32x4*)(rowp + 32 * bj) = w; } }
    }
};

struct EpiOdd {
    static constexpr bool PERM = true, AFTER_DRAIN = false;
    bf16_t* UG; bf16_t* V; const float* ssx; float* ssv;
    __device__ __forceinline__ void operator()(const f32x4 (&acc)[2][2][4][2], const Unit& u, int wr, int wc, int fr, int fq) const {
        const int row0 = u.pm * BM + wr * 64 + fr;
        if (u.pn < 32) {
#pragma unroll
            for (int ai = 0; ai < 2; ++ai)
#pragma unroll
                for (int m = 0; m < 4; ++m) { const int row = row0 + ai * HALF + m * 16;
                    const float rx = __builtin_amdgcn_rsqf(ssx[row] * (1.f / 2048.f) + 1e-6f);
                    f32x4 o[2];
#pragma unroll
                    for (int n = 0; n < 2; ++n) { const f32x4 uu = acc[ai][0][m][n] * rx, gt = acc[ai][1][m][n] * rx;
                        const f32x2 a = gelu_pk((f32x2){uu[0], uu[1]}), b = gelu_pk((f32x2){uu[2], uu[3]});
                        o[n] = (f32x4){a.x * silu_f(gt[0]), a.y * silu_f(gt[1]), b.x * silu_f(gt[2]), b.y * silu_f(gt[3])}; }
                    u32x4 w; w.x = cvt_pk_bf16(o[0][0], o[0][1]); w.y = cvt_pk_bf16(o[0][2], o[0][3]); w.z = cvt_pk_bf16(o[1][0], o[1][1]); w.w = cvt_pk_bf16(o[1][2], o[1][3]);
                    *(u32x4*)(UG + (size_t)row * 4096 + u.pn * 128 + wc * 32 + 8 * fq) = w; }
        } else {
            const int colb = (u.pn - 32) * 256 + wc * 32 + 8 * fq;
#pragma unroll
            for (int ai = 0; ai < 2; ++ai)
#pragma unroll
                for (int m = 0; m < 4; ++m) { const int row = row0 + ai * HALF + m * 16;
                    const float rx = __builtin_amdgcn_rsqf(ssx[row] * (1.f / 2048.f) + 1e-6f);
                    float ss = 0.f;
#pragma unroll
                    for (int bj = 0; bj < 2; ++bj) { const f32x4 v0 = acc[ai][bj][m][0] * rx, v1 = acc[ai][bj][m][1] * rx;
                        const f32x2 a = gelu_pk((f32x2){v0[0], v0[1]}), b = gelu_pk((f32x2){v0[2], v0[3]}), c = gelu_pk((f32x2){v1[0], v1[1]}), d = gelu_pk((f32x2){v1[2], v1[3]});
                        ss += (a.x * a.x + a.y * a.y) + (b.x * b.x + b.y * b.y) + (c.x * c.x + c.y * c.y) + (d.x * d.x + d.y * d.y);
                        u32x4 w; w.x = cvt_pk_bf16(a.x, a.y); w.y = cvt_pk_bf16(b.x, b.y); w.z = cvt_pk_bf16(c.x, c.y); w.w = cvt_pk_bf16(d.x, d.y);
                        *(u32x4*)(V + (size_t)row * 4096 + colb + bj * HALF) = w; }
                    ss += __shfl_xor(ss, 16); ss += __shfl_xor(ss, 32);
                    if (fq == 0) atomicAdd(ssv + row, ss); }
        }
    }
};
struct EpiResN {
    static constexpr bool PERM = false, AFTER_DRAIN = false;
    const float* base; float* out; int ldc; bf16_t* xn; const float* gn; float* ssn;
    __device__ __forceinline__ void operator()(const f32x4 (&acc)[2][2][4][2], const Unit& u, int wr, int wc, int fr, int fq) const {
        typedef unsigned u32x2v __attribute__((ext_vector_type(2)));
        const int row0 = u.pm * BM + wr * 64 + fr, col0 = u.pn * BM + wc * 32 + 4 * fq;
        f32x4 gg[2][2];
#pragma unroll
        for (int bj = 0; bj < 2; ++bj)
#pragma unroll
            for (int n = 0; n < 2; ++n) gg[bj][n] = xn ? *(const f32x4*)(gn + col0 + bj * HALF + n * 16) : (f32x4){0.f, 0.f, 0.f, 0.f};
#pragma unroll
        for (int ai = 0; ai < 2; ++ai)
#pragma unroll
            for (int m = 0; m < 4; ++m) { const int row = row0 + ai * HALF + m * 16; const size_t off = (size_t)row * ldc + col0; float ss = 0.f;
#pragma unroll
                for (int bj = 0; bj < 2; ++bj)
#pragma unroll
                    for (int n = 0; n < 2; ++n) { const f32x4 o = *(const f32x4*)(base + off + bj * HALF + n * 16) + acc[ai][bj][m][n]; *(f32x4*)(out + off + bj * HALF + n * 16) = o;
                        if (xn) { ss += (o[0] * o[0] + o[1] * o[1]) + (o[2] * o[2] + o[3] * o[3]); const f32x4 t = o * gg[bj][n];
                            u32x2v w; w.x = cvt_pk_bf16(t[0], t[1]); w.y = cvt_pk_bf16(t[2], t[3]); *(u32x2v*)(xn + off + bj * HALF + n * 16) = w; } }
                if (xn) { ss += __shfl_xor(ss, 16); ss += __shfl_xor(ss, 32); if (fq == 0) atomicAdd(ssn + row, ss); } }
    }
};

struct EpiResB {
    static constexpr bool PERM = true, AFTER_DRAIN = false;
    bf16_t* xb; float* outf; float* ssn; int nowrite;
    __device__ __forceinline__ void operator()(const f32x4 (&acc)[2][2][4][2], const Unit& u, int wr, int wc, int fr, int fq) const {
        const int row0 = u.pm * BM + wr * 64 + fr, col0 = u.pn * BM + wc * 32 + 8 * fq;
#pragma unroll
        for (int ai = 0; ai < 2; ++ai)
#pragma unroll
            for (int m = 0; m < 4; ++m) { const int row = row0 + ai * HALF + m * 16; const size_t off = (size_t)row * 2048 + col0; float ss = 0.f;
#pragma unroll
                for (int bj = 0; bj < 2; ++bj) { const u32x4 b = *(const u32x4*)(xb + off + bj * HALF);
                    f32x4 o0 = acc[ai][bj][m][0], o1 = acc[ai][bj][m][1];
                    o0[0] += __uint_as_float(b.x << 16); o0[1] += __uint_as_float(b.x & 0xffff0000u); o0[2] += __uint_as_float(b.y << 16); o0[3] += __uint_as_float(b.y & 0xffff0000u);
                    o1[0] += __uint_as_float(b.z << 16); o1[1] += __uint_as_float(b.z & 0xffff0000u); o1[2] += __uint_as_float(b.w << 16); o1[3] += __uint_as_float(b.w & 0xffff0000u);
                    if (outf) { *(f32x4*)(outf + off + bj * HALF) = o0; *(f32x4*)(outf + off + bj * HALF + 4) = o1; }
                    else { ss += (o0[0] * o0[0] + o0[1] * o0[1]) + (o0[2] * o0[2] + o0[3] * o0[3]) + (o1[0] * o1[0] + o1[1] * o1[1]) + (o1[2] * o1[2] + o1[3] * o1[3]);
                        u32x4 w; w.x = cvt_pk_bf16(o0[0], o0[1]); w.y = cvt_pk_bf16(o0[2], o0[3]); w.z = cvt_pk_bf16(o1[0], o1[1]); w.w = cvt_pk_bf16(o1[2], o1[3]);
                        if (!nowrite) *(u32x4*)(xb + off + bj * HALF) = w; } }
                if (!outf) { ss += __shfl_xor(ss, 16); ss += __shfl_xor(ss, 32); if (fq == 0) atomicAdd(ssn + row, ss); } }
    }
};

template <class Epi, class Sched, bool ALIGN_EPI = false, bool SP2 = false>
__device__ __forceinline__ void gemm_phase(PG8_LAS unsigned char* lds, const Gemm g, const Sched& S, const Epi& E, const int tid) {
    const int wid = __builtin_amdgcn_readfirstlane(tid >> 6), lane = tid & 63, wr = wid >> 2, wc = wid & 3, fr = lane & 15, fq = lane >> 4;
    const int K = g.K, nt = K / BK;
    unsigned voffA[2], voffB[2];
#pragma unroll
    for (int i = 0; i < 2; ++i) { int R, C; stage_rc(tid * 16 + i * 8192, R, C); const int Rb = Epi::PERM ? ((R & ~31) + perm32(R & 31)) : R;
        voffA[i] = (unsigned)(R * K + C) * 2u; voffB[i] = (unsigned)(Rb * K + C) * 2u; }
    const size_t kstep = (size_t)(BK * 2);
    const size_t hstep = (size_t)HALF * K * 2;
    const size_t tstep = 2 * hstep;
    const unsigned ldsw = (unsigned)wid * 1024u;
    const int aoff = lds_byte(wr * 64 + fr, fq * 8), boff = lds_byte(wc * 32 + fr, fq * 8);
#define PG8_SA(b, h) (((b) * 2 + (h)) * HTB)
#define PG8_SB(b, h) ((4 + (b) * 2 + (h)) * HTB)
#define PG8_STAGE(bufoff, gbase, voff) do { _Pragma("unroll") for (int _i = 0; _i < 2; ++_i) \
        __builtin_amdgcn_global_load_lds((const unsigned*)((const char*)(gbase) + (voff)[_i]), (PG8_LAS unsigned*)(lds + (bufoff) + ldsw + _i * 8192), 16, 0, 0); } while (0)
#define PG8_LDA(dst, b, h) do { _Pragma("unroll") for (int m = 0; m < 4; ++m) _Pragma("unroll") for (int k = 0; k < 2; ++k) dst[m][k] = *(const PG8_LAS bf16x8*)(lds + PG8_SA(b, h) + aoff + m * 2048 + k * 1024); } while (0)
#define PG8_LDB(dst, b, h) do { _Pragma("unroll") for (int n = 0; n < 2; ++n) _Pragma("unroll") for (int k = 0; k < 2; ++k) dst[n][k] = *(const PG8_LAS bf16x8*)(lds + PG8_SB(b, h) + boff + n * 2048 + k * 1024); } while (0)
#define PG8_MMA(ai, bj, At, Bt) do { __builtin_amdgcn_s_setprio(1); _Pragma("unroll") for (int m = 0; m < 4; ++m) _Pragma("unroll") for (int n = 0; n < 2; ++n) _Pragma("unroll") for (int k = 0; k < 2; ++k) \
        acc[ai][bj][m][n] = __builtin_amdgcn_mfma_f32_16x16x32_bf16(Bt[n][k], At[m][k], acc[ai][bj][m][n], 0, 0, 0); __builtin_amdgcn_s_setprio(0); } while (0)
#define PG8_WAIT_V(n) asm volatile("s_waitcnt vmcnt(" #n ")" ::: "memory")
#define PG8_WAIT_L(n) asm volatile("s_waitcnt lgkmcnt(" #n ")" ::: "memory")
#define PG8_BAR __builtin_amdgcn_s_barrier()
#define PG8_SCHED __builtin_amdgcn_sched_barrier(0)
    Unit cur, nxt; int ui = 0;
    if (!S.next(0, cur)) return;
    f32x4 acc[2][2][4][2];
#pragma unroll
    for (int a = 0; a < 2; ++a)
#pragma unroll
        for (int b = 0; b < 2; ++b)
#pragma unroll
            for (int m = 0; m < 4; ++m)
#pragma unroll
                for (int n = 0; n < 2; ++n) acc[a][b][m][n] = (f32x4){0.f, 0.f, 0.f, 0.f};
    bf16x8 At[4][2], B0[2][2], B1[2][2];
    const char* cA = (const char*)g.A + (size_t)cur.pm * tstep; const char* cB = (const char*)g.Bt + (size_t)cur.pn * tstep;
    S.a_ready(cur);
    if constexpr (SP2) {
        PG8_STAGE(PG8_SB(0, 0), cB, voffB); PG8_STAGE(PG8_SB(0, 1), cB + hstep, voffB); PG8_STAGE(PG8_SA(0, 0), cA, voffA); PG8_STAGE(PG8_SA(0, 1), cA + hstep, voffA);
        if (wr == 1) PG8_BAR;
        PG8_WAIT_V(2); PG8_BAR;
        PG8_STAGE(PG8_SB(1, 0), cB + kstep, voffB); PG8_STAGE(PG8_SA(1, 0), cA + kstep, voffA); PG8_STAGE(PG8_SB(1, 1), cB + hstep + kstep, voffB);
        PG8_WAIT_V(6); PG8_BAR;
    } else {
        PG8_STAGE(PG8_SB(0, 0), cB, voffB); PG8_STAGE(PG8_SA(0, 0), cA, voffA); PG8_STAGE(PG8_SB(0, 1), cB + hstep, voffB); PG8_STAGE(PG8_SA(0, 1), cA + hstep, voffA);
        if (wr == 1) PG8_BAR;
        PG8_WAIT_V(4); PG8_BAR;
        PG8_STAGE(PG8_SB(1, 0), cB + kstep, voffB); PG8_STAGE(PG8_SA(1, 0), cA + kstep, voffA); PG8_STAGE(PG8_SB(1, 1), cB + hstep + kstep, voffB);
        PG8_WAIT_V(6); PG8_BAR;
    }
    for (;;) {
        const bool has_next = S.next(ui + 1, nxt);
        const char* nA = has_next ? (const char*)g.A + (size_t)nxt.pm * tstep : cA; const char* nB = has_next ? (const char*)g.Bt + (size_t)nxt.pn * tstep : cB;
        for (int t = 0; t < nt; t += 2) {
            const bool last = (t == nt - 2);
            const char* a1 = cA + (size_t)(t + 1) * kstep;
            const char* a2 = last ? nA : cA + (size_t)(t + 2) * kstep; const char* b2 = last ? nB : cB + (size_t)(t + 2) * kstep;
            const char* a3 = a2 + kstep; const char* b3 = b2 + kstep;
            if (last && has_next) S.a_ready(nxt);
            if constexpr (SP2) {
            PG8_LDB(B0, 0, 0); PG8_LDB(B1, 0, 1); PG8_SCHED; PG8_LDA(At, 0, 0); PG8_STAGE(PG8_SA(1, 1), a1 + hstep, voffA);
            PG8_WAIT_V(8); PG8_WAIT_L(0); PG8_BAR; PG8_MMA(0, 0, At, B0); PG8_MMA(0, 1, At, B1); PG8_BAR; PG8_SCHED;
            PG8_LDA(At, 0, 1); PG8_STAGE(PG8_SB(0, 0), b2, voffB); PG8_STAGE(PG8_SB(0, 1), b2 + hstep, voffB); PG8_STAGE(PG8_SA(0, 0), a2, voffA);
            PG8_WAIT_V(8); PG8_WAIT_L(0); PG8_BAR; PG8_MMA(1, 0, At, B0); PG8_MMA(1, 1, At, B1); PG8_BAR; PG8_SCHED;
            PG8_LDB(B0, 1, 0); PG8_LDB(B1, 1, 1); PG8_SCHED; PG8_LDA(At, 1, 0); PG8_STAGE(PG8_SA(0, 1), a2 + hstep, voffA);
            PG8_WAIT_V(8); PG8_WAIT_L(0); PG8_BAR; PG8_MMA(0, 0, At, B0); PG8_MMA(0, 1, At, B1); PG8_BAR; PG8_SCHED;
            PG8_LDA(At, 1, 1); PG8_STAGE(PG8_SB(1, 0), b3, voffB); PG8_STAGE(PG8_SB(1, 1), b3 + hstep, voffB); PG8_STAGE(PG8_SA(1, 0), a3, voffA);
            PG8_WAIT_V(8); PG8_WAIT_L(0); PG8_BAR; PG8_MMA(1, 0, At, B0); PG8_MMA(1, 1, At, B1); PG8_BAR; PG8_SCHED;
            } else {
            PG8_LDB(B0, 0, 0); PG8_SCHED; PG8_LDA(At, 0, 0); PG8_STAGE(PG8_SA(1, 1), a1 + hstep, voffA);
            PG8_WAIT_L(8); PG8_BAR; PG8_WAIT_L(0); PG8_MMA(0, 0, At, B0); PG8_BAR; PG8_SCHED;
            PG8_LDB(B1, 0, 1); PG8_STAGE(PG8_SB(0, 0), b2, voffB);
            PG8_BAR; PG8_WAIT_L(0); PG8_MMA(0, 1, At, B1); PG8_BAR;
            PG8_LDA(At, 0, 1); PG8_STAGE(PG8_SA(0, 0), a2, voffA);
            PG8_BAR; PG8_WAIT_L(0); PG8_MMA(1, 0, At, B0); PG8_BAR; PG8_SCHED;
            PG8_STAGE(PG8_SB(0, 1), b2 + hstep, voffB);
            PG8_WAIT_V(6); PG8_BAR; PG8_MMA(1, 1, At, B1); PG8_BAR;
            PG8_LDB(B0, 1, 0); PG8_SCHED; PG8_LDA(At, 1, 0); PG8_STAGE(PG8_SA(0, 1), a2 + hstep, voffA);
            PG8_WAIT_L(8); PG8_BAR; PG8_WAIT_L(0); PG8_MMA(0, 0, At, B0); PG8_BAR; PG8_SCHED;
            PG8_LDB(B1, 1, 1); PG8_STAGE(PG8_SB(1, 0), b3, voffB);
            PG8_BAR; PG8_WAIT_L(0); PG8_MMA(0, 1, At, B1); PG8_BAR;
            PG8_LDA(At, 1, 1); PG8_STAGE(PG8_SA(1, 0), a3, voffA);
            PG8_BAR; PG8_WAIT_L(0); PG8_MMA(1, 0, At, B0); PG8_BAR; PG8_SCHED;
            PG8_STAGE(PG8_SB(1, 1), b3 + hstep, voffB);
            PG8_WAIT_V(6); PG8_BAR; PG8_MMA(1, 1, At, B1); PG8_BAR;
            }
        }
        if constexpr (ALIGN_EPI) { if (wr == 0) PG8_BAR; }
        if constexpr (!Epi::AFTER_DRAIN) { E(acc, cur, wr, wc, fr, fq); S.done(cur); }
        if (!has_next) break;
#pragma unroll
        for (int a = 0; a < 2; ++a)
#pragma unroll
            for (int b = 0; b < 2; ++b)
#pragma unroll
                for (int m = 0; m < 4; ++m)
#pragma unroll
                    for (int n = 0; n < 2; ++n) acc[a][b][m][n] = (f32x4){0.f, 0.f, 0.f, 0.f};
        cur = nxt; cA = nA; cB = nB; ++ui;
        if constexpr (ALIGN_EPI) { if (wr == 1) PG8_BAR; }
    }
    PG8_WAIT_V(0);
    if constexpr (!ALIGN_EPI) { if (wr == 0) PG8_BAR; }
    PG8_BAR;
    if constexpr (Epi::AFTER_DRAIN) { E.fused(acc, cur, wr, wc, fr, fq, lds, wid, lane); S.done(cur); }
#undef PG8_SA
#undef PG8_SB
#undef PG8_STAGE
#undef PG8_LDA
#undef PG8_LDB
#undef PG8_MMA
#undef PG8_WAIT_V
#undef PG8_WAIT_L
#undef PG8_BAR
#undef PG8_SCHED
}
}


#define GAS __attribute__((address_space(1)))
#define LAS __attribute__((address_space(3)))
typedef unsigned short bf16;
typedef unsigned v4u __attribute__((ext_vector_type(4)));
typedef float f32x4 __attribute__((ext_vector_type(4)));
typedef short bf16x8 __attribute__((ext_vector_type(8)));
typedef GAS unsigned gu32;
typedef GAS unsigned long long gu64;
#define RLX_AGENT __ATOMIC_RELAXED, __HIP_MEMORY_SCOPE_AGENT
#define LDS_WAIT() asm volatile("s_waitcnt lgkmcnt(0)" ::: "memory")
#define VM_WAIT() asm volatile("s_waitcnt vmcnt(0)" ::: "memory")
__device__ __forceinline__ unsigned long long rt() { return __builtin_amdgcn_s_memrealtime(); }
__device__ __forceinline__ unsigned f2bf(float f) { unsigned u = __builtin_bit_cast(unsigned, f); return (u + 0x7fffu + ((u >> 16) & 1u)) >> 16; }
__device__ __forceinline__ unsigned pk2(float lo, float hi) { return f2bf(lo) | (f2bf(hi) << 16); }

#define XB_TMO      128
#define XB_XCNT(j)  (256  + 64 * (j))
#define XB_XSUB(j)  (1280 + 64 * (j))
#define XB_XGEN(j)  (2304 + 64 * (j))
#define XB_TOP      3328
#define XB_TOPGEN   3392
#define XCD_BAR_WORDS 3456
#define XB_SPIN_CAP (1u << 18)

__device__ __forceinline__ unsigned xb_ld(unsigned* p)              { return __hip_atomic_load(p, __ATOMIC_RELAXED, __HIP_MEMORY_SCOPE_AGENT); }
__device__ __forceinline__ unsigned xb_add(unsigned* p, unsigned v) { return __hip_atomic_fetch_add(p, v, __ATOMIC_RELAXED, __HIP_MEMORY_SCOPE_AGENT); }
__device__ __forceinline__ unsigned xb_xcc_id() { return (unsigned)__builtin_amdgcn_s_getreg((3 << 11) | 20) & 0xFu; }
#define XB_SPIN(cond, bar) do { unsigned _sp = 0; while (cond) { __builtin_amdgcn_s_sleep(1); \
    if ((++_sp & 255u) == 0u) { if (xb_ld(&(bar)[XB_TMO])) break; if (_sp > XB_SPIN_CAP) { atomicAdd(&(bar)[XB_TMO], 1u); break; } } } } while (0)

struct XcdBarrier {
    unsigned* bar; unsigned x;
    volatile LAS unsigned* st;
};

__device__ __forceinline__ XcdBarrier xcd_barrier_post(unsigned* bar, volatile LAS unsigned* st) {
    XcdBarrier b; b.bar = bar; b.x = xb_xcc_id(); b.st = st;
    if (threadIdx.x == 0) (void)xb_add(&bar[XB_XCNT(b.x)], 1u);
    return b;
}
__device__ __forceinline__ void xcd_barrier_complete(unsigned* bar, unsigned x, unsigned& nloc, unsigned& nx) {
    const unsigned G = gridDim.x * gridDim.y * gridDim.z;
    unsigned sum, cnt, mine, sp = 0u;
    for (;;) {
        sum = 0u; cnt = 0u; mine = 0u;
#pragma unroll
        for (unsigned j = 0; j < 16; ++j) { const unsigned c = xb_ld(&bar[XB_XCNT(j)]); sum += c; cnt += (c > 0u) ? 1u : 0u; mine = (j == x) ? c : mine; }
        if (sum == G) break;
        __builtin_amdgcn_s_sleep(1);
        if ((++sp & 255u) == 0u) { if (xb_ld(&bar[XB_TMO])) break; if (sp > XB_SPIN_CAP) { atomicAdd(&bar[XB_TMO], 1u); break; } }
    }
    nloc = mine > 0u ? mine : 1u; nx = cnt > 0u ? cnt : 1u;
}

__device__ __forceinline__ void xcd_barrier(const XcdBarrier& b) {
    asm volatile("s_waitcnt vmcnt(0)" ::: "memory");
    __syncthreads();
    if (threadIdx.x == 0) {
        unsigned* bar = b.bar;
        __builtin_amdgcn_s_waitcnt(0);
        unsigned nloc = b.st[0], nx = b.st[1];
        if (nloc == 0u) { xcd_barrier_complete(bar, b.x, nloc, nx); b.st[0] = nloc; b.st[1] = nx; }
        const unsigned old = xb_add(&bar[XB_XSUB(b.x)], 1u);
        const unsigned gen = old / nloc;
        if (old + 1u == (gen + 1u) * nloc) {
            __builtin_amdgcn_fence(__ATOMIC_RELEASE, "agent");
            asm volatile("s_waitcnt vmcnt(0)" ::: "memory");
            const unsigned og = xb_add(&bar[XB_TOP], 1u);
            const unsigned tg = og / nx;
            if (og + 1u == (tg + 1u) * nx) xb_add(&bar[XB_TOPGEN], 1u);
            else XB_SPIN(xb_ld(&bar[XB_TOPGEN]) == tg, bar);
            __builtin_amdgcn_fence(__ATOMIC_ACQUIRE, "agent");
            xb_add(&bar[XB_XGEN(b.x)], 1u);
            asm volatile("s_waitcnt vmcnt(0)" ::: "memory");
        } else {
            XB_SPIN(xb_ld(&bar[XB_XGEN(b.x)]) == gen, bar);
            __builtin_amdgcn_fence(__ATOMIC_ACQUIRE, "agent");
            asm volatile("s_waitcnt vmcnt(0)" ::: "memory");
        }
    }
    __syncthreads();
}

constexpr int NWAVES = 8;
#ifndef MK_ONE_LAUNCH
#define MK_ONE_LAUNCH 1
#endif
constexpr int SEQ = 2048, DMODEL = 2048, MROWS = 8192;
constexpr int EV_IN = 6400, OD_IN = 12288, CWID = 4096;
constexpr float EPS = 1e-6f;
constexpr size_t MiB = 1u << 20;
constexpr size_t WS_CTL = 0, CTL_ZERO_BYTES = 1 * MiB;
constexpr size_t WS_EWIN = 2 * MiB, SZ_EWIN = 25 * MiB;
constexpr size_t WS_EWOUT = 52 * MiB, SZ_EWOUT = 8 * MiB;
constexpr size_t WS_OWIN = 68 * MiB, SZ_OWIN = 48 * MiB;
constexpr size_t WS_OWOUT = 164 * MiB, SZ_OWOUT = 16 * MiB;
constexpr size_t WS_XN = 196 * MiB;
constexpr size_t WS_Z = 228 * MiB;
constexpr size_t WS_Y = 420 * MiB;
constexpr size_t WS_LUT = 484 * MiB;
constexpr size_t WS_END = 486 * MiB;
constexpr int CW_BAR = 4096;
constexpr int CW_SSX = 16384;
constexpr int CW_SSV = 49152;
static_assert((CW_SSV + 2 * 8192) * 4 <= (int)CTL_ZERO_BYTES, "CTL map");
constexpr int RING_OFF = 0, RING_BYTES = 131072;
constexpr int LDSCTL_OFF = RING_BYTES, MISC_OFF = LDSCTL_OFF + 320;
constexpr int LDS_BYTES = 147456;
constexpr int NPHASE = 15;
enum { PH_PRO = 0, PH_G1A, PH_G1B, PH_ATTB, PH_G2E, PH_G1O, PH_MIX, PH_G2O };

__device__ __forceinline__ float bf2f(unsigned short u) { return __uint_as_float((unsigned)u << 16); }
__device__ __forceinline__ float wave_sum(float v) {
#pragma unroll
    for (int o = 1; o < 64; o <<= 1) v += __shfl_xor(v, o);
    return v;
}
__device__ __forceinline__ int t5_bucket(int n) {
    if (n < 16) return n;
    return 16 + (n >= 22) + (n >= 30) + (n >= 40) + (n >= 54) + (n >= 73) + (n >= 99) + (n >= 134) + (n >= 182) + (n >= 246) + (n >= 332) + (n >= 450) + (n >= 609) + (n >= 825) + (n >= 1117) + (n >= 1513);
}

__device__ __forceinline__ void p0_transpose_item(const float* W, int K, int N, bf16* WT, LAS float* scr, int item, int lane, const int permkind, const float* gk = nullptr) {
    const int nblk = N / 32, kb = item / nblk, nb = item % nblk, k0 = 64 * kb, n0 = 32 * nb;
    int r0 = n0;
    if (permkind == 1) r0 = (n0 & ~255) + 128 * ((n0 >> 5) & 1) + 32 * ((n0 >> 6) & 3);
    else if (permkind == 2) r0 = (n0 < 4096) ? (256 * (n0 >> 7) + (n0 & 127))
                               : (n0 < 8192) ? (8192 + (n0 - 4096))
                               : (256 * ((n0 - 8192) >> 7) + 128 + ((n0 - 8192) & 127));
    { const int q4 = (lane & 7) * 4, rr = lane >> 3; const float* wp = W + (size_t)(k0 + rr) * N + n0 + q4; f32x4 v[8];
#pragma unroll
        for (int i = 0; i < 8; ++i) v[i] = __builtin_nontemporal_load((const GAS f32x4*)(wp + (size_t)(8 * i) * N));
#pragma unroll
        for (int i = 0; i < 8; ++i) { LAS float* d = scr + (8 * i + rr) * 33 + q4; const float gs = gk ? gk[k0 + 8 * i + rr] : 1.0f;
            d[0] = v[i].x * gs; d[1] = v[i].y * gs; d[2] = v[i].z * gs; d[3] = v[i].w * gs; } }
    LDS_WAIT(); asm volatile("" ::: "memory");
    const int c = lane & 7;
#pragma unroll
    for (int j = 0; j < 4; ++j) { const int n = (lane >> 3) + 8 * j; const LAS float* s = scr + (8 * c) * 33 + n;
        v4u o; o.x = pk2(s[0 * 33], s[1 * 33]); o.y = pk2(s[2 * 33], s[3 * 33]); o.z = pk2(s[4 * 33], s[5 * 33]); o.w = pk2(s[6 * 33], s[7 * 33]);
        *(GAS v4u*)(WT + (size_t)(r0 + n) * K + k0 + 8 * c) = o; }
    LDS_WAIT(); asm volatile("" ::: "memory");
}
__device__ __forceinline__ void x_row_to_bf16(const float* xrow, bf16* orow, float* ss, int lane) {
    const GAS f32x4* xr = (const GAS f32x4*)xrow + lane;
    GAS unsigned long long* o8 = (GAS unsigned long long*)orow + lane; float s = 0.f;
#pragma unroll
    for (int j = 0; j < 8; ++j) { const f32x4 v = __builtin_nontemporal_load(xr + 64 * j); s += (v.x * v.x + v.y * v.y) + (v.z * v.z + v.w * v.w);
        o8[64 * j] = (unsigned long long)pk2(v.x, v.y) | ((unsigned long long)pk2(v.z, v.w) << 32); }
    s = wave_sum(s);
    if (lane == 0) *ss = s;
}
struct Weights { const float *ev_w_in, *ev_w_out, *od_w_in, *od_w_out, *ev_ln_g, *od_ln_g; };
__device__ __forceinline__ void ph_prologue(LAS unsigned char* lds, int wave, int lane, int vcu, int G, const Weights& W, unsigned char* ws, const float* x) {
    LAS float* scr = (LAS float*)(lds + RING_OFF + wave * 16384);
    const int gw = vcu * NWAVES + wave, NGW = G * NWAVES;
    constexpr int I_EI = (DMODEL / 64) * (EV_IN / 32), I_EO = (DMODEL / 64) * (DMODEL / 32), I_OI = (DMODEL / 64) * (OD_IN / 32), I_OO = (CWID / 64) * (DMODEL / 32);
    constexpr int I_PAIR = I_EI + I_EO + I_OI + I_OO, NITEMS = 2 * I_PAIR;
    for (int it = gw; it < NITEMS; it += NGW) {
        const int j = it / I_PAIR; int r = it % I_PAIR;
        if (r < I_EI) { p0_transpose_item(W.ev_w_in + (size_t)j * DMODEL * EV_IN, DMODEL, EV_IN, (bf16*)(ws + WS_EWIN + j * SZ_EWIN), scr, r, lane, 1, W.ev_ln_g + j * DMODEL); continue; } r -= I_EI;
        if (r < I_EO) { p0_transpose_item(W.ev_w_out + (size_t)j * DMODEL * DMODEL, DMODEL, DMODEL, (bf16*)(ws + WS_EWOUT + j * SZ_EWOUT), scr, r, lane, 0); continue; } r -= I_EO;
        if (r < I_OI) { p0_transpose_item(W.od_w_in + (size_t)j * DMODEL * OD_IN, DMODEL, OD_IN, (bf16*)(ws + WS_OWIN + j * SZ_OWIN), scr, r, lane, 2, W.od_ln_g + j * DMODEL); continue; } r -= I_OI;
        p0_transpose_item(W.od_w_out + (size_t)j * CWID * DMODEL, CWID, DMODEL, (bf16*)(ws + WS_OWOUT + j * SZ_OWOUT), scr, r, lane, 0);
    }
    float* ssx0 = (float*)(ws + WS_CTL) + CW_SSX;
    for (int m = gw; m < MROWS; m += NGW) x_row_to_bf16(x + (size_t)m * DMODEL, (bf16*)(ws + WS_XN) + (size_t)m * DMODEL, ssx0 + m, lane);
}


namespace att {
using bf16x8 = __attribute__((ext_vector_type(8))) short;
using s16x4 = __attribute__((ext_vector_type(4))) short;
using f32x16 = __attribute__((ext_vector_type(16))) float;
using u32x4 = __attribute__((ext_vector_type(4))) unsigned;
typedef short v4i16_t __attribute__((ext_vector_type(4)));
typedef float f32x2_t __attribute__((ext_vector_type(2))); typedef __bf16 bf16x2_t __attribute__((ext_vector_type(2)));
typedef LAS const char* lds_cptr;
constexpr int ZP = 6400, YP = 2048, SLOTB = 8192, NSLOT = 3;
constexpr int L_K = 0, L_V = NSLOT * SLOTB, L_LUT = 2 * NSLOT * SLOTB, L_WS = L_LUT + 10240, L_OST = L_WS + 2048, L_END = L_OST + 32768;
static_assert(L_END <= 131072, "attention LDS map");
constexpr int LUT_N = 2304, LUT_OFF = 256;
constexpr float LOG2E = 1.4426950408889634f;
__device__ __forceinline__ int crow(int r, int hi) { return (r & 3) + 8 * (r >> 2) + 4 * hi; }
__device__ __forceinline__ void glds16(const void* gsrc, unsigned lds_dst) { unsigned keep;
    asm volatile("s_mov_b32 %0, m0\n\ts_mov_b32 m0, %2\n\ts_nop 0\n\tglobal_load_lds_dwordx4 %1, off\n\ts_mov_b32 m0, %0" : "=&s"(keep) : "v"(gsrc), "s"(lds_dst) : "memory"); }
__device__ __forceinline__ unsigned cvtpk_s(float lo, float hi) { f32x2_t v = {lo, hi}; bf16x2_t b = __builtin_convertvector(v, bf16x2_t); return __builtin_bit_cast(unsigned, b); }
#define ATT_WAIT_BAR(N) asm volatile("s_waitcnt vmcnt(" #N ") lgkmcnt(0)\n\ts_barrier" ::: "memory")
#define ATT_SBAR() __builtin_amdgcn_sched_barrier(0)
__device__ __forceinline__ void kload8(bf16x8* kf, lds_cptr kp) {
    kf[0] = *(const LAS bf16x8*)(kp);        kf[1] = *(const LAS bf16x8*)(kp + 512);
    kf[2] = *(const LAS bf16x8*)(kp + 2048); kf[3] = *(const LAS bf16x8*)(kp + 2560);
    kf[4] = *(const LAS bf16x8*)(kp + 4096); kf[5] = *(const LAS bf16x8*)(kp + 4608);
    kf[6] = *(const LAS bf16x8*)(kp + 6144); kf[7] = *(const LAS bf16x8*)(kp + 6656);
}
__device__ __forceinline__ void kload2(bf16x8* kf, lds_cptr kp, int j) { kf[2 * j] = *(const LAS bf16x8*)(kp + j * 2048); kf[2 * j + 1] = *(const LAS bf16x8*)(kp + j * 2048 + 512); }
__device__ __forceinline__ s16x4 vtr(lds_cptr p) { return __builtin_bit_cast(s16x4, __builtin_amdgcn_ds_read_tr16_b64_v4i16((LAS v4i16_t*)p)); }
__device__ __forceinline__ void pv(f32x16* o, int vb, bf16x8 pa0, bf16x8 pa1, bf16x8 pa2, bf16x8 pa3) {
#pragma unroll
    for (int d0 = 0; d0 < 2; ++d0) { s16x4 lo[4], hi[4];
#pragma unroll
        for (int ks = 0; ks < 4; ++ks) {
            asm volatile("ds_read_b64_tr_b16 %0,%1 offset:%c2" : "=&v"(lo[ks]) : "v"(vb), "i"(d0 * 4096 + ks * 1024) : "memory");
            asm volatile("ds_read_b64_tr_b16 %0,%1 offset:%c2" : "=&v"(hi[ks]) : "v"(vb), "i"(d0 * 4096 + ks * 1024 + 512) : "memory"); }
        asm volatile("s_waitcnt lgkmcnt(0)" ::: "memory"); ATT_SBAR();
#define ATT_PK(k) (bf16x8){lo[k][0], lo[k][1], lo[k][2], lo[k][3], hi[k][0], hi[k][1], hi[k][2], hi[k][3]}
        o[d0] = __builtin_amdgcn_mfma_f32_32x32x16_bf16(pa0, ATT_PK(0), o[d0], 0, 0, 0);
        o[d0] = __builtin_amdgcn_mfma_f32_32x32x16_bf16(pa1, ATT_PK(1), o[d0], 0, 0, 0);
        o[d0] = __builtin_amdgcn_mfma_f32_32x32x16_bf16(pa2, ATT_PK(2), o[d0], 0, 0, 0);
        o[d0] = __builtin_amdgcn_mfma_f32_32x32x16_bf16(pa3, ATT_PK(3), o[d0], 0, 0, 0);
#undef ATT_PK
    }
}
#define ATT_LUTV(lp, H, r) ((lp)[((H) ? 27 : 59) - (((r) & 3) + 8 * ((r) >> 2))])
#define ATT_LUT4(T, lp, H, B) do { T[0] = ATT_LUTV(lp, H, B); T[1] = ATT_LUTV(lp, H, (B) + 1); T[2] = ATT_LUTV(lp, H, (B) + 2); T[3] = ATT_LUTV(lp, H, (B) + 3); } while (0)
__device__ __forceinline__ void attn_unit(const int b, const int hh, const int qb, const bf16* Z, bf16* Y, const float* sinks, const float* lutg, const float* m0g, const bool newhead, LAS unsigned char* shm, const int tid) {
    const bool isB = hh >= 16; const int h = hh & 15;
    const int lane = tid & 63, r32 = lane & 31, hi = lane >> 5; const int wid = __builtin_amdgcn_readfirstlane(tid >> 6);
    const int qcol = isB ? 2304 + h * 64 : h * 64;
    const int kcol = isB ? 3328 + h * 64 : 1024 + (h >> 3) * 64;
    const int vcol = isB ? 4352 + h * 64 : 1152 + (h >> 3) * 64;
    const int gcol = isB ? 5376 + h * 64 : 1280 + h * 64;
    const int ycol = (isB ? 1024 : 0) + h * 64;
    const long rowbase = (long)b * SEQ; const int q0 = qb * 256;
    const int t_lo = isB ? 0 : (qb > 0 ? 4 * qb - 2 : 0), NT = 4 * qb + 4 - t_lo;
    const float M0 = m0g[hh];
    LAS float* lut = (LAS float*)(shm + L_LUT);
    if (newhead) { for (int i = tid; i < LUT_N; i += 512) lut[i] = lutg[hh * LUT_N + i] - M0; }
    const bf16* Qw = Z + (rowbase + q0 + wid * 32) * ZP + qcol;
    const unsigned lds0 = (unsigned)(uintptr_t)shm;
    const bf16* ksrc = Z + (rowbase + 64 * t_lo + lane) * ZP + kcol + wid * 8;
    const bf16* vsrc = Z + (rowbase + 64 * t_lo + 16 * (wid & 3) + (lane >> 2)) * ZP + vcol + (wid >> 2) * 32 + (lane & 3) * 8;
    const unsigned kdst = lds0 + L_K + wid * 1024, vdst = lds0 + L_V + wid * 1024;
#define ATT_DMA_K(i, slot) glds16(ksrc + (long)(i) * 64 * ZP, (unsigned)__builtin_amdgcn_readfirstlane(kdst + (slot)))
#define ATT_DMA_V(i, slot) glds16(vsrc + (long)(i) * 64 * ZP, (unsigned)__builtin_amdgcn_readfirstlane(vdst + (slot)))
    const int vb0 = (int)(lds0 + L_V) + ((lane >> 4) & 1) * 32 + (lane & 3) * 8 + (4 * hi + ((lane & 15) >> 2)) * 64;
    const lds_cptr shm3 = (lds_cptr)shm; const lds_cptr kp0 = shm3 + L_K + hi * 1024 + r32 * 16; const lds_cptr vp0 = shm3 + L_V + ((lane >> 4) & 1) * 32 + (lane & 3) * 8 + (4 * hi + ((lane & 15) >> 2)) * 64;
    bf16x8 kf[8];
    ATT_DMA_K(0, 0); ATT_DMA_V(0, 0); ATT_DMA_K(1, SLOTB);
    bf16x8 qr[4];
#pragma unroll
    for (int d0 = 0; d0 < 4; ++d0) qr[d0] = *reinterpret_cast<const bf16x8*>(Qw + (long)r32 * ZP + d0 * 16 + hi * 8);
    float l_reg = 0.f; f32x16 o[2]; o[0] = f32x16{}; o[1] = f32x16{};
    const LAS float* lp0 = lut + (q0 + wid * 32 + r32 - 64 * t_lo - 4 * hi + LUT_OFF - 59);
    f32x16 pA0, pA1, pB0, pB1;
    int sl_prev = 0, sl_cur = 0, sl_next = SLOTB;
#define ATT_ROT() do { sl_prev = sl_cur; sl_cur = sl_next; sl_next = (sl_next == (NSLOT - 1) * SLOTB) ? 0 : sl_next + SLOTB; } while (0)
    ATT_DMA_K(2, 2 * SLOTB);
    ATT_WAIT_BAR(3);
    { const lds_cptr kb = kp0;
#pragma unroll
        for (int d0 = 0; d0 < 4; ++d0) { const bf16x8 b0 = *(const LAS bf16x8*)(kb + d0 * 2048), b1 = *(const LAS bf16x8*)(kb + d0 * 2048 + 512);
            if (d0 == 0) { pA0 = __builtin_amdgcn_mfma_f32_32x32x16_bf16(b0, qr[0], f32x16{}, 0, 0, 0); pA1 = __builtin_amdgcn_mfma_f32_32x32x16_bf16(b1, qr[0], f32x16{}, 0, 0, 0); }
            else { pA0 = __builtin_amdgcn_mfma_f32_32x32x16_bf16(b0, qr[d0], pA0, 0, 0, 0); pA1 = __builtin_amdgcn_mfma_f32_32x32x16_bf16(b1, qr[d0], pA1, 0, 0, 0); } } }
#pragma unroll
    for (int r = 0; r < 16; ++r) { pA0[r] = __builtin_amdgcn_exp2f(pA0[r] + ATT_LUTV(lp0, 0, r)); pA1[r] = __builtin_amdgcn_exp2f(pA1[r] + ATT_LUTV(lp0, 1, r)); }
    ATT_WAIT_BAR(0);
    ATT_DMA_K(3, 0); ATT_DMA_V(1, SLOTB);
    ATT_ROT();
    kload8(kf, kp0 + sl_cur);
    ATT_WAIT_BAR(2);
    s16x4 vlo[8], vhi[8]; u32x4 pw0, pw1, pw2, pw3;
#define ATT_PKW(P, B) cvtpk_s(P[B], P[B + 1])
#define ATT_PAF(k) __builtin_bit_cast(bf16x8, pw##k)
#define ATT_VFR(i) (bf16x8){vlo[i][0], vlo[i][1], vlo[i][2], vlo[i][3], vhi[i][0], vhi[i][1], vhi[i][2], vhi[i][3]}
#define ATT_PIN(x) asm volatile("" : "+v"(x))
#define ATT_GAPA(MF, A0, A1, A2, A3, W0, W1, PW) do { MF; sacc += A0; sacc += A1; sacc += A2; sacc += A3; ATT_PIN(sacc); W0; W1; ATT_PIN(PW); ATT_SBAR(); } while (0)
#define ATT_EX(v) __builtin_amdgcn_exp2f(v)
#define ATT_GAPB(MF, X, B, TC, TN, HN, BN) do { MF; ATT_LUT4(TN, lpc_, HN, BN); \
    X[B] = ATT_EX(X[B] + TC[0]); X[B + 1] = ATT_EX(X[B + 1] + TC[1]); X[B + 2] = ATT_EX(X[B + 2] + TC[2]); X[B + 3] = ATT_EX(X[B + 3] + TC[3]); ATT_PIN(X); ATT_SBAR(); } while (0)
#define ATT_VRD(i) do { vlo[i] = vtr(vp_ + (((i) >> 2) * 4096 + ((i) & 3) * 1024)); vhi[i] = vtr(vp_ + (((i) >> 2) * 4096 + ((i) & 3) * 1024 + 512)); } while (0)
#define ATT_KRD(G, j) do { if (G) { kload2(kf, kp0 + sl_next, j); ATT_SBAR(); } } while (0)
#define ATT_STEP(C0, C1, P0, P1, i, GK, GV, GL) do { ATT_SBAR(); \
    const lds_cptr vp_ = vp0 + sl_prev; const LAS float* lpc_ = lp0 - 64 * (i); float ta_[4], tb_[4]; \
    ATT_VRD(0); ATT_SBAR(); float sacc = (P0[0] + P0[1]); \
    ATT_GAPA(C0 = __builtin_amdgcn_mfma_f32_32x32x16_bf16(kf[0], qr[0], f32x16{}, 0, 0, 0), P0[2], P0[3], P0[4], P0[5],     pw0[0] = ATT_PKW(P0, 0), pw0[1] = ATT_PKW(P0, 2), pw0); \
    ATT_VRD(4); ATT_SBAR(); ATT_GAPA(C1 = __builtin_amdgcn_mfma_f32_32x32x16_bf16(kf[1], qr[0], f32x16{}, 0, 0, 0), P0[6], P0[7], P0[8], P0[9],     pw0[2] = ATT_PKW(P0, 4), pw0[3] = ATT_PKW(P0, 6), pw0); \
    ATT_VRD(1); ATT_SBAR(); ATT_GAPA(C0 = __builtin_amdgcn_mfma_f32_32x32x16_bf16(kf[2], qr[1], C0, 0, 0, 0), P0[10], P0[11], P0[12], P0[13], pw1[0] = ATT_PKW(P0, 8), pw1[1] = ATT_PKW(P0, 10), pw1); \
    ATT_VRD(5); ATT_SBAR(); ATT_GAPA(C1 = __builtin_amdgcn_mfma_f32_32x32x16_bf16(kf[3], qr[1], C1, 0, 0, 0), P0[14], P0[15], P1[0], P1[1],   pw1[2] = ATT_PKW(P0, 12), pw1[3] = ATT_PKW(P0, 14), pw1); \
    ATT_VRD(2); ATT_SBAR(); ATT_GAPA(C0 = __builtin_amdgcn_mfma_f32_32x32x16_bf16(kf[4], qr[2], C0, 0, 0, 0), P1[2], P1[3], P1[4], P1[5],     pw2[0] = ATT_PKW(P1, 0), pw2[1] = ATT_PKW(P1, 2), pw2); \
    ATT_VRD(6); ATT_SBAR(); ATT_GAPA(C1 = __builtin_amdgcn_mfma_f32_32x32x16_bf16(kf[5], qr[2], C1, 0, 0, 0), P1[6], P1[7], P1[8], P1[9],     pw2[2] = ATT_PKW(P1, 4), pw2[3] = ATT_PKW(P1, 6), pw2); \
    ATT_VRD(3); ATT_SBAR(); ATT_GAPA(C0 = __builtin_amdgcn_mfma_f32_32x32x16_bf16(kf[6], qr[3], C0, 0, 0, 0), P1[10], P1[11], P1[12], P1[13], pw3[0] = ATT_PKW(P1, 8), pw3[1] = ATT_PKW(P1, 10), pw3); \
    ATT_VRD(7); ATT_SBAR(); ATT_GAPA(C1 = __builtin_amdgcn_mfma_f32_32x32x16_bf16(kf[7], qr[3], C1, 0, 0, 0), P1[14], P1[15], 0.f, 0.f,       pw3[2] = ATT_PKW(P1, 12), pw3[3] = ATT_PKW(P1, 14), pw3); \
    l_reg += sacc; \
    if (GK) { ATT_DMA_K((i) + 3, sl_cur); } if (GV) { ATT_DMA_V((i) + 1, sl_next); } \
    ATT_LUT4(ta_, lpc_, 0, 0); ATT_SBAR(); \
    ATT_GAPB(o[0] = __builtin_amdgcn_mfma_f32_32x32x16_bf16(ATT_PAF(0), ATT_VFR(0), o[0], 0, 0, 0), C0, 0, ta_, tb_, 0, 4); \
    ATT_GAPB(o[1] = __builtin_amdgcn_mfma_f32_32x32x16_bf16(ATT_PAF(0), ATT_VFR(4), o[1], 0, 0, 0), C0, 4, tb_, ta_, 0, 8); \
    ATT_KRD(GL, 0); ATT_GAPB(o[0] = __builtin_amdgcn_mfma_f32_32x32x16_bf16(ATT_PAF(1), ATT_VFR(1), o[0], 0, 0, 0), C0, 8, ta_, tb_, 0, 12); \
    ATT_KRD(GL, 1); ATT_GAPB(o[1] = __builtin_amdgcn_mfma_f32_32x32x16_bf16(ATT_PAF(1), ATT_VFR(5), o[1], 0, 0, 0), C0, 12, tb_, ta_, 1, 0); \
    ATT_KRD(GL, 2); ATT_GAPB(o[0] = __builtin_amdgcn_mfma_f32_32x32x16_bf16(ATT_PAF(2), ATT_VFR(2), o[0], 0, 0, 0), C1, 0, ta_, tb_, 1, 4); \
    ATT_KRD(GL, 3); ATT_GAPB(o[1] = __builtin_amdgcn_mfma_f32_32x32x16_bf16(ATT_PAF(2), ATT_VFR(6), o[1], 0, 0, 0), C1, 4, tb_, ta_, 1, 8); \
    ATT_GAPB(o[0] = __builtin_amdgcn_mfma_f32_32x32x16_bf16(ATT_PAF(3), ATT_VFR(3), o[0], 0, 0, 0), C1, 8, ta_, tb_, 1, 12); \
    ATT_GAPB(o[1] = __builtin_amdgcn_mfma_f32_32x32x16_bf16(ATT_PAF(3), ATT_VFR(7), o[1], 0, 0, 0), C1, 12, tb_, ta_, 1, 12); \
    } while (0)
#define ATT_ENDW(tt) do { if ((tt) + 3 < NT) { ATT_WAIT_BAR(2); } else if ((tt) + 2 < NT) { ATT_WAIT_BAR(1); } else { ATT_WAIT_BAR(0); } } while (0)
    int t = 1;
    for (; t + 1 < NT; t += 2) {
        ATT_STEP(pB0, pB1, pA0, pA1, t, (t + 3 < NT), (t + 1 < NT), (t + 1 < NT));         ATT_ENDW(t);     ATT_ROT();
        ATT_STEP(pA0, pA1, pB0, pB1, t + 1, (t + 4 < NT), (t + 2 < NT), (t + 2 < NT));     ATT_ENDW(t + 1); ATT_ROT();
    }
    ATT_STEP(pB0, pB1, pA0, pA1, NT - 1, false, false, false);
    { float sacc = pB0[0] + pB0[1];
#pragma unroll
        for (int r = 2; r < 16; ++r) sacc += pB0[r];
#pragma unroll
        for (int r = 0; r < 16; ++r) sacc += pB1[r];
        l_reg += sacc;
        pw0 = (u32x4){ATT_PKW(pB0, 0), ATT_PKW(pB0, 2), ATT_PKW(pB0, 4), ATT_PKW(pB0, 6)}; pw1 = (u32x4){ATT_PKW(pB0, 8), ATT_PKW(pB0, 10), ATT_PKW(pB0, 12), ATT_PKW(pB0, 14)};
        pw2 = (u32x4){ATT_PKW(pB1, 0), ATT_PKW(pB1, 2), ATT_PKW(pB1, 4), ATT_PKW(pB1, 6)}; pw3 = (u32x4){ATT_PKW(pB1, 8), ATT_PKW(pB1, 10), ATT_PKW(pB1, 12), ATT_PKW(pB1, 14)};
        ATT_SBAR(); pv(o, vb0 + sl_cur, ATT_PAF(0), ATT_PAF(1), ATT_PAF(2), ATT_PAF(3)); }
#undef ATT_PKW
#undef ATT_PAF
#undef ATT_VFR
#undef ATT_PIN
#undef ATT_GAPA
#undef ATT_GAPB
#undef ATT_EX
#undef ATT_VRD
#undef ATT_KRD
#undef ATT_STEP
#undef ATT_ENDW
#undef ATT_ROT
#undef ATT_DMA_K
#undef ATT_DMA_V
    { auto rr = __builtin_amdgcn_permlane32_swap(__float_as_uint(l_reg), __float_as_uint(l_reg), false, false); l_reg = __uint_as_float(rr[0]) + __uint_as_float(rr[1]); }
    if (!isB) l_reg += __builtin_amdgcn_exp2f(sinks[h] * LOG2E - M0);
    LAS float* wsf = (LAS float*)(shm + L_WS) + wid * 64;
    if (hi == 0) wsf[32 + r32] = l_reg;
    asm volatile("s_waitcnt lgkmcnt(0)" ::: "memory");
    float rli[16];
#pragma unroll
    for (int r = 0; r < 16; ++r) rli[r] = __builtin_amdgcn_rcpf(wsf[32 + crow(r, hi)]);
    { LAS bf16* stg = (LAS bf16*)(shm + L_OST) + wid * 2048;
#pragma unroll
        for (int r = 0; r < 16; ++r) { const int orow = crow(r, hi);
#pragma unroll
            for (int d0 = 0; d0 < 2; ++d0) stg[orow * 64 + d0 * 32 + r32] = (bf16)f2bf(o[d0][r] * rli[r]); }
        asm volatile("s_waitcnt lgkmcnt(0)" ::: "memory");
#pragma unroll
        for (int i = 0; i < 4; ++i) { const int row = i * 8 + (lane >> 3), ch = lane & 7;
            const u32x4 v = *(const LAS u32x4*)(stg + row * 64 + ch * 8);
            const u32x4 g = *(const GAS u32x4*)(Z + (rowbase + q0 + wid * 32 + row) * ZP + gcol + ch * 8);
            u32x4 w;
            w.x = pk2(__uint_as_float(v.x << 16) * __uint_as_float(g.x << 16), __uint_as_float(v.x & 0xffff0000u) * __uint_as_float(g.x & 0xffff0000u));
            w.y = pk2(__uint_as_float(v.y << 16) * __uint_as_float(g.y << 16), __uint_as_float(v.y & 0xffff0000u) * __uint_as_float(g.y & 0xffff0000u));
            w.z = pk2(__uint_as_float(v.z << 16) * __uint_as_float(g.z << 16), __uint_as_float(v.z & 0xffff0000u) * __uint_as_float(g.z & 0xffff0000u));
            w.w = pk2(__uint_as_float(v.w << 16) * __uint_as_float(g.w << 16), __uint_as_float(v.w & 0xffff0000u) * __uint_as_float(g.w & 0xffff0000u));
            *(GAS u32x4*)(Y + (rowbase + q0 + wid * 32 + row) * YP + ycol + ch * 8) = w; } }
    asm volatile("s_waitcnt lgkmcnt(0)\n\ts_barrier" ::: "memory");
}
__device__ __forceinline__ void attn_phase_b(const bf16* Z, bf16* Y, const float* sinks, const float* lutg, const float* m0g, LAS unsigned char* shm, int vcu, int G, int tid) {
    int prev_hh = -1;
    for (int u = vcu; u < 512; u += G) {
        const int i = u >> 8, v = u & 255, bh = v >> 2, s = v & 3, b = bh >> 4, h = bh & 15;
        attn_unit(b, 16 + h, (i == 0) ? 7 - s : s, Z, Y, sinks, lutg, m0g, (16 + h) != prev_hh, shm, tid);
        prev_hh = 16 + h;
    }
}
__device__ __forceinline__ void attn_phase_a(const bf16* Z, bf16* Y, const float* sinks, const float* lutg, const float* m0g, LAS unsigned char* shm, int a, int na, int tid) {
    int prev_hh = -1;
    for (int u = a; u < 512; u += na) {
        const int bh = u >> 3, qb = u & 7, b = bh >> 4, h = bh & 15;
        attn_unit(b, h, qb, Z, Y, sinks, lutg, m0g, h != prev_hh, shm, tid);
        prev_hh = h;
    }
}
__device__ __forceinline__ void build_tables(float* lutg, float* m0g, const float* relb, const float* ev_qk_g, int gtid, int gthreads) {
    for (int e = gtid; e < 32 * LUT_N; e += gthreads) { const int hh = e / LUT_N, i = e % LUT_N, d = i - LUT_OFF; float val = -1e30f;
        if (d >= 0) { const int w = (hh >= 16) ? ((d <= 128 ? 1 : 0) + (((d & 3) == 0 && d <= 512) ? 1 : 0) + (((d & 15) == 0) ? 1 : 0)) : (d <= 127 ? 1 : 0);
            if (w > 0) val = relb[t5_bucket(d) * 32 + hh] * LOG2E + (w == 1 ? 0.f : (w == 2 ? 1.0f : 1.5849625f)); }
        lutg[e] = val; }
    if (gtid < 64) { const int j = gtid >> 5, hh = gtid & 31; const float* gq = ev_qk_g + j * 256 + (hh >= 16 ? 128 : 0); const float* gk = gq + 64;
        float maxg = 0.f, maxb = 0.f;
        for (int d = 0; d < 64; ++d) maxg = fmaxf(maxg, fabsf(gq[d] * gk[d]));
        for (int k = 0; k < 32; ++k) maxb = fmaxf(maxb, fabsf(relb[k * 32 + hh]));
        m0g[gtid] = (8.0f * maxg + maxb) * LOG2E + 1.5849625f + 0.25f; }
}
#undef ATT_WAIT_BAR
#undef ATT_SBAR
#undef ATT_LUTV
#undef ATT_LUT4
}

namespace mix {
using bf16x8 = __attribute__((ext_vector_type(8))) short;
using s16x4 = __attribute__((ext_vector_type(4))) short;
using f32x16 = __attribute__((ext_vector_type(16))) float;
using u32x4 = __attribute__((ext_vector_type(4))) unsigned;
constexpr int L_V = 0, L_STG = 65536, L_RS = RING_BYTES + 2048;
#define MIX_DMA_V(ch_, g_) do { const bf16* src_ = V + (size_t)((ch_) * 128 + (lane >> 2)) * CWID + 256 * (g_) + 32 * wid + (lane & 3) * 8; \
    _Pragma("unroll") for (int kg = 0; kg < 8; ++kg) att::glds16(src_ + (size_t)(16 * kg) * CWID, (unsigned)__builtin_amdgcn_readfirstlane(lds0 + L_V + (wid * 8 + kg) * 1024)); } while (0)
__device__ __forceinline__ void mix_phase(const bf16* UG, const bf16* V, bf16* Y, const float* ssv, const float* vg, const float* wsp, const float* bsp, LAS unsigned char* shm, int vcu, int G, const int tid) {
    const int lane = tid & 63, r32 = lane & 31, hi = lane >> 5; const int wid = __builtin_amdgcn_readfirstlane(tid >> 6);
    const int tb = wid & 3, ch2 = wid >> 2, nks = 2 * tb + 2;
    LAS float* rs = (LAS float*)(shm + L_RS);
    const unsigned lds0 = (unsigned)(uintptr_t)shm;
    const int vb = (int)(lds0 + L_V) + ch2 * 32768 + ((lane >> 4) & 1) * 32 + (lane & 3) * 8 + (4 * hi + ((lane & 15) >> 2)) * 64;
    LAS bf16* stg = (LAS bf16*)(shm + L_STG) + wid * 4096;
    int u = vcu;
    if (u < 1024) { if (tid < 128) rs[tid] = __builtin_amdgcn_rsqf(ssv[(u >> 4) * 128 + tid] * (1.f / 4096.f) + EPS); MIX_DMA_V(u >> 4, u & 15); }
    for (; u < 1024; u += G) {
        const int ch = u >> 4, g = u & 15, row0 = ch * 128;
        const int t = 32 * tb + r32; const float* wrow = wsp + ((size_t)g * 128 + t) * 128 + 4 * hi;
        f32x4 wa[8][2];
#pragma unroll
        for (int ks = 0; ks < 8; ++ks) if (ks < nks) { wa[ks][0] = *(const GAS f32x4*)(wrow + 16 * ks); wa[ks][1] = *(const GAS f32x4*)(wrow + 16 * ks + 8); }
        asm volatile("s_waitcnt vmcnt(0) lgkmcnt(0)\n\ts_barrier" ::: "memory");
        bf16x8 af[8];
#pragma unroll
        for (int ks = 0; ks < 8; ++ks) { af[ks] = bf16x8{};
            if (ks < nks) { const int s0 = 16 * ks + 4 * hi;
                f32x4 a = wa[ks][0] * *(const LAS f32x4*)(rs + s0), b = wa[ks][1] * *(const LAS f32x4*)(rs + s0 + 8);
                a.x = (s0 + 0 <= t) ? a.x : 0.f; a.y = (s0 + 1 <= t) ? a.y : 0.f; a.z = (s0 + 2 <= t) ? a.z : 0.f; a.w = (s0 + 3 <= t) ? a.w : 0.f;
                b.x = (s0 + 8 <= t) ? b.x : 0.f; b.y = (s0 + 9 <= t) ? b.y : 0.f; b.z = (s0 + 10 <= t) ? b.z : 0.f; b.w = (s0 + 11 <= t) ? b.w : 0.f;
                u32x4 w; w.x = pk2(a.x, a.y); w.y = pk2(a.z, a.w); w.z = pk2(b.x, b.y); w.w = pk2(b.z, b.w);
                af[ks] = __builtin_bit_cast(bf16x8, w); } }
        f32x16 acc[4];
#pragma unroll
        for (int nb = 0; nb < 4; ++nb) { acc[nb] = f32x16{};
#pragma unroll
            for (int ks = 0; ks < 8; ++ks) { if (ks < nks) { s16x4 lo, hh;
                asm volatile("ds_read_b64_tr_b16 %0,%1 offset:%c2" : "=&v"(lo) : "v"(vb), "i"(nb * 8192 + ks * 1024) : "memory");
                asm volatile("ds_read_b64_tr_b16 %0,%1 offset:%c2" : "=&v"(hh) : "v"(vb), "i"(nb * 8192 + ks * 1024 + 512) : "memory");
                asm volatile("s_waitcnt lgkmcnt(0)" ::: "memory"); __builtin_amdgcn_sched_barrier(0);
                const bf16x8 bfr = (bf16x8){lo[0], lo[1], lo[2], lo[3], hh[0], hh[1], hh[2], hh[3]};
                acc[nb] = __builtin_amdgcn_mfma_f32_32x32x16_bf16(af[ks], bfr, acc[nb], 0, 0, 0); } } }
        asm volatile("s_waitcnt lgkmcnt(0)\n\ts_barrier" ::: "memory");
        { const int un = u + G; if (un < 1024) { if (tid < 128) rs[tid] = __builtin_amdgcn_rsqf(ssv[(un >> 4) * 128 + tid] * (1.f / 4096.f) + EPS); MIX_DMA_V(un >> 4, un & 15); } }
#pragma unroll
        for (int nb = 0; nb < 4; ++nb) { const float gv = vg[256 * g + 128 * ch2 + 32 * nb + r32];
#pragma unroll
            for (int r = 0; r < 16; ++r) { const int tl = (r & 3) + 8 * (r >> 2) + 4 * hi;
                stg[tl * 128 + 32 * nb + r32] = (bf16)f2bf(acc[nb][r] * gv + bsp[g * 128 + 32 * tb + tl]); } }
        asm volatile("s_waitcnt lgkmcnt(0)" ::: "memory");
#pragma unroll
        for (int i = 0; i < 8; ++i) { const int row = i * 4 + (lane >> 4), chk = lane & 15;
            const u32x4 s = *(const LAS u32x4*)(stg + row * 128 + chk * 8);
            const size_t idx = (size_t)(row0 + 32 * tb + row) * CWID + 256 * g + 128 * ch2 + chk * 8;
            const u32x4 q = *(const GAS u32x4*)(UG + idx);
            u32x4 w;
            w.x = pk2(__uint_as_float(s.x << 16) * __uint_as_float(q.x << 16), __uint_as_float(s.x & 0xffff0000u) * __uint_as_float(q.x & 0xffff0000u));
            w.y = pk2(__uint_as_float(s.y << 16) * __uint_as_float(q.y << 16), __uint_as_float(s.y & 0xffff0000u) * __uint_as_float(q.y & 0xffff0000u));
            w.z = pk2(__uint_as_float(s.z << 16) * __uint_as_float(q.z << 16), __uint_as_float(s.z & 0xffff0000u) * __uint_as_float(q.z & 0xffff0000u));
            w.w = pk2(__uint_as_float(s.w << 16) * __uint_as_float(q.w << 16), __uint_as_float(s.w & 0xffff0000u) * __uint_as_float(q.w & 0xffff0000u));
            *(GAS u32x4*)(Y + idx) = w; }
        asm volatile("s_waitcnt lgkmcnt(0)" ::: "memory");
    }
}
#undef MIX_DMA_V
}

struct Args { const float* in[13]; float* out; unsigned char* ws; int ph_lo, ph_hi; };
__global__ void __launch_bounds__(NWAVES * 64, 2) skel_fwd(Args args) {
    extern __shared__ __attribute__((aligned(16))) unsigned char lds_raw[];
    LAS unsigned char* lds = (LAS unsigned char*)lds_raw;
    const int G = gridDim.x; int vcu; { const int bx = blockIdx.x; vcu = (G % 8 == 0) ? (bx % 8) * (G / 8) + bx / 8 : bx; }
    unsigned char* ws = args.ws;
    gu32* ctl = (gu32*)(ws + WS_CTL);
    for (int u = threadIdx.x; u < (LDS_BYTES - LDSCTL_OFF) / 4; u += NWAVES * 64) ((LAS unsigned*)(lds + LDSCTL_OFF))[u] = 0u;
    __syncthreads();
    const int lo = args.ph_lo, hi = args.ph_hi;
    XcdBarrier bar; bar.bar = (unsigned*)(ctl + CW_BAR); bar.x = 0; bar.st = nullptr;
    if (hi - lo > 1) bar = xcd_barrier_post((unsigned*)(ctl + CW_BAR), (volatile LAS unsigned*)(lds + MISC_OFF) + 8);
    const float* x_in = args.in[0];
    const float *ev_ln_g = args.in[1], *ev_w_in = args.in[2], *ev_qk_g = args.in[3], *ev_sinks = args.in[4], *ev_w_out = args.in[5];
    const float *od_ln_g = args.in[6], *od_w_in = args.in[7], *od_v_g = args.in[8], *od_w_s = args.in[9], *od_b_s = args.in[10], *od_w_out = args.in[11], *rel_bias = args.in[12];
    float* out = args.out;
    bf16* XN = (bf16*)(ws + WS_XN); bf16* Z = (bf16*)(ws + WS_Z); bf16* VB = (bf16*)(ws + WS_Z + 64 * MiB); bf16* Y = (bf16*)(ws + WS_Y);
    float* ssx = (float*)(ws + WS_CTL) + CW_SSX; float* ssv = (float*)(ws + WS_CTL) + CW_SSV;

#if PROBE_CLK >= 0
    long long clk_c0 = 0, clk_c1 = 1; unsigned long long clk_r0 = __builtin_amdgcn_s_memrealtime(), clk_r1 = 1;
#endif
    for (int p = lo; p < hi; ++p) {
        int kind = PH_PRO, layer = 0;
        if (p > 0) { const int q = p - 1, pair = q / 7, r = q % 7; layer = 2 * pair + (r >= 4 ? 1 : 0); kind = 1 + r; }
        const int j = layer >> 1;
        int tid = threadIdx.x; asm volatile("" : "+v"(tid));
        const int lane = tid & 63, wave = __builtin_amdgcn_readfirstlane(tid >> 6);
        const float* lutg = (const float*)(ws + WS_LUT); const float* m0g = (const float*)(ws + WS_LUT + 512 * 1024) + j * 32;
        if (kind == PH_PRO) {
            Weights W{ev_w_in, ev_w_out, od_w_in, od_w_out, ev_ln_g, od_ln_g};
            ph_prologue(lds, wave, lane, vcu, G, W, ws, x_in);
            att::build_tables((float*)(ws + WS_LUT), (float*)(ws + WS_LUT + 512 * 1024), rel_bias, ev_qk_g, vcu * (NWAVES * 64) + tid, G * NWAVES * 64);
        } else if (kind == PH_G1A || kind == PH_G1B) {
            pg8::Gemm g{XN, (const bf16*)(ws + WS_EWIN + j * SZ_EWIN), MROWS, EV_IN, DMODEL};
            const int nwg = (MROWS / 256) * (EV_IN / 256), full = nwg / G, rem = nwg % G, c = (int)blockIdx.x;
            pg8::WindowOrder S; S.init(g.M, g.N, G, c); S.i0 = (kind == PH_G1A) ? 0 : full; S.n = (kind == PH_G1A) ? full : 1;
            if (kind == PH_G1A || c < rem) { pg8::EpiQKV E{Z, g.N, ev_qk_g + j * 256, ssx + layer * MROWS}; pg8::gemm_phase<pg8::EpiQKV, pg8::WindowOrder, true, true>(lds + RING_OFF, g, S, E, tid); }
            else att::attn_phase_a(Z, Y, ev_sinks + j * 16, lutg, m0g, lds + RING_OFF, c - rem, G - rem, tid);
        } else if (kind == PH_ATTB) {
            att::attn_phase_b(Z, Y, ev_sinks + j * 16, lutg, m0g, lds + RING_OFF, vcu, G, tid);
        } else if (kind == PH_G1O) {
            pg8::Gemm g{XN, (const bf16*)(ws + WS_OWIN + j * SZ_OWIN), MROWS, OD_IN, DMODEL};
            pg8::StaticOrder S; S.init(g.M, g.N, G, (int)blockIdx.x);
            pg8::EpiOdd E{Z, VB, ssx + layer * MROWS, ssv + j * MROWS}; pg8::gemm_phase<pg8::EpiOdd, pg8::StaticOrder, true, true>(lds + RING_OFF, g, S, E, tid);
        } else if (kind == PH_MIX) {
            mix::mix_phase(Z, VB, Y, ssv + j * MROWS, od_v_g + j * CWID, od_w_s + (size_t)j * 16 * 16384, od_b_s + j * 2048, lds + RING_OFF, vcu, G, tid);
        } else {
            const bool odd = (kind == PH_G2O);
            pg8::Gemm g{Y, odd ? (const bf16*)(ws + WS_OWOUT + j * SZ_OWOUT) : (const bf16*)(ws + WS_EWOUT + j * SZ_EWOUT), MROWS, DMODEL, odd ? CWID : DMODEL};
            pg8::StaticOrder S; S.init(g.M, g.N, G, (int)blockIdx.x);
            const int nl = layer + 1;
            pg8::EpiResB E{XN, (nl < 4) ? (float*)nullptr : out, ssx + (nl & 3) * MROWS, 0};
            pg8::gemm_phase<pg8::EpiResB, pg8::StaticOrder, true, true>(lds + RING_OFF, g, S, E, tid);
        }
        if (p + 1 < hi) xcd_barrier(bar);
#if PROBE_CLK >= 0
        if (p == PROBE_CLK - 1) { clk_c0 = clock64(); clk_r0 = __builtin_amdgcn_s_memrealtime(); }
        if (p == PROBE_CLK) { clk_c1 = clock64(); clk_r1 = __builtin_amdgcn_s_memrealtime(); }
#endif
    }
#if PROBE_CLK >= 0
    if (blockIdx.x == 0 && threadIdx.x == 0) { const float us = (float)(clk_r1 - clk_r0) * 0.01f;
        const int n = (us > PROBE_T0) + (us > PROBE_T0 + PROBE_DT) + (us > PROBE_T0 + 2 * PROBE_DT) + (us > PROBE_T0 + 3 * PROBE_DT) + (us > PROBE_T0 + 4 * PROBE_DT);
        out[0] += 0.08f * (float)n; }
#endif
}

extern "C" void kernel_launch(void* const* d_in, const int* in_sizes, int n_in, void* d_out, int out_size, void* d_ws, size_t ws_size, hipStream_t stream) {
    static int grid = 0;
    if (grid == 0) {
        if (n_in != 13 || out_size != MROWS * DMODEL || ws_size < WS_END) { fprintf(stderr, "kernel_launch: unexpected shapes (n_in %d out %d ws %zu)\n", n_in, out_size, ws_size); grid = -1; return; }
        int dev = 0, cus = 0;
        if (hipGetDevice(&dev) != hipSuccess || hipDeviceGetAttribute(&cus, hipDeviceAttributeMultiprocessorCount, dev) != hipSuccess) { grid = -1; return; }
        if (hipFuncSetAttribute((const void*)skel_fwd, hipFuncAttributeMaxDynamicSharedMemorySize, LDS_BYTES) != hipSuccess) { fprintf(stderr, "kernel_launch: hipFuncSetAttribute failed\n"); grid = -1; return; }
        int per_cu = 0;
        (void)hipOccupancyMaxActiveBlocksPerMultiprocessor(&per_cu, (const void*)skel_fwd, NWAVES * 64, LDS_BYTES);
        (void)hipGetLastError();
        grid = cus;
    }
    if (grid < 0) return;
    (void)hipMemsetAsync((char*)d_ws + WS_CTL, 0, CTL_ZERO_BYTES, stream);
    Args a{};
    for (int i = 0; i < 13; ++i) a.in[i] = (const float*)d_in[i];
    a.out = (float*)d_out; a.ws = (unsigned char*)d_ws;
#if MK_ONE_LAUNCH
    a.ph_lo = 0; a.ph_hi = NPHASE;
    hipLaunchKernelGGL(skel_fwd, dim3(grid), dim3(NWAVES * 64), LDS_BYTES, stream, a);
#else
    for (int p = 0; p < NPHASE; ++p) { a.ph_lo = p; a.ph_hi = p + 1; hipLaunchKernelGGL(skel_fwd, dim3(grid), dim3(NWAVES * 64), LDS_BYTES, stream, a); }
#endif
}
```
